# Optimizing an MI355X kernel written in HIP

```python
import math
import jax, jax.numpy as jnp
from jax import lax
import numpy as np

D_MODEL = 1024
BATCH = 32
SEQ = 2048
DEPTH = 1

CTX_LEN = 256
GRID_W = 64
POS_BASE = 10000.0
EPS = 1e-6
N_MOD = 6
ML_HEADS = 4
ML_DV = (D_MODEL // 2) // ML_HEADS
ML_DK = ML_DV // 2
ML_QK = ML_HEADS * ML_DK
ML_V = ML_HEADS * ML_DV
ML_CONV = 3
ML_CHUNK = 64
ML_F_BIAS_LO = 3.0
ML_F_BIAS_HI = 6.0
GLA_HEADS = 4
GLA_DV = (D_MODEL - D_MODEL // 2) // GLA_HEADS
GLA_DK = GLA_DV // 2
GLA_QK = GLA_HEADS * GLA_DK
GLA_V = GLA_HEADS * GLA_DV
GLA_RANK = 16
GLA_NORMALIZER = 16.0
GLA_CHUNK = 64
MIX_WIDTH = ML_V + GLA_V
IN_SIZES = (ML_QK, ML_QK, ML_V, ML_V, 4 * ML_HEADS, GLA_QK, GLA_QK, GLA_V, GLA_V, 2 * GLA_RANK)
IN_WIDTH = 2 * ML_QK + 2 * ML_V + 4 * ML_HEADS + 2 * GLA_QK + 2 * GLA_V + 2 * GLA_RANK
N_EXPERTS = 32
TOP_K = 4
D_EXPERT = D_MODEL
SWIGLU_LIMIT = 7.0
SWIGLU_ALPHA = 1.702

kernel_name = 'hybrid_mlstm_gla_moe_dit_block'


def _rms(x, g):
    xf = x.astype(jnp.float32)
    y = xf * lax.rsqrt(jnp.mean(xf * xf, axis=-1, keepdims=True) + EPS)
    return (y * g.astype(jnp.float32)).astype(x.dtype)


def _modulate(h, shift, scale):
    return h * (1 + scale) + shift


def _adaln(cond, w, b):
    return (jax.nn.silu(cond) @ w + b).reshape(cond.shape[0], N_MOD, 1, w.shape[0])


def _grid_sincos(rows, d, dtype):
    f32 = jnp.float32
    nf = d // 4
    omega = 1.0 / (POS_BASE ** (jnp.arange(nf, dtype=f32) / nf))
    r = jnp.broadcast_to(jnp.arange(rows, dtype=f32)[:, None, None] * omega, (rows, GRID_W, nf))
    cl = jnp.broadcast_to(jnp.arange(GRID_W, dtype=f32)[None, :, None] * omega, (rows, GRID_W, nf))
    pe = jnp.concatenate([jnp.sin(r), jnp.cos(r), jnp.sin(cl), jnp.cos(cl)], axis=-1)
    return pe.reshape(rows * GRID_W, d).astype(dtype)


def _split_cols(z):
    offs = [int(o) for o in np.cumsum(IN_SIZES)[:-1]]
    return jnp.split(z, offs, axis=-1)


def _heads(a, n_heads):
    b, t, w = a.shape
    return a.reshape(b, t, n_heads, w // n_heads).transpose(0, 2, 1, 3)


def _merge_heads_norm(h, g, dtype):
    b, nh, t, d = h.shape
    hf = h.astype(jnp.float32)
    hf = hf * lax.rsqrt(jnp.mean(hf * hf, axis=-1, keepdims=True) + EPS)
    hf = hf.transpose(0, 2, 1, 3).reshape(b, t, nh * d)
    return (hf * g.astype(jnp.float32)).astype(dtype)


def _centred_conv(a, w, bias):
    k = w.shape[0]
    p = k // 2
    t = a.shape[1]
    ap = jnp.pad(a, ((0, 0), (p, p), (0, 0)))
    out = bias
    for i in range(k):
        out = out + ap[:, i:i + t] * w[i]
    return out


def _to_chunks(a, L):
    t = a.shape[2]
    return jnp.moveaxis(a.reshape(a.shape[:2] + (t // L, L) + a.shape[3:]), 2, 0)


def _from_chunks(hs):
    nc, b, h, L, d = hs.shape
    return jnp.moveaxis(hs, 0, 2).reshape(b, h, nc * L, d)


def _mlstm_scan(q, k, v, ig, lf, state):
    L = ML_CHUNK
    mask = jnp.tril(jnp.ones((L, L), dtype=bool))
    f32 = jnp.float32

    def step(carry, inp):
        C, n, m = carry
        qc, kc, vc, ic, fc = inp
        b = jnp.cumsum(fc, axis=-1)
        inter = b + m[..., None]
        dmat = b[..., :, None] - b[..., None, :] + ic[..., None, :]
        dmat = jnp.where(mask, dmat, -jnp.inf)
        m_t = jnp.maximum(inter, jnp.max(dmat, axis=-1))
        w_intra = jnp.exp(dmat - m_t[..., None])
        w_inter = jnp.exp(inter - m_t)
        s = jnp.einsum('bhtd,bhsd->bhts', qc, kc) * w_intra
        num = jnp.einsum('bhts,bhsv->bhtv', s, vc) + w_inter[..., None] * jnp.einsum('bhtd,bhdv->bhtv', qc, C)
        den = jnp.sum(s, axis=-1) + w_inter * jnp.einsum('bhtd,bhd->bht', qc, n)
        h = num / jnp.maximum(jnp.abs(den), jnp.exp(-m_t))[..., None]
        bL = b[..., -1]
        dec = bL[..., None] - b + ic
        m_new = jnp.maximum(bL + m, jnp.max(dec, axis=-1))
        wk = jnp.exp(dec - m_new[..., None])
        wc = jnp.exp(bL + m - m_new)
        C_new = wc[..., None, None] * C + jnp.einsum('bhs,bhsd,bhsv->bhdv', wk, kc, vc)
        n_new = wc[..., None] * n + jnp.einsum('bhs,bhsd->bhd', wk, kc)
        return (C_new, n_new, m_new), h

    xs = tuple(_to_chunks(a.astype(f32), L) for a in (q, k, v, ig, lf))
    carry, hs = lax.scan(step, state, xs)
    return _from_chunks(hs), carry


def _gla_scan(q, k, v, la, state):
    L = GLA_CHUNK
    mask = jnp.tril(jnp.ones((L, L), dtype=bool))[:, :, None]
    f32 = jnp.float32

    def step(S, inp):
        qc, kc, vc, lc = inp
        b = jnp.cumsum(lc, axis=2)
        rel = b[:, :, :, None, :] - b[:, :, None, :, :]
        rel = jnp.where(mask, rel, -jnp.inf)
        A = jnp.einsum('bhtd,bhsd,bhtsd->bhts', qc, kc, jnp.exp(rel))
        o = jnp.einsum('bhts,bhsv->bhtv', A, vc) + jnp.einsum('bhtd,bhdv->bhtv', qc * jnp.exp(b), S)
        bL = b[:, :, -1]
        S_new = jnp.exp(bL)[..., None] * S + jnp.einsum('bhsd,bhsv->bhdv', kc * jnp.exp(bL[:, :, None] - b), vc)
        return S_new, o

    xs = tuple(_to_chunks(a.astype(f32), L) for a in (q, k, v, la))
    S, hs = lax.scan(step, state, xs)
    return _from_chunks(hs), S


def _bidirectional(scan, ctx_f, ctx_b, lat_f, lat_b, state0):
    flip = lambda a: jnp.flip(a, axis=2)
    h_cf, s_f = scan(*ctx_f, state0)
    h_lf, _ = scan(*lat_f, s_f)
    h_cb, s_b = scan(*[flip(a) for a in ctx_b], state0)
    h_lb, _ = scan(*[flip(a) for a in lat_b], s_b)
    return h_cf + flip(h_cb), h_lf + flip(h_lb)


def _project(u, w_in, ml_conv_w, ml_conv_b, ml_gate_b, gla_gate_w2, gla_gate_b):
    f32 = jnp.float32
    b, t, _ = u.shape
    z = u @ w_in
    ml_q, ml_k, ml_v, ml_o, ml_g, g_q, g_k, g_v, g_g, g_lr = _split_cols(z)
    qk = jax.nn.silu(_centred_conv(jnp.concatenate([ml_q, ml_k], axis=-1), ml_conv_w, ml_conv_b))
    mq = _heads(qk[..., :ML_QK], ML_HEADS) * (ML_DK ** -0.5)
    mk = _heads(qk[..., ML_QK:], ML_HEADS)
    mv = _heads(ml_v, ML_HEADS)
    gates = (ml_g.astype(f32).reshape(b, t, 4, ML_HEADS) + ml_gate_b.astype(f32)).transpose(2, 0, 3, 1)
    ml_fwd = (mq, mk, mv, gates[0], jax.nn.log_sigmoid(gates[1]))
    ml_bwd = (mq, mk, mv, gates[2], jax.nn.log_sigmoid(gates[3]))
    gq = _heads(g_q, GLA_HEADS) * (GLA_DK ** -0.5)
    gk = _heads(g_k, GLA_HEADS)
    gv = _heads(g_v, GLA_HEADS)
    lr = g_lr.astype(f32).reshape(b, t, 2, GLA_RANK)
    pre = jnp.einsum('btzr,zrc->zbtc', lr, gla_gate_w2.astype(f32)) + gla_gate_b.astype(f32)[:, None, None, :]
    la = jax.nn.log_sigmoid(pre) / GLA_NORMALIZER
    la = la.reshape(2, b, t, GLA_HEADS, GLA_DK).transpose(0, 1, 3, 2, 4)
    return ml_fwd, ml_bwd, ml_o, (gq, gk, gv, la[0]), (gq, gk, gv, la[1]), g_g


def _hybrid_mixer(u_lat, u_ctx, w_in, ml_conv_w, ml_conv_b, ml_gate_b, ml_norm_g,
                  gla_gate_w2, gla_gate_b, gla_norm_g, w_out, ctx_out):
    p_lat = _project(u_lat, w_in, ml_conv_w, ml_conv_b, ml_gate_b, gla_gate_w2, gla_gate_b)
    p_ctx = _project(u_ctx, w_in, ml_conv_w, ml_conv_b, ml_gate_b, gla_gate_w2, gla_gate_b)
    b = u_lat.shape[0]
    f32 = jnp.float32
    ml_state0 = (jnp.zeros((b, ML_HEADS, ML_DK, ML_DV), f32), jnp.zeros((b, ML_HEADS, ML_DK), f32),
                 jnp.zeros((b, ML_HEADS), f32))
    gla_state0 = jnp.zeros((b, GLA_HEADS, GLA_DK, GLA_DV), f32)
    ml_c, ml_l = _bidirectional(_mlstm_scan, p_ctx[0], p_ctx[1], p_lat[0], p_lat[1], ml_state0)
    gla_c, gla_l = _bidirectional(_gla_scan, p_ctx[3], p_ctx[4], p_lat[3], p_lat[4], gla_state0)

    def merge(ml_h, ml_o, gla_h, g_g, dtype):
        a = _merge_heads_norm(ml_h, ml_norm_g, dtype) * jax.nn.sigmoid(ml_o)
        g = _merge_heads_norm(gla_h, gla_norm_g, dtype) * jax.nn.silu(g_g)
        return jnp.concatenate([a, g], axis=-1) @ w_out

    y_lat = merge(ml_l, p_lat[2], gla_l, p_lat[5], u_lat.dtype)
    y_ctx = merge(ml_c, p_ctx[2], gla_c, p_ctx[5], u_ctx.dtype) if ctx_out else None
    return y_lat, y_ctx


def _moe(u, router_w, router_b, w_gu, b_gu, w_down, b_down):
    bsz, t, d = u.shape
    tok = u.reshape(bsz * t, d)
    logits = (tok @ router_w + router_b).astype(jnp.float32)
    top_v, top_i = lax.top_k(logits, TOP_K)
    probs = jax.nn.softmax(top_v, axis=-1)
    gates = jnp.sum(jax.nn.one_hot(top_i, N_EXPERTS, dtype=jnp.float32) * probs[..., None], axis=1).astype(tok.dtype)
    out = jnp.zeros_like(tok)
    for e in range(N_EXPERTS):
        gu = tok @ w_gu[e] + b_gu[e]
        gate = jnp.minimum(gu[:, :D_EXPERT], SWIGLU_LIMIT)
        up = jnp.clip(gu[:, D_EXPERT:], -SWIGLU_LIMIT, SWIGLU_LIMIT)
        glu = gate * jax.nn.sigmoid(SWIGLU_ALPHA * gate)
        out = out + gates[:, e:e + 1] * (((up + 1) * glu) @ w_down[e] + b_down[e])
    return out.reshape(bsz, t, d)


def setup_inputs(seed: int = 0) -> dict:
    key = jax.random.key(seed)
    ks = jax.random.split(key, 24)
    f32 = jnp.float32
    nrm = lambda k, s, sc: jax.random.normal(k, s, f32) * sc
    D = D_MODEL
    f_bias = jnp.linspace(ML_F_BIAS_LO, ML_F_BIAS_HI, ML_HEADS, dtype=f32)
    zero_h = jnp.zeros((ML_HEADS,), f32)
    gate_base = jnp.stack([zero_h, f_bias, zero_h, f_bias])
    return {
        'x': nrm(ks[0], (BATCH, SEQ, D), 1.0),
        'c': nrm(ks[1], (BATCH, D), 1.0),
        'ctx': nrm(ks[2], (BATCH, CTX_LEN, D), 1.0),
        'c_ctx': nrm(ks[3], (D,), 1.0),
        'ada_w': nrm(ks[4], (DEPTH, D, N_MOD * D), 0.5 * D ** -0.5),
        'ada_b': nrm(ks[5], (DEPTH, N_MOD * D), 0.02),
        'norm1_g': 1.0 + nrm(ks[6], (DEPTH, D), 0.02),
        'w_in': nrm(ks[7], (DEPTH, D, IN_WIDTH), D ** -0.5),
        'ml_conv_w': nrm(ks[8], (DEPTH, ML_CONV, 2 * ML_QK), ML_CONV ** -0.5),
        'ml_conv_b': nrm(ks[9], (DEPTH, 2 * ML_QK), 0.02),
        'ml_gate_b': gate_base[None] + nrm(ks[10], (DEPTH, 4, ML_HEADS), 0.1),
        'ml_norm_g': 1.0 + nrm(ks[11], (DEPTH, ML_V), 0.02),
        'gla_gate_w2': nrm(ks[12], (DEPTH, 2, GLA_RANK, GLA_QK), GLA_RANK ** -0.5),
        'gla_gate_b': 1.0 + nrm(ks[13], (DEPTH, 2, GLA_QK), 0.1),
        'gla_norm_g': 1.0 + nrm(ks[14], (DEPTH, GLA_V), 0.02),
        'w_out': nrm(ks[15], (DEPTH, MIX_WIDTH, D), MIX_WIDTH ** -0.5),
        'norm2_g': 1.0 + nrm(ks[16], (DEPTH, D), 0.02),
        'router_w': nrm(ks[17], (DEPTH, D, N_EXPERTS), D ** -0.5),
        'router_b': nrm(ks[18], (DEPTH, N_EXPERTS), 0.01),
        'moe_w_gu': nrm(ks[19], (DEPTH, N_EXPERTS, D, 2 * D_EXPERT), D ** -0.5),
        'moe_b_gu': nrm(ks[20], (DEPTH, N_EXPERTS, 2 * D_EXPERT), 0.02),
        'moe_w_down': nrm(ks[21], (DEPTH, N_EXPERTS, D_EXPERT, D), D_EXPERT ** -0.5),
        'moe_b_down': nrm(ks[22], (DEPTH, N_EXPERTS, D), 0.02),
        'final_norm_g': 1.0 + nrm(ks[23], (D,), 0.02),
    }


def reference(x, c, ctx, c_ctx, ada_w, ada_b, norm1_g, w_in, ml_conv_w, ml_conv_b, ml_gate_b,
              ml_norm_g, gla_gate_w2, gla_gate_b, gla_norm_g, w_out, norm2_g, router_w, router_b,
              moe_w_gu, moe_b_gu, moe_w_down, moe_b_down, final_norm_g):
    T = x.shape[1]
    ROWS = T // GRID_W
    x = x + _grid_sincos(ROWS, x.shape[-1], x.dtype)[None]
    for l in range(DEPTH):
        last = l == DEPTH - 1
        m_lat = _adaln(c, ada_w[l], ada_b[l])
        m_ctx = _adaln(c_ctx[None, :], ada_w[l], ada_b[l])
        u_lat = _modulate(_rms(x, norm1_g[l]), m_lat[:, 0], m_lat[:, 1])
        u_ctx = _modulate(_rms(ctx, norm1_g[l]), m_ctx[:, 0], m_ctx[:, 1])
        y_lat, y_ctx = _hybrid_mixer(u_lat, u_ctx, w_in[l], ml_conv_w[l], ml_conv_b[l], ml_gate_b[l],
                                     ml_norm_g[l], gla_gate_w2[l], gla_gate_b[l], gla_norm_g[l], w_out[l],
                                     not last)
        x = x + m_lat[:, 2] * y_lat
        x = x + m_lat[:, 5] * _moe(_modulate(_rms(x, norm2_g[l]), m_lat[:, 3], m_lat[:, 4]), router_w[l],
                                   router_b[l], moe_w_gu[l], moe_b_gu[l], moe_w_down[l], moe_b_down[l])
        if not last:
            ctx = ctx + m_ctx[:, 2] * y_ctx
            ctx = ctx + m_ctx[:, 5] * _moe(_modulate(_rms(ctx, norm2_g[l]), m_ctx[:, 3], m_ctx[:, 4]),
                                           router_w[l], router_b[l], moe_w_gu[l], moe_b_gu[l],
                                           moe_w_down[l], moe_b_down[l])
    return _rms(x, final_norm_g)
```

```cpp
#include <hip/hip_runtime.h>
#include <cstdio>
#include <cstdint>

#ifndef MK_N_LAUNCHES
#define MK_N_LAUNCHES 1
#endif

#define GAS __attribute__((address_space(1)))
#define LAS __attribute__((address_space(3)))
typedef unsigned short bf16;
typedef short bf16x8 __attribute__((ext_vector_type(8)));
typedef short s16x4 __attribute__((ext_vector_type(4)));
typedef float f32x4 __attribute__((ext_vector_type(4)));
typedef float f32x2 __attribute__((ext_vector_type(2)));
typedef unsigned u32x4 __attribute__((ext_vector_type(4)));
typedef unsigned u32x2 __attribute__((ext_vector_type(2)));

constexpr int NB = 32, T = 2048, D = 1024, CT = 256;
constexpr int NLAT = NB * T, NCTX = NB * CT, NTOK = NLAT + NCTX;
constexpr int INW = 3120, ZW = 3328;
constexpr size_t PL64 = (size_t)NTOK * 64, PL128 = (size_t)NTOK * 128;
constexpr int F_MLQ = 0, F_MLK = 1, F_GQ = 2, F_GK = 3, F_MLV = 0, F_MLO = 1, F_GV = 2, F_GG = 3;
__host__ __device__ constexpr size_t plane64(int f, int h) { return (size_t)(f * 4 + h) * PL64; }
__host__ __device__ constexpr size_t plane128(int f, int h) { return 16 * PL64 + (size_t)(f * 4 + h) * PL128; }
constexpr size_t Z_MISC = 16 * PL64 + 16 * PL128;
constexpr int M_MLG = 0, M_LR = 16;
constexpr int NE = 32, TOPK = 4, DE = 1024;
constexpr int LCAP = 65536;
constexpr int MAXTILES = 1056;
constexpr float EPS = 1e-6f;

constexpr size_t MiB = 1u << 20;
constexpr size_t WS_CTL = 0, CTL_ZERO_BYTES = 1 * MiB;
constexpr size_t WS_MODS = 1 * MiB;
constexpr size_t WS_POS = 2 * MiB;
constexpr size_t WS_WIN = 10 * MiB;
constexpr size_t WS_WOUT = 17 * MiB;
constexpr size_t WS_RWT = 19 * MiB;
constexpr size_t WS_LTOK = 20 * MiB;
constexpr size_t WS_LP = 28 * MiB;
constexpr size_t WS_TGP = 36 * MiB;
constexpr size_t WS_NST = 37 * MiB;
constexpr size_t WS_U = 40 * MiB;
constexpr size_t WS_Z = 184 * MiB;
constexpr size_t WS_ST = 652 * MiB;
constexpr size_t WS_WGU = 104 * MiB;
constexpr size_t WS_WD = 168 * MiB;
constexpr size_t WS_ACT = 200 * MiB;
constexpr size_t WS_Y = 472 * MiB;
constexpr size_t WS_X1B = 736 * MiB;
constexpr size_t WS_U8 = 652 * MiB;
constexpr size_t WS_WIN8 = 20 * MiB;
constexpr size_t WS_END = 908 * MiB;
constexpr int CW_CNT = 2048;
constexpr int CW_BAR = 8192;

constexpr int RING_BYTES = 131072;
constexpr int LDS_BYTES = 147456;
constexpr int MISC_OFF = LDS_BYTES - 256;
constexpr int TAB_OFF = RING_BYTES;
constexpr int PF_OFF = TAB_OFF + 5120, PF_SLOT = 3072;
constexpr int NWAVES = 8, NTHR = 512;

#define LDS_WAIT() asm volatile("s_waitcnt lgkmcnt(0)" ::: "memory")
#define VM_WAIT() asm volatile("s_waitcnt vmcnt(0)" ::: "memory")
#define BAR_LDS() do { asm volatile("s_waitcnt lgkmcnt(0)" ::: "memory"); __builtin_amdgcn_s_barrier(); asm volatile("" ::: "memory"); } while (0)
__device__ __forceinline__ unsigned f2bf(float f) { unsigned u = __builtin_bit_cast(unsigned, f); return (u + 0x7fffu + ((u >> 16) & 1u)) >> 16; }
__device__ __forceinline__ unsigned pk2(float lo, float hi) { unsigned r; asm("v_cvt_pk_bf16_f32 %0, %1, %2" : "=v"(r) : "v"(lo), "v"(hi)); return r; }
__device__ __forceinline__ float bf2f(unsigned short b) { return __builtin_bit_cast(float, ((unsigned)b) << 16); }
__device__ __forceinline__ float bflo(unsigned w) { return __builtin_bit_cast(float, w << 16); }
__device__ __forceinline__ float bfhi(unsigned w) { return __builtin_bit_cast(float, w & 0xffff0000u); }
__device__ __forceinline__ float fsigmoid(float x) { return __builtin_amdgcn_rcpf(1.0f + __expf(-x)); }
__device__ __forceinline__ float fsilu(float x) { return x * __builtin_amdgcn_rcpf(1.0f + __expf(-x)); }
__device__ __forceinline__ float flogsigmoid(float x) { return fminf(x, 0.f) - log1pf(__expf(-fabsf(x))); }
__device__ __forceinline__ f32x4 ldbf4(const bf16* p) { const u32x2 w = *(const u32x2*)p; return (f32x4){bflo(w.x), bfhi(w.x), bflo(w.y), bfhi(w.y)}; }
__device__ __forceinline__ float wave_sum(float v) {
#pragma unroll
    for (int o = 1; o < 64; o <<= 1) v += __shfl_xor(v, o);
    return v;
}

namespace pg8 {
#define PG8_LAS __attribute__((address_space(3)))
typedef unsigned short bf16_t;
constexpr int BM = 256, BK = 64, HALF = 128, HTB = HALF * BK * 2, STAGE_BYTES = 8 * HTB, NXCD = 8, WGM = 8, GK = 1024;
__host__ __device__ __forceinline__ int lds_byte(int r, int c) { const int st = (r >> 4) * 2 + (c >> 5), rr = r & 15, cc = c & 31, ob = rr * 64 + cc * 2; return st * 1024 + (ob ^ (((ob >> 9) & 1) << 5)); }
__host__ __device__ __forceinline__ void stage_rc(int b, int& R, int& C) { const int st = b / 1024, sb = b % 1024, swz = sb ^ (((sb >> 9) & 1) << 5); R = (st >> 1) * 16 + swz / 64; C = (st & 1) * 32 + (swz % 64) / 2; }
__host__ __device__ __forceinline__ int perm32(int rho) { const int n = rho >> 4, i = rho & 15; return 8 * (i >> 2) + 4 * n + (i & 3); }
__host__ __device__ __forceinline__ int perm32w(int rho) { const int n = rho >> 4, i = rho & 15; return 16 * (i >> 2) + 4 * n + (i & 3); }
__device__ __forceinline__ unsigned cvt_pk_bf16(float lo, float hi) { unsigned r; asm volatile("v_cvt_pk_bf16_f32 %0, %1, %2" : "=v"(r) : "v"(lo), "v"(hi)); return r; }

typedef int i32x8 __attribute__((ext_vector_type(8)));
__device__ __forceinline__ i32x8 cat16(bf16x8 a, bf16x8 b) { typedef int i32x4 __attribute__((ext_vector_type(4))); const i32x4 x = __builtin_bit_cast(i32x4, a), y = __builtin_bit_cast(i32x4, b); return __builtin_shufflevector(x, y, 0, 1, 2, 3, 4, 5, 6, 7); }
__device__ __forceinline__ void mfma_f8(f32x4& acc, const i32x8& a, const i32x8& b, int sc) {
    asm volatile("s_nop 1\n\tv_mfma_scale_f32_16x16x128_f8f6f4 %0, %1, %2, %0, %3, %3 op_sel_hi:[0,0,0]" : "+v"(acc) : "v"(a), "v"(b), "v"(sc));
}
__device__ __forceinline__ void dma16(const void* g, PG8_LAS unsigned char* l) {
    unsigned keep; const unsigned dst = (unsigned)(size_t)l;
    asm volatile("s_mov_b32 %0, m0\n\ts_mov_b32 m0, %2\n\ts_nop 0\n\tglobal_load_lds_dwordx4 %1, off\n\ts_mov_b32 m0, %0" : "=&s"(keep) : "v"(g), "s"(dst) : "memory");
}
struct Unit { int pm, pn, g, r0, slot; };

__device__ __forceinline__ bool order_next(int i, int G, int c, int nM, int nN, int& pm, int& pn) {
    const int nwg = nM * nN; const long L = (long)i * G + c; if (L >= nwg) return false;
    int wgid = (int)L; { const int q = nwg / NXCD, r = nwg % NXCD, xcd = wgid % NXCD, off = wgid / NXCD; wgid = (xcd < r ? xcd * (q + 1) : r * (q + 1) + (xcd - r) * q) + off; }
    const int nig = WGM * nN, gid = wgid / nig, fm = gid * WGM, gsz = (nM - fm) < WGM ? (nM - fm) : WGM;
    pm = fm + ((wgid % nig) % gsz); pn = (wgid % nig) / gsz; return true;
}

template <class Epi, class Prob, bool ALIGN_EPI>
__device__ __forceinline__ void gemm_phase(PG8_LAS unsigned char* lds, const Prob& P, const Epi& E) {
    const int tid = threadIdx.x, wid = __builtin_amdgcn_readfirstlane(tid >> 6), lane = tid & 63, wr = wid >> 2, wc = wid & 3, fr = lane & 15, fq = lane >> 4;
    constexpr bool F8 = Prob::FP8; constexpr bool CM = Epi::CMAP == 1; constexpr int NST = Epi::NST; static_assert(GK / (F8 ? 128 : 64) >= 6, "peeled K loop");
    constexpr int RSB = F8 ? GK : GK * 2, nt = RSB / 128;
    unsigned vB, vA, cA2;
    { int R, C; stage_rc(tid * 16, R, C); const int Rb = CM ? 64 * (R >> 5) + perm32w(R & 31) : Epi::PERM ? ((R & ~31) + perm32(R & 31)) : R; vB = (unsigned)(Rb * RSB + C * 2); vA = (unsigned)(R * RSB + C * 2); cA2 = (unsigned)(C * 2); }
    constexpr size_t kstep = (size_t)(BK * 2);
    constexpr size_t hstep = (size_t)(CM ? 8 : HALF) * RSB;
    const unsigned ldsw = (unsigned)wid * 1024u;
    const int aoff = lds_byte(wr * 64 + fr, fq * 8), boff = lds_byte(wc * 32 + fr, fq * 8);
#define PG8_SA(b, h) (((b) * 2 + (h)) * HTB)
#define PG8_SB(b, h) ((4 + (b) * 2 + (h)) * HTB)
#define PG8_STAGE_B(bufoff, gbase) do { _Pragma("unroll") for (int _i = 0; _i < 2; ++_i) \
        __builtin_amdgcn_global_load_lds((const unsigned*)((const char*)(gbase) + (size_t)(_i * (CM ? 128 : 64) * RSB) + vB), (PG8_LAS unsigned*)(lds + (bufoff) + ldsw + _i * 8192), 16, 0, 0); } while (0)
#define PG8_STAGE_A(bufoff, abase, tk, h) do { _Pragma("unroll") for (int _i = 0; _i < 2; ++_i) { \
        if constexpr (GATH) { const unsigned _t = _i ? ((tk)[h] >> 16) : ((tk)[h] & 0xffffu); \
            __builtin_amdgcn_global_load_lds((const unsigned*)((abase) + (size_t)(_t * (unsigned)RSB + cA2)), (PG8_LAS unsigned*)(lds + (bufoff) + ldsw + _i * 8192), 16, 0, 0); } \
        else __builtin_amdgcn_global_load_lds((const unsigned*)((abase) + (size_t)(((h) * 128 + _i * 64) * RSB) + vA), (PG8_LAS unsigned*)(lds + (bufoff) + ldsw + _i * 8192), 16, 0, 0); } } while (0)
#define PG8_LDA(dst, b, h) do { _Pragma("unroll") for (int m = 0; m < 4; ++m) _Pragma("unroll") for (int k = 0; k < 2; ++k) dst[m][k] = *(const PG8_LAS bf16x8*)(lds + PG8_SA(b, h) + aoff + m * 2048 + k * 1024); } while (0)
#define PG8_LDB(dst, b, h) do { _Pragma("unroll") for (int n = 0; n < 2; ++n) _Pragma("unroll") for (int k = 0; k < 2; ++k) dst[n][k] = *(const PG8_LAS bf16x8*)(lds + PG8_SB(b, h) + boff + n * 2048 + k * 1024); } while (0)
#define PG8_MMA(ai, bj, At, Bt) do { __builtin_amdgcn_s_setprio(1); _Pragma("unroll") for (int m = 0; m < 4; ++m) _Pragma("unroll") for (int n = 0; n < 2; ++n) { \
        if constexpr (F8) { mfma_f8(acc[ai][bj][m][n], cat16(Bt[n][0], Bt[n][1]), cat16(At[m][0], At[m][1]), sc127); } \
        else { _Pragma("unroll") for (int k = 0; k < 2; ++k) acc[ai][bj][m][n] = __builtin_amdgcn_mfma_f32_16x16x32_bf16(Bt[n][k], At[m][k], acc[ai][bj][m][n], 0, 0, 0); } } \
        __builtin_amdgcn_s_setprio(0); } while (0)
#define PG8_WAIT_V(n) asm volatile("s_waitcnt vmcnt(" #n ")" ::: "memory")
#define PG8_WAIT_VN(n) asm volatile("s_waitcnt vmcnt(%0)" :: "n"(n) : "memory")
#define PG8_WAIT_L(n) asm volatile("s_waitcnt lgkmcnt(" #n ")" ::: "memory")
#define PG8_BAR __builtin_amdgcn_s_barrier()
#define PG8_SCHED __builtin_amdgcn_sched_barrier(0)
    Unit cur, nxt; int ui = 0;
    if (!P.next(0, cur)) return;
    f32x4 acc[2][2][4][2];
#pragma unroll
    for (int a = 0; a < 2; ++a)
#pragma unroll
        for (int b = 0; b < 2; ++b)
#pragma unroll
            for (int m = 0; m < 4; ++m)
#pragma unroll
                for (int n = 0; n < 2; ++n) acc[a][b][m][n] = (f32x4){0.f, 0.f, 0.f, 0.f};
    bf16x8 At[4][2], B0[2][2], B1[2][2];
    constexpr bool GATH = Prob::GATHERS;
    int sc127 = 127; asm volatile("" : "+v"(sc127));
    unsigned tc[2] = {0u, 0u}, tn[2] = {0u, 0u};
    constexpr bool PF = Prob::PREFETCH;
    cur.slot = 0;
    if constexpr (PF) { P.pf_issue(cur, 0, wid, lane, lds); PG8_WAIT_V(0); PG8_BAR; asm volatile("" ::: "memory"); }
    if constexpr (GATH) P.a_tok(cur, tid, tc, lds);
    const char* cA = P.a_ptr(cur);
    const char* cB = P.b_ptr(cur);
    PG8_STAGE_B(PG8_SB(0, 0), cB); PG8_STAGE_B(PG8_SB(0, 1), cB + hstep); PG8_STAGE_A(PG8_SA(0, 0), cA, tc, 0); PG8_STAGE_A(PG8_SA(0, 1), cA, tc, 1);
    if (wr == 1) PG8_BAR;
    PG8_WAIT_V(2); PG8_BAR;
    PG8_STAGE_B(PG8_SB(1, 0), cB + kstep); PG8_STAGE_A(PG8_SA(1, 0), cA + kstep, tc, 0); PG8_STAGE_B(PG8_SB(1, 1), cB + hstep + kstep); PG8_STAGE_A(PG8_SA(1, 1), cA + kstep, tc, 1);
    PG8_WAIT_V(0); PG8_BAR;
    bool relax = false;
    for (;;) {
        const bool has_next = P.next(ui + 1, nxt);
        const char* nB = cB; const char* nA = cA;
        nxt.slot = (ui + 1) % 3;
        if (has_next) { if constexpr (PF) P.pf_issue(nxt, nxt.slot, wid, lane, lds); nA = P.a_ptr(nxt); nB = P.b_ptr(nxt); }
        tn[0] = tc[0]; tn[1] = tc[1];
        {
            const char* a2 = cA + (size_t)2 * kstep; const char* a3 = a2 + kstep; const char* b2 = cB + (size_t)2 * kstep; const char* b3 = b2 + kstep;
            PG8_LDB(B0, 0, 0); PG8_LDB(B1, 0, 1); PG8_SCHED; PG8_LDA(At, 0, 0);
            if (relax) PG8_WAIT_VN(8 + NST); else PG8_WAIT_V(8);
            PG8_WAIT_L(0); PG8_BAR; PG8_MMA(0, 0, At, B0); PG8_MMA(0, 1, At, B1); PG8_BAR; PG8_SCHED;
            PG8_LDA(At, 0, 1); PG8_STAGE_B(PG8_SB(0, 0), b2); PG8_STAGE_B(PG8_SB(0, 1), b2 + hstep); PG8_STAGE_A(PG8_SA(0, 0), a2, tc, 0);
            if (relax) PG8_WAIT_VN(8 + NST); else PG8_WAIT_V(8);
            PG8_WAIT_L(0); PG8_BAR; PG8_MMA(1, 0, At, B0); PG8_MMA(1, 1, At, B1); PG8_BAR; PG8_SCHED;
            PG8_LDB(B0, 1, 0); PG8_LDB(B1, 1, 1); PG8_SCHED; PG8_LDA(At, 1, 0); PG8_STAGE_A(PG8_SA(0, 1), a2, tc, 1);
            if (relax) PG8_WAIT_VN(8 + NST); else PG8_WAIT_V(8);
            PG8_WAIT_L(0); PG8_BAR; PG8_MMA(0, 0, At, B0); PG8_MMA(0, 1, At, B1); PG8_BAR; PG8_SCHED;
            PG8_LDA(At, 1, 1); PG8_STAGE_B(PG8_SB(1, 0), b3); PG8_STAGE_B(PG8_SB(1, 1), b3 + hstep); PG8_STAGE_A(PG8_SA(1, 0), a3, tc, 0);
            if (relax) PG8_WAIT_VN(8); else PG8_WAIT_V(8);
            PG8_WAIT_L(0); PG8_BAR; PG8_MMA(1, 0, At, B0); PG8_MMA(1, 1, At, B1); PG8_BAR; PG8_SCHED;
        }
#pragma unroll 1
        for (int t = 2; t < nt; t += 2) {
            const bool last = (t == nt - 2);
            if constexpr (GATH) { if (t == nt - 4 && has_next) P.a_tok(nxt, tid, tn, lds); }
            const char* a1 = cA + (size_t)(t + 1) * kstep;
            const char* a2 = last ? nA : cA + (size_t)(t + 2) * kstep; const char* a3 = a2 + kstep;
            const char* b2 = last ? nB : cB + (size_t)(t + 2) * kstep; const char* b3 = b2 + kstep;
            PG8_LDB(B0, 0, 0); PG8_LDB(B1, 0, 1); PG8_SCHED; PG8_LDA(At, 0, 0); PG8_STAGE_A(PG8_SA(1, 1), a1, tc, 1);
            PG8_WAIT_V(8); PG8_WAIT_L(0); PG8_BAR; PG8_MMA(0, 0, At, B0); PG8_MMA(0, 1, At, B1); PG8_BAR; PG8_SCHED;
            PG8_LDA(At, 0, 1); PG8_STAGE_B(PG8_SB(0, 0), b2); PG8_STAGE_B(PG8_SB(0, 1), b2 + hstep); { unsigned t2[2] = {last ? tn[0] : tc[0], last ? tn[1] : tc[1]}; PG8_STAGE_A(PG8_SA(0, 0), a2, t2, 0); }
            PG8_WAIT_V(8); PG8_WAIT_L(0); PG8_BAR; PG8_MMA(1, 0, At, B0); PG8_MMA(1, 1, At, B1); PG8_BAR; PG8_SCHED;
            PG8_LDB(B0, 1, 0); PG8_LDB(B1, 1, 1); PG8_SCHED; PG8_LDA(At, 1, 0); { unsigned t2[2] = {last ? tn[0] : tc[0], last ? tn[1] : tc[1]}; PG8_STAGE_A(PG8_SA(0, 1), a2, t2, 1); }
            PG8_WAIT_V(8); PG8_WAIT_L(0); PG8_BAR; PG8_MMA(0, 0, At, B0); PG8_MMA(0, 1, At, B1); PG8_BAR; PG8_SCHED;
            PG8_LDA(At, 1, 1); PG8_STAGE_B(PG8_SB(1, 0), b3); PG8_STAGE_B(PG8_SB(1, 1), b3 + hstep); { unsigned t2[2] = {last ? tn[0] : tc[0], last ? tn[1] : tc[1]}; PG8_STAGE_A(PG8_SA(1, 0), a3, t2, 0); }
            PG8_WAIT_V(8); PG8_WAIT_L(0); PG8_BAR; PG8_MMA(1, 0, At, B0); PG8_MMA(1, 1, At, B1); PG8_BAR; PG8_SCHED;
        }
        PG8_STAGE_A(PG8_SA(1, 1), nA + kstep, tn, 1);
        if constexpr (ALIGN_EPI) { if (wr == 0) PG8_BAR; }
        E(acc, cur, wr, wc, fr, fq);
        if (!has_next) break;
        relax = NST > 0 && E.full(cur, wc);
#pragma unroll
        for (int a = 0; a < 2; ++a)
#pragma unroll
            for (int b = 0; b < 2; ++b)
#pragma unroll
                for (int m = 0; m < 4; ++m)
#pragma unroll
                    for (int n = 0; n < 2; ++n) acc[a][b][m][n] = (f32x4){0.f, 0.f, 0.f, 0.f};
        cur = nxt; cB = nB; cA = nA; ++ui; tc[0] = tn[0]; tc[1] = tn[1];
        if constexpr (ALIGN_EPI) { if (wr == 1) PG8_BAR; }
    }
    PG8_WAIT_V(0);
    if constexpr (!ALIGN_EPI) { if (wr == 0) PG8_BAR; }
    PG8_BAR;
#undef PG8_SA
#undef PG8_SB
#undef PG8_STAGE_A
#undef PG8_STAGE_B
#undef PG8_LDA
#undef PG8_LDB
#undef PG8_MMA
#undef PG8_WAIT_V
#undef PG8_WAIT_VN
#undef PG8_WAIT_L
#undef PG8_BAR
#undef PG8_SCHED
}
}

#define XB_TMO      128
#define XB_XCNT(j)  (256  + 64 * (j))
#define XB_XSUB(j)  (1280 + 64 * (j))
#define XB_XGEN(j)  (2304 + 64 * (j))
#define XB_TOP      3328
#define XB_TOPGEN   3392
#define XCD_BAR_WORDS 3456
#define XB_SPIN_CAP (1u << 18)
__device__ __forceinline__ unsigned xb_ld(unsigned* p)              { return __hip_atomic_load(p, __ATOMIC_RELAXED, __HIP_MEMORY_SCOPE_AGENT); }
__device__ __forceinline__ unsigned xb_add(unsigned* p, unsigned v) { return __hip_atomic_fetch_add(p, v, __ATOMIC_RELAXED, __HIP_MEMORY_SCOPE_AGENT); }
__device__ __forceinline__ unsigned xb_xcc_id() { return (unsigned)__builtin_amdgcn_s_getreg((3 << 11) | 20) & 0xFu; }
#define XB_SPIN(cond, bar) do { unsigned _sp = 0; while (cond) { __builtin_amdgcn_s_sleep(1); \
    if ((++_sp & 255u) == 0u) { if (xb_ld(&(bar)[XB_TMO])) break; if (_sp > XB_SPIN_CAP) { atomicAdd(&(bar)[XB_TMO], 1u); break; } } } } while (0)
struct XcdBarrier { unsigned* bar; unsigned x; volatile LAS unsigned* st; };
__device__ __forceinline__ XcdBarrier xcd_barrier_post(unsigned* bar, volatile LAS unsigned* st) {
    XcdBarrier b; b.bar = bar; b.x = xb_xcc_id(); b.st = st;
    if (threadIdx.x == 0) (void)xb_add(&bar[XB_XCNT(b.x)], 1u);
    return b;
}
__device__ __forceinline__ void xcd_barrier_complete(unsigned* bar, unsigned x, unsigned& nloc, unsigned& nx) {
    const unsigned G = gridDim.x * gridDim.y * gridDim.z;
    unsigned sum, cnt, mine, sp = 0u;
    for (;;) {
        sum = 0u; cnt = 0u; mine = 0u;
#pragma unroll
        for (unsigned j = 0; j < 16; ++j) { const unsigned c = xb_ld(&bar[XB_XCNT(j)]); sum += c; cnt += (c > 0u) ? 1u : 0u; mine = (j == x) ? c : mine; }
        if (sum == G) break;
        __builtin_amdgcn_s_sleep(1);
        if ((++sp & 255u) == 0u) { if (xb_ld(&bar[XB_TMO])) break; if (sp > XB_SPIN_CAP) { atomicAdd(&bar[XB_TMO], 1u); break; } }
    }
    nloc = mine > 0u ? mine : 1u; nx = cnt > 0u ? cnt : 1u;
}
__device__ __forceinline__ void xcd_barrier(const XcdBarrier& b) {
    asm volatile("s_waitcnt vmcnt(0)" ::: "memory");
    __syncthreads();
    if (threadIdx.x == 0) {
        unsigned* bar = b.bar;
        __builtin_amdgcn_s_waitcnt(0);
        unsigned nloc = b.st[0], nx = b.st[1];
        if (nloc == 0u) { xcd_barrier_complete(bar, b.x, nloc, nx); b.st[0] = nloc; b.st[1] = nx; }
        const unsigned old = xb_add(&bar[XB_XSUB(b.x)], 1u);
        const unsigned gen = old / nloc;
        if (old + 1u == (gen + 1u) * nloc) {
            __builtin_amdgcn_fence(__ATOMIC_RELEASE, "agent");
            asm volatile("s_waitcnt vmcnt(0)" ::: "memory");
            const unsigned og = xb_add(&bar[XB_TOP], 1u);
            const unsigned tg = og / nx;
            if (og + 1u == (tg + 1u) * nx) xb_add(&bar[XB_TOPGEN], 1u);
            else XB_SPIN(xb_ld(&bar[XB_TOPGEN]) == tg, bar);
            __builtin_amdgcn_fence(__ATOMIC_ACQUIRE, "agent");
            xb_add(&bar[XB_XGEN(b.x)], 1u);
            asm volatile("s_waitcnt vmcnt(0)" ::: "memory");
        } else {
            XB_SPIN(xb_ld(&bar[XB_XGEN(b.x)]) == gen, bar);
            __builtin_amdgcn_fence(__ATOMIC_ACQUIRE, "agent");
            asm volatile("s_waitcnt vmcnt(0)" ::: "memory");
        }
    }
    __syncthreads();
}

namespace pg8 {
struct ProbDense {
    static constexpr bool FP8 = false, GATHERS = false, PREFETCH = false; const char* A; const char* Bt; int nM, nN, G, c;
    __device__ __forceinline__ bool next(int i, Unit& u) const { u.g = 0; u.r0 = 0; return order_next(i, G, c, nM, nN, u.pm, u.pn); }
    __device__ __forceinline__ const char* a_ptr(const Unit& u) const { return A + (size_t)u.pm * (256 * 2048); }
    __device__ __forceinline__ void a_tok(const Unit&, int, unsigned (&)[2], PG8_LAS unsigned char*) const {}
    __device__ __forceinline__ const char* b_ptr(const Unit& u) const { return Bt + (size_t)u.pn * (256 * 2048); }
};
struct ProbIn {
    static constexpr bool FP8 = false, GATHERS = false, PREFETCH = false; const char* A; const char* Bt; int G, c;
    __device__ __forceinline__ bool next(int i, Unit& u) const { u.g = 0; u.r0 = 0;
        const int L = i * G + c;
        if (L < 256 * 13) return order_next(i, G, c, 256, 13, u.pm, u.pn);
        const int L2 = L - 256 * 13; if (L2 >= 32 * 7) return false;
        const int k = L2 % 7; u.pm = 256 + L2 / 7; u.pn = k < 3 ? k + 1 : k < 6 ? k + 4 : 12; return true; }
    __device__ __forceinline__ const char* a_ptr(const Unit& u) const { return A + (size_t)u.pm * (256 * 2048); }
    __device__ __forceinline__ void a_tok(const Unit&, int, unsigned (&)[2], PG8_LAS unsigned char*) const {}
    __device__ __forceinline__ const char* b_ptr(const Unit& u) const { return Bt + (size_t)u.pn * (256 * 2048); }
};
template <bool F8> struct ProbIn2 {
    static constexpr bool FP8 = F8, GATHERS = false, PREFETCH = false; const char* A; const char* Bt; int G, c;
    static constexpr int NT = F8 ? 8 : 5, NC = F8 ? 4 : 3, RS = F8 ? 1024 : 2048;
    __device__ __forceinline__ bool next(int i, Unit& u) const { u.g = 0; u.r0 = 0;
        const int L = i * G + c; int k;
        if (L < 256 * NT) { if (!order_next(i, G, c, 256, NT, u.pm, k)) return false; u.pn = F8 ? (k < 4 ? 2 + k : 4 + k) : (k < 2 ? k : k < 4 ? k + 4 : 12); return true; }
        const int L2 = L - 256 * NT; if (L2 >= 32 * NC) return false;
        k = L2 % NC; u.pm = 256 + L2 / NC; u.pn = F8 ? (k < 2 ? 2 + k : 6 + k) : (k == 0 ? 1 : k == 1 ? 7 : 12); return true; }
    __device__ __forceinline__ const char* a_ptr(const Unit& u) const { return A + (size_t)u.pm * (256 * RS); }
    __device__ __forceinline__ void a_tok(const Unit&, int, unsigned (&)[2], PG8_LAS unsigned char*) const {}
    __device__ __forceinline__ const char* b_ptr(const Unit& u) const { return Bt + (size_t)u.pn * (256 * RS); }
};
template <bool GATHER> struct ProbMoe {
    static constexpr bool FP8 = true, GATHERS = GATHER, PREFETCH = true;
    const char* A; const char* W; const int* ltok; const LAS int* tab; const LAS int* cnts; int nM, nN, G, c; size_t wstride; const float* bias; const float* lp;
    __device__ __forceinline__ bool next(int i, Unit& u) const {
        if (!order_next(i, G, c, nM, nN, u.pm, u.pn)) return false;
        const int e = tab[u.pm]; u.g = e >> 16; u.r0 = (e & 0xffff) * 256; return true;
    }
    __device__ __forceinline__ const char* a_ptr(const Unit& u) const { return GATHER ? A : A + (size_t)u.pm * (256 * 1024); }
    __device__ __forceinline__ void pf_issue(const Unit& u, int slot, int wid, int lane, PG8_LAS unsigned char* lds) const {
        PG8_LAS unsigned char* sl = lds + PF_OFF + slot * PF_SLOT;
        if (GATHER && wid == 0) dma16(ltok + (size_t)u.g * LCAP + u.r0 + 4 * lane, sl);
        if (wid == 1) { const float* src = GATHER ? bias + (size_t)(u.g & 31) * 2048 + (lane >> 5) * 1024 + u.pn * 128 + (lane & 31) * 4 : bias + (size_t)(u.g & 31) * 1024 + u.pn * 256 + lane * 4; dma16(src, sl + 1024); }
        if (!GATHER && wid == 2) dma16(lp + (size_t)u.g * LCAP + u.r0 + 4 * lane, sl + 2048);
    }
    __device__ __forceinline__ void a_tok(const Unit& u, int tid, unsigned (&tk)[2], PG8_LAS unsigned char* lds) const {
        if constexpr (GATHER) {
            int R, C; stage_rc(tid * 16, R, C); (void)C; const int cnt = cnts[u.g]; const PG8_LAS int* T = (const PG8_LAS int*)(lds + PF_OFF + u.slot * PF_SLOT);
#pragma unroll
            for (int h = 0; h < 2; ++h) { unsigned t[2];
#pragma unroll
                for (int i = 0; i < 2; ++i) { const int row = h * 128 + i * 64 + R; const int tok = T[row]; t[i] = (u.r0 + row < cnt) ? (unsigned)tok : 0u; }
                tk[h] = t[0] | (t[1] << 16); }
        }
    }
    __device__ __forceinline__ const char* b_ptr(const Unit& u) const { return W + (size_t)(u.g & 31) * wstride + (size_t)u.pn * (256 * 1024); }
};

struct EpiZ {
    static constexpr bool PERM = true; static constexpr int CMAP = 0, NST = 16; bf16_t* O; float sc;
    __device__ __forceinline__ bool full(const Unit& u, int) const { return u.pn != 12; }
    __device__ __forceinline__ void operator()(const f32x4 (&acc)[2][2][4][2], const Unit& u, int wr, int wc, int fr, int fq) const {
        const int row0 = u.pm * BM + wr * 64 + fr, pn = u.pn;
        int kind, f, hb;
        if (pn == 0) { kind = 0; f = F_MLQ; hb = 0; } else if (pn == 1) { kind = 0; f = F_MLK; hb = 0; } else if (pn == 6) { kind = 0; f = F_GQ; hb = 0; } else if (pn == 7) { kind = 0; f = F_GK; hb = 0; }
        else if (pn < 4) { kind = 1; f = F_MLV; hb = 2 * (pn - 2); } else if (pn < 6) { kind = 1; f = F_MLO; hb = 2 * (pn - 4); } else if (pn < 10) { kind = 1; f = F_GV; hb = 2 * (pn - 8); }
        else if (pn < 12) { kind = 1; f = F_GG; hb = 2 * (pn - 10); } else { kind = 2; f = 0; hb = 0; }
#pragma unroll
        for (int bj = 0; bj < 2; ++bj) {
            bf16_t* base; int pitch; bool ok = true;
            if (kind == 0) { base = O + plane64(f, 2 * bj + (wc >> 1)) + (wc & 1) * 32 + 8 * fq; pitch = 64; }
            else if (kind == 1) { base = O + plane128(f, hb + bj) + wc * 32 + 8 * fq; pitch = 128; }
            else { base = O + Z_MISC + wc * 32 + 8 * fq; pitch = 64; ok = (bj == 0) && (wc < 2); }
            if (ok) {
#pragma unroll
                for (int ai = 0; ai < 2; ++ai)
#pragma unroll
                    for (int m = 0; m < 4; ++m) { const f32x4 v0 = acc[ai][bj][m][0] * sc, v1 = acc[ai][bj][m][1] * sc;
                        u32x4 w; w.x = cvt_pk_bf16(v0[0], v0[1]); w.y = cvt_pk_bf16(v0[2], v0[3]); w.z = cvt_pk_bf16(v1[0], v1[1]); w.w = cvt_pk_bf16(v1[2], v1[3]);
                        *(u32x4*)(base + (size_t)(row0 + ai * HALF + m * 16) * pitch) = w; } }
        }
    }
};
struct EpiX1 {
    static constexpr bool PERM = true; static constexpr int CMAP = 0, NST = 16; const float* x; const float* pos; const float* mods; bf16_t* O;
    __device__ __forceinline__ bool full(const Unit&, int) const { return true; }
    __device__ __forceinline__ void operator()(const f32x4 (&acc)[2][2][4][2], const Unit& u, int wr, int wc, int fr, int fq) const {
        const int row0 = u.pm * BM + wr * 64 + fr, col0 = u.pn * BM + wc * 32 + 8 * fq;
        const int b = (u.pm * BM) >> 11;
        const float* g1 = mods + (size_t)b * 6144 + 2 * 1024 + col0;
        f32x4 gv[2][2];
#pragma unroll
        for (int bj = 0; bj < 2; ++bj)
#pragma unroll
            for (int n = 0; n < 2; ++n) gv[bj][n] = *(const f32x4*)(g1 + bj * HALF + 4 * n);
#pragma unroll
        for (int ai = 0; ai < 2; ++ai)
#pragma unroll
            for (int m = 0; m < 4; ++m) { const int row = row0 + ai * HALF + m * 16; const size_t off = (size_t)row * D + col0; const float* pp = pos + (size_t)(row & (T - 1)) * D + col0;
#pragma unroll
                for (int bj = 0; bj < 2; ++bj) { f32x4 r[2];
#pragma unroll
                    for (int n = 0; n < 2; ++n) { const f32x4 xv = *(const f32x4*)(x + off + bj * HALF + 4 * n); const f32x4 pv = *(const f32x4*)(pp + bj * HALF + 4 * n); r[n] = xv + pv + gv[bj][n] * acc[ai][bj][m][n]; }
                    u32x4 w; w.x = cvt_pk_bf16(r[0][0], r[0][1]); w.y = cvt_pk_bf16(r[0][2], r[0][3]); w.z = cvt_pk_bf16(r[1][0], r[1][1]); w.w = cvt_pk_bf16(r[1][2], r[1][3]);
                    *(u32x4*)(O + off + bj * HALF) = w; }
                if (m & 1) asm volatile("" ::: "memory"); }
    }
};
__device__ __forceinline__ unsigned pk4_fp8(float a, float b, float c, float d) { int w = 0; w = __builtin_amdgcn_cvt_pk_fp8_f32(a, b, w, false); w = __builtin_amdgcn_cvt_pk_fp8_f32(c, d, w, true); return (unsigned)w; }
constexpr float WSC = 32.0f, WSCI = 1.0f / 32.0f;
struct EpiGU {
    static constexpr bool PERM = true; static constexpr int CMAP = 0, NST = 8; unsigned char* O; PG8_LAS unsigned char* pf;
    __device__ __forceinline__ bool full(const Unit&, int) const { return true; }
    __device__ __forceinline__ void operator()(const f32x4 (&acc)[2][2][4][2], const Unit& u, int wr, int wc, int fr, int fq) const {
        const int row0 = u.pm * BM + wr * 64 + fr, j0 = u.pn * HALF + wc * 32 + 8 * fq;
        const PG8_LAS float* bg = (const PG8_LAS float*)(pf + u.slot * PF_SLOT + 1024) + wc * 32 + 8 * fq;
        f32x4 bgv[2], buv[2];
#pragma unroll
        for (int n = 0; n < 2; ++n) { bgv[n] = *(const PG8_LAS f32x4*)(bg + 4 * n); buv[n] = *(const PG8_LAS f32x4*)(bg + 128 + 4 * n) + 1.0f; }
        typedef float f32x2 __attribute__((ext_vector_type(2)));
        constexpr float NC = -1.702f * 1.44269504088896f;
#pragma unroll
        for (int ai = 0; ai < 2; ++ai)
#pragma unroll
            for (int m = 0; m < 4; ++m) { unsigned char* rowp = O + (size_t)(row0 + ai * HALF + m * 16) * DE + j0; float r[8];
#pragma unroll
                for (int n = 0; n < 2; ++n) { const f32x4 gt = acc[ai][0][m][n] * WSCI + bgv[n], up = acc[ai][1][m][n] * WSCI + buv[n];
#pragma unroll
                    for (int i = 0; i < 4; i += 2) { const f32x2 g = {fminf(gt[i], 7.0f), fminf(gt[i + 1], 7.0f)}, uu = {fminf(fmaxf(up[i], -6.0f), 8.0f), fminf(fmaxf(up[i + 1], -6.0f), 8.0f)};
                        const f32x2 t = g * NC; const f32x2 d = (f32x2){__builtin_amdgcn_exp2f(t[0]), __builtin_amdgcn_exp2f(t[1])} + 1.0f;
                        const f32x2 rc = {__builtin_amdgcn_rcpf(d[0]), __builtin_amdgcn_rcpf(d[1])}; const f32x2 o = (g * uu) * rc; r[4 * n + i] = o[0]; r[4 * n + i + 1] = o[1]; } }
                u32x2 w; w.x = pk4_fp8(r[0], r[1], r[2], r[3]); w.y = pk4_fp8(r[4], r[5], r[6], r[7]);
                *(u32x2*)rowp = w; }
    }
};
constexpr float YSC = 16.0f, YSCI = 1.0f / 16.0f;
#ifndef YST_NT
#define YST_NT 0
#endif
#if YST_NT
#define YST(p_, w_) __builtin_nontemporal_store((w_), (u32x4*)(p_))
#else
#define YST(p_, w_) (*(u32x4*)(p_) = (w_))
#endif
struct EpiDown {
    static constexpr bool PERM = true; static constexpr int CMAP = 1, NST = 8; unsigned char* O; PG8_LAS unsigned char* pf; const LAS int* cnts;
    __device__ __forceinline__ bool full(const Unit&, int) const { return true; }
    __device__ __forceinline__ void operator()(const f32x4 (&acc)[2][2][4][2], const Unit& u, int wr, int wc, int fr, int fq) const {
        const int row0 = u.pm * BM + wr * 64 + fr, col0 = u.pn * BM + wc * 64 + 16 * fq;
        const PG8_LAS float* bb = (const PG8_LAS float*)(pf + u.slot * PF_SLOT + 1024) + wc * 64 + 16 * fq; const PG8_LAS float* lpl = (const PG8_LAS float*)(pf + u.slot * PF_SLOT + 2048); const int cnt = cnts[u.g];
        f32x4 bv[2][2]; float pv[2][4];
#pragma unroll
        for (int ai = 0; ai < 2; ++ai)
#pragma unroll
            for (int m = 0; m < 4; ++m) pv[ai][m] = lpl[wr * 64 + fr + ai * HALF + m * 16];
#pragma unroll
        for (int bj = 0; bj < 2; ++bj)
#pragma unroll
            for (int n = 0; n < 2; ++n) bv[bj][n] = *(const PG8_LAS f32x4*)(bb + bj * 8 + 4 * n);
#pragma unroll
        for (int ai = 0; ai < 2; ++ai)
#pragma unroll
            for (int m = 0; m < 4; ++m) { const int rt = wr * 64 + fr + ai * HALF + m * 16; const float p = (u.r0 + rt < cnt) ? pv[ai][m] * YSC : 0.f;
                unsigned char* rowp = O + (size_t)(row0 + ai * HALF + m * 16) * D + col0; u32x4 w;
#pragma unroll
                for (int bj = 0; bj < 2; ++bj) { const f32x4 v0 = (acc[ai][bj][m][0] * WSCI + bv[bj][0]) * p, v1 = (acc[ai][bj][m][1] * WSCI + bv[bj][1]) * p;
                    w[2 * bj] = pk4_fp8(v0[0], v0[1], v0[2], v0[3]); w[2 * bj + 1] = pk4_fp8(v1[0], v1[1], v1[2], v1[3]); }
                YST(rowp, w); }
    }
};
}

struct Args { const float* in[24]; float* out; unsigned char* ws; int ph_lo, ph_hi, li, pad; };
enum { I_X = 0, I_C, I_CTX, I_CCTX, I_ADAW, I_ADAB, I_N1G, I_WIN, I_CONVW, I_CONVB, I_MLGB, I_MLNG, I_GW2, I_GGB, I_GNG, I_WOUT, I_N2G, I_RW, I_RB, I_WGU, I_BGU, I_WD, I_BD, I_FNG };

__device__ __forceinline__ void transpose_item(const float* W, int N, bf16* WT, int k0, int n0, int orow0, LAS float* scr, int lane, int orow1 = -1) {
    if (orow1 < 0) orow1 = orow0 + 16;
    const int n = n0 + (lane & 31);
#pragma unroll 8
    for (int i = 0; i < 32; ++i) { const int kk = 2 * i + (lane >> 5); float v = 0.f; if (n < N) v = W[(size_t)(k0 + kk) * N + n]; scr[kk * 33 + (lane & 31)] = v; }
    LDS_WAIT(); asm volatile("" ::: "memory");
    const int c = lane & 7;
#pragma unroll
    for (int j = 0; j < 4; ++j) { const int nn = (lane >> 3) + 8 * j; const LAS float* s = scr + (8 * c) * 33 + nn;
        u32x4 o; o.x = pk2(s[0 * 33], s[1 * 33]); o.y = pk2(s[2 * 33], s[3 * 33]); o.z = pk2(s[4 * 33], s[5 * 33]); o.w = pk2(s[6 * 33], s[7 * 33]);
        *(u32x4*)(WT + (size_t)(nn < 16 ? orow0 + nn : orow1 + nn - 16) * 1024 + k0 + 8 * c) = o; }
    LDS_WAIT(); asm volatile("" ::: "memory");
}

__device__ __forceinline__ void transpose_item_f8(const float* W, int N, unsigned char* WT, int k0, int n0, int orow0, float sc, LAS float* scr, int lane) {
    const int n = n0 + (lane & 31);
#pragma unroll 8
    for (int i = 0; i < 32; ++i) { const int kk = 2 * i + (lane >> 5); float v = 0.f; if (n < N) v = W[(size_t)(k0 + kk) * N + n]; scr[kk * 33 + (lane & 31)] = v * sc; }
    LDS_WAIT(); asm volatile("" ::: "memory");
    const int c = lane & 7;
#pragma unroll
    for (int j = 0; j < 4; ++j) { const int nn = (lane >> 3) + 8 * j; const LAS float* s = scr + (8 * c) * 33 + nn;
        u32x2 o; o.x = pg8::pk4_fp8(s[0 * 33], s[1 * 33], s[2 * 33], s[3 * 33]); o.y = pg8::pk4_fp8(s[4 * 33], s[5 * 33], s[6 * 33], s[7 * 33]);
        *(u32x2*)(WT + (size_t)(orow0 + nn) * 1024 + k0 + 8 * c) = o; }
    LDS_WAIT(); asm volatile("" ::: "memory");
}

__host__ __device__ constexpr int zperm(int n) { return n < 1536 ? n : n < 1552 ? 3072 + (n - 1536) : n < 3088 ? n - 16 : n; }
__device__ __forceinline__ void p0_prologue(const Args& a, LAS unsigned char* lds, int vcu, int G) {
    const int tid = threadIdx.x, lane = tid & 63, wave = __builtin_amdgcn_readfirstlane(tid >> 6);
    unsigned char* ws = a.ws;
    {
        float* mods = (float*)(ws + WS_MODS);
        const float* c = a.in[I_C]; const float* cc = a.in[I_CCTX]; const float* aw = a.in[I_ADAW]; const float* ab = a.in[I_ADAB];
        LAS float* sl = (LAS float*)lds + wave * 4224;
        for (int item = vcu; item < 96; item += G) {
            const int n0 = item * 64;
            for (int idx = lane; idx < 33 * 128; idx += 64) { const int r = idx >> 7, kk = idx & 127, k = 128 * wave + kk; const float cv = r < 32 ? c[r * 1024 + k] : cc[k]; sl[idx] = fsilu(cv); }
            LDS_WAIT(); asm volatile("" ::: "memory");
            float acc[33];
#pragma unroll
            for (int r = 0; r < 33; ++r) acc[r] = 0.f;
            const float* wp = aw + (size_t)(128 * wave) * 6144 + n0 + lane;
            for (int kk = 0; kk < 128; kk += 4) {
                const float w0 = wp[(size_t)(kk + 0) * 6144], w1 = wp[(size_t)(kk + 1) * 6144], w2 = wp[(size_t)(kk + 2) * 6144], w3 = wp[(size_t)(kk + 3) * 6144];
#pragma unroll
                for (int r = 0; r < 33; ++r) { const f32x4 s = *(const LAS f32x4*)(sl + r * 128 + kk); acc[r] += s[0] * w0 + s[1] * w1 + s[2] * w2 + s[3] * w3; }
            }
            __syncthreads();
            LAS float* red = (LAS float*)lds;
#pragma unroll
            for (int r = 0; r < 33; ++r) red[(wave * 33 + r) * 64 + lane] = acc[r];
            __syncthreads();
            for (int idx = tid; idx < 33 * 64; idx += NTHR) { const int r = idx >> 6, l = idx & 63; float s = ab[n0 + l];
#pragma unroll
                for (int w = 0; w < 8; ++w) s += red[(w * 33 + r) * 64 + l];
                mods[(size_t)r * 6144 + n0 + l] = s; }
            __syncthreads();
        }
    }
    const int gw = vcu * NWAVES + wave, NGW = G * NWAVES;
    {
        float* pos = (float*)(ws + WS_POS);
        for (int t = gw; t < T; t += NGW) { const float rr = (float)(t >> 6), cl = (float)(t & 63);
#pragma unroll
            for (int j = 0; j < 16; ++j) { const int d = lane + 64 * j; const int q = d >> 8, i = d & 255;
                const float om = exp2f(-13.287712379549449f * (float)i * (1.0f / 256.0f));
                const float ang = ((q < 2) ? rr : cl) * om * 0.15915494309189535f;
                const float v = (q & 1) ? __builtin_amdgcn_cosf(ang) : __builtin_amdgcn_sinf(ang);
                pos[(size_t)t * D + d] = v; } }
    }
}

__device__ __forceinline__ void p1_weight_copies(const Args& a, LAS unsigned char* lds, int vcu, int G) {
    const int tid = threadIdx.x, lane = tid & 63, wave = __builtin_amdgcn_readfirstlane(tid >> 6);
    unsigned char* ws = a.ws;
    const int gw = vcu * NWAVES + wave, NGW = G * NWAVES;
    {
        LAS float* scr = (LAS float*)(lds + wave * 16384);
        bf16* wint = (bf16*)(ws + WS_WIN); bf16* woutt = (bf16*)(ws + WS_WOUT);
        constexpr int I_IN = 16 * 104, I_OUT = 16 * 32;
        for (int it = gw; it < I_IN + I_OUT; it += NGW) {
            if (it < I_IN) { const int kb = it / 104, nb = it % 104, n0 = 32 * nb;
                transpose_item(a.in[I_WIN], INW, wint, 64 * kb, n0, zperm(n0), scr, lane, zperm(n0 + 16)); }
            else { const int r = it - I_IN, kb = r / 32, nb = r % 32; transpose_item(a.in[I_WOUT], D, woutt, 64 * kb, 32 * nb, 32 * nb, scr, lane); }
        }
        for (int it = gw; it < 16 * 64; it += NGW) { const int kb = it >> 6, nb = it & 63, g0 = nb < 32 ? 512 + 32 * nb : 2048 + 32 * (nb - 32), n0 = g0 < 1536 ? g0 : g0 + 16;
            transpose_item_f8(a.in[I_WIN], INW, ws + WS_WIN8, 64 * kb, n0, g0, pg8::WSC, (LAS float*)(lds + wave * 16384), lane); }
        float* rwt = (float*)(ws + WS_RWT); const float* rw = a.in[I_RW];
        for (int idx = gw * 64 + lane; idx < 32 * 1024; idx += NGW * 64) { const int e = idx >> 10, d = idx & 1023; rwt[idx] = rw[d * 32 + e]; }
    }
}

#define P1C(lane_, j_) (8 * (lane_) + 512 * ((j_) >> 1) + 4 * ((j_) & 1))
__device__ __forceinline__ void p1_load_row(const Args& a, const float* pos, int m, int lane, f32x4 (&v)[4]) {
    if (m < NLAT) { const float* src = a.in[I_X] + (size_t)m * D; const float* pp = pos + (size_t)(m & (T - 1)) * D;
#pragma unroll
        for (int j = 0; j < 4; ++j) v[j] = *(const f32x4*)(src + P1C(lane, j)) + *(const f32x4*)(pp + P1C(lane, j)); }
    else { const float* src = a.in[I_CTX] + (size_t)((m < NTOK ? m : NTOK - 1) - NLAT) * D;
#pragma unroll
        for (int j = 0; j < 4; ++j) v[j] = *(const f32x4*)(src + P1C(lane, j)); }
}
constexpr float USC = 16.0f;
__device__ __forceinline__ void p1_norm1(const Args& a, int vcu, int G) {
    const int tid = threadIdx.x, lane = tid & 63, wave = __builtin_amdgcn_readfirstlane(tid >> 6);
    const int gw = vcu * NWAVES + wave, NGW = G * NWAVES;
    const float* mods = (const float*)(a.ws + WS_MODS); const float* pos = (const float*)(a.ws + WS_POS); const float* g1 = a.in[I_N1G];
    bf16* U = (bf16*)(a.ws + WS_U);
    f32x4 gv[4];
#pragma unroll
    for (int j = 0; j < 4; ++j) gv[j] = *(const f32x4*)(g1 + P1C(lane, j));
    f32x4 vn[2][4];
    p1_load_row(a, pos, gw, lane, vn[0]); p1_load_row(a, pos, gw + NGW, lane, vn[1]);
    for (int m0 = gw; m0 < NTOK; m0 += 2 * NGW) {
        f32x4 v[2][4];
#pragma unroll
        for (int r = 0; r < 2; ++r)
#pragma unroll
            for (int j = 0; j < 4; ++j) v[r][j] = vn[r][j];
        if (m0 + 2 * NGW < NTOK) { p1_load_row(a, pos, m0 + 2 * NGW, lane, vn[0]); p1_load_row(a, pos, m0 + 3 * NGW, lane, vn[1]); }
        f32x4 sh[2][4], sc[2][4];
#pragma unroll
        for (int r = 0; r < 2; ++r) { const int m = m0 + r * NGW; const int cr = m < NLAT ? (m >> 11) : 32; const float* md = mods + (size_t)cr * 6144;
#pragma unroll
            for (int j = 0; j < 4; ++j) { sh[r][j] = *(const f32x4*)(md + P1C(lane, j)); sc[r][j] = *(const f32x4*)(md + 1024 + P1C(lane, j)); } }
#pragma unroll
        for (int r = 0; r < 2; ++r) { const int m = m0 + r * NGW; if (m >= NTOK) continue;
            float s = 0.f;
#pragma unroll
            for (int j = 0; j < 4; ++j) s += (v[r][j].x * v[r][j].x + v[r][j].y * v[r][j].y) + (v[r][j].z * v[r][j].z + v[r][j].w * v[r][j].w);
            const float rr = 1.0f / sqrtf(wave_sum(s) * (1.0f / D) + EPS);
            bf16* ub = U + (size_t)m * D + 8 * lane; unsigned char* u8 = a.ws + WS_U8 + (size_t)m * D + 8 * lane;
#pragma unroll
            for (int jp = 0; jp < 2; ++jp) { u32x4 wb; u32x2 w8;
#pragma unroll
                for (int q = 0; q < 2; ++q) { const int j = 2 * jp + q; const f32x4 y = v[r][j] * rr * gv[j] * (sc[r][j] + 1.0f) + sh[r][j];
                    wb[2 * q] = pk2(y.x, y.y); wb[2 * q + 1] = pk2(y.z, y.w);
                    const f32x4 y8 = y * USC; w8[q] = pg8::pk4_fp8(y8.x, y8.y, y8.z, y8.w); }
                *(u32x4*)(ub + 512 * jp) = wb; *(u32x2*)(u8 + 512 * jp) = w8; } }
    }
}

#undef P1C
typedef short v4i16_t __attribute__((ext_vector_type(4)));
__device__ __forceinline__ s16x4 trr(const LAS unsigned char* p) { return __builtin_bit_cast(s16x4, __builtin_amdgcn_ds_read_tr16_b64_v4i16((LAS v4i16_t*)p)); }
__device__ __forceinline__ bf16x8 cat8(s16x4 lo, s16x4 hi) { return __builtin_shufflevector(lo, hi, 0, 1, 2, 3, 4, 5, 6, 7); }
#define MFMA16(a, b, c) __builtin_amdgcn_mfma_f32_16x16x32_bf16((a), (b), (c), 0, 0, 0)
constexpr int PQK = 144, PV = 272;
__device__ __forceinline__ int vswz(int r) { return ((r & 3) << 2) | ((r >> 2) & 3); }
__device__ __forceinline__ float lane_scan(float x, int lane, int rev) {
#pragma unroll
    for (int o = 1; o < 64; o <<= 1) { const float up = __shfl_up(x, o), dn = __shfl_down(x, o); if (rev) { if (lane + o < 64) x += dn; } else { if (lane >= o) x += up; } }
    return x;
}
__device__ __forceinline__ u32x4 ldz8(const bf16* Z, int segbase, int seglen, int t, int col) {
    u32x4 v = (u32x4){0u, 0u, 0u, 0u};
    if (t >= 0 && t < seglen) v = *(const u32x4*)(Z + (size_t)(segbase + t) * ZW + col);
    return v;
}
__device__ __forceinline__ void conv8(const LAS unsigned char* raw, int s, int c8, const float (&cw)[3][8], const float (&cb)[8], float (&o)[8]) {
    const u32x4 a0 = *(const LAS u32x4*)(raw + (s + 0) * PQK + c8 * 16), a1 = *(const LAS u32x4*)(raw + (s + 1) * PQK + c8 * 16), a2 = *(const LAS u32x4*)(raw + (s + 2) * PQK + c8 * 16);
#pragma unroll
    for (int j = 0; j < 4; ++j) {
        const float l0 = bflo(a0[j]), h0 = bfhi(a0[j]), l1 = bflo(a1[j]), h1 = bfhi(a1[j]), l2 = bflo(a2[j]), h2 = bfhi(a2[j]);
        o[2 * j] = fsilu(cb[2 * j] + cw[0][2 * j] * l0 + cw[1][2 * j] * l1 + cw[2][2 * j] * l2);
        o[2 * j + 1] = fsilu(cb[2 * j + 1] + cw[0][2 * j + 1] * h0 + cw[1][2 * j + 1] * h1 + cw[2][2 * j + 1] * h2);
    }
}
__device__ __forceinline__ u32x4 pack8(const float (&o)[8], float s) { u32x4 w; w.x = pk2(o[0] * s, o[1] * s); w.y = pk2(o[2] * s, o[3] * s); w.z = pk2(o[4] * s, o[5] * s); w.w = pk2(o[6] * s, o[7] * s); return w; }

constexpr int P3_GRP = 73152, P3_RK = 0, P3_VT = 16896, P3_KP = 49664, P3_LR = 68096, P3_WB = 72192, P3_WBS = 320;
__device__ __forceinline__ float fast_logsigmoid(float x) { return fminf(x, 0.f) - __logf(1.0f + __expf(-fabsf(x))); }
__device__ __forceinline__ void glds16(const void* g, LAS unsigned char* l) {
    unsigned keep; const unsigned dst = (unsigned)(size_t)l;
    asm volatile("s_mov_b32 %0, m0\n\ts_mov_b32 m0, %2\n\ts_nop 0\n\tglobal_load_lds_dwordx4 %1, off\n\ts_mov_b32 m0, %0" : "=&s"(keep) : "v"(g), "s"(dst) : "memory");
}
__device__ __forceinline__ void glds16nt(const void* g, LAS unsigned char* l) {
    unsigned keep; const unsigned dst = (unsigned)(size_t)l;
    asm volatile("s_mov_b32 %0, m0\n\ts_mov_b32 m0, %2\n\ts_nop 0\n\tglobal_load_lds_dwordx4 %1, off nt\n\ts_mov_b32 m0, %0" : "=&s"(keep) : "v"(g), "s"(dst) : "memory");
}
__device__ __forceinline__ void p3_chains(const Args& a, LAS unsigned char* lds, int vcu, int G) {
    const int tid = threadIdx.x, lane = tid & 63, wave = __builtin_amdgcn_readfirstlane(tid >> 6);
    const int grp = wave >> 2, gw4 = wave & 3, gt = tid & 255;
    const int g = lane >> 4, q = (lane & 15) >> 2, p = lane & 3, l15 = lane & 15;
    const bf16* Z = (const bf16*)(a.ws + WS_Z);
    bf16* ST = (bf16*)(a.ws + WS_ST); float* NST = (float*)(a.ws + WS_NST);
    LAS unsigned char* base = lds + grp * P3_GRP;
    const int c8 = gt & 7;
    for (int pair = vcu; pair < 256; pair += G) {
        const int ch = pair * 2 + grp;
        const int h = ch & 3, dir = (ch >> 2) & 1, type = (ch >> 3) & 1, b = ch >> 4;
        const bf16* ZK = Z + plane64(type ? F_GK : F_MLK, h); const bf16* ZV = Z + plane128(type ? F_GV : F_MLV, h); const bf16* ZM = Z + Z_MISC;
        float cw[3][8], cb[8];
        {
            const float* w = a.in[I_CONVW]; const float* bb = a.in[I_CONVB]; const int chn = 256 + h * 64 + c8 * 8;
#pragma unroll
            for (int j = 0; j < 8; ++j) { cw[0][j] = w[chn + j]; cw[1][j] = w[512 + chn + j]; cw[2][j] = w[1024 + chn + j]; cb[j] = bb[chn + j]; }
        }
        const float bias_i = a.in[I_MLGB][(2 * dir) * 4 + h], bias_f = a.in[I_MLGB][(2 * dir + 1) * 4 + h];
        bf16x8 w2f; float gbd;
        {
            const int d = h * 64 + 16 * gw4 + l15; const float* w2 = a.in[I_GW2] + (size_t)dir * 16 * 256 + d;
#pragma unroll
            for (int j = 0; j < 8; ++j) { float v = 0.f; if (g < 2) v = w2[(8 * g + j) * 256]; w2f[j] = (short)f2bf(v); }
            gbd = a.in[I_GGB][dir * 256 + d];
        }
        bf16x8 onesf;
#pragma unroll
        for (int j = 0; j < 8; ++j) onesf[j] = (short)(l15 == 0 ? 0x3F80 : 0);
        f32x4 acc[4][2], accn[4];
#pragma unroll
        for (int mt = 0; mt < 4; ++mt) { accn[mt] = (f32x4){0.f, 0.f, 0.f, 0.f};
#pragma unroll
            for (int nt = 0; nt < 2; ++nt) acc[mt][nt] = (f32x4){0.f, 0.f, 0.f, 0.f}; }
        float rgi = 0.f, rgf = 0.f;
#define P3_CHUNK(j, lat_, c_, t0_, sb_, sl_) const bool lat_ = (j) >= 4; const int c_ = dir == 0 ? (lat_ ? (j) - 4 : (j)) : (lat_ ? 35 - (j) : 3 - (j)); \
        const int t0_ = 64 * c_, sb_ = lat_ ? b * T : NLAT + b * CT, sl_ = lat_ ? T : CT
        for (int it = -3; it < 36; ++it) {
            if (type == 0 && gw4 == 0) {
                const int j2 = it + 2;
                if (j2 >= 0 && j2 < 36) { LAS float* WB = (LAS float*)(base + P3_WB + (j2 % 3) * P3_WBS);
                    const float lf = fast_logsigmoid(rgf + bias_f), ig = rgi + bias_i; const float B = lane_scan(lf, lane, dir);
                    const float tot = __shfl(B, dir ? 0 : 63); WB[lane] = __expf(tot - B + ig); if (lane == 0) WB[64] = __expf(tot); }
                const int j3 = it + 3;
                if (j3 < 36) { P3_CHUNK(j3, lat3, c3, t03, sb3, sl3); (void)sl3; (void)lat3; const bf16* zr = ZM + (size_t)(sb3 + t03 + lane) * 64 + M_MLG; rgi = bf2f(zr[(2 * dir) * 4 + h]); rgf = bf2f(zr[(2 * dir + 1) * 4 + h]); }
            }
            {
                const int j2 = it + 2;
                if (j2 >= 0 && j2 < 36) { P3_CHUNK(j2, lat2, c2, t02, sb2, sl2); (void)lat2;
                    LAS unsigned char* RK = base + P3_RK + (j2 & 1) * 8448;
#pragma unroll
                    for (int i = 0; i < 2; ++i) { const int qi = gw4 + 4 * i, row = 8 * qi + (lane >> 3); int t = t02 - 1 + row; t = t < 0 ? 0 : t;
                        glds16(ZK + (size_t)(sb2 + t) * 64 + (lane & 7) * 8, RK + qi * 1024); }
                    if (gw4 == 0 && lane < 16) { const int row = 64 + (lane >> 3); int t = t02 - 1 + row; t = t >= sl2 ? sl2 - 1 : t;
                        glds16(ZK + (size_t)(sb2 + t) * 64 + (lane & 7) * 8, RK + 8192); }
                    if (type == 1 && gw4 < 2) { LAS unsigned char* LR = base + P3_LR + (j2 & 1) * 2048; const int row = 32 * gw4 + (lane >> 1);
                        glds16(ZM + (size_t)(sb2 + t02 + row) * 64 + M_LR + dir * 16 + (lane & 1) * 8, LR + gw4 * 1024); }
                }
                const int j1 = it + 1;
                if (j1 >= 0 && j1 < 36) { P3_CHUNK(j1, lat1, c1, t01, sb1, sl1); (void)lat1; (void)sl1;
                    LAS unsigned char* VT = base + P3_VT + (j1 & 1) * 16384;
#pragma unroll
                    for (int i = 0; i < 4; ++i) { const int qi = gw4 * 4 + i, row = 4 * qi + (lane >> 4);
                        glds16(ZV + (size_t)(sb1 + t01 + row) * 128 + ((lane & 15) ^ vswz(row)) * 8, VT + qi * 1024); }
                }
            }
            {
                const int j1 = it + 1;
                if (j1 >= 0 && j1 < 36) { P3_CHUNK(j1, lat1, c1, t01, sb1, sl1); (void)lat1; (void)sb1;
                    const LAS unsigned char* RK = base + P3_RK + (j1 & 1) * 8448; LAS unsigned char* KP = base + P3_KP + (j1 & 1) * 9216;
                    LAS float* WB = (LAS float*)(base + P3_WB + (j1 % 3) * P3_WBS);
                    if (type == 0) {
#pragma unroll
                        for (int pss = 0; pss < 2; ++pss) { const int s = (gt >> 3) + 32 * pss;
                            u32x4 a0 = *(const LAS u32x4*)(RK + (s + 0) * 128 + c8 * 16); const u32x4 a1 = *(const LAS u32x4*)(RK + (s + 1) * 128 + c8 * 16); u32x4 a2 = *(const LAS u32x4*)(RK + (s + 2) * 128 + c8 * 16);
                            if (t01 + s - 1 < 0) a0 = (u32x4){0u, 0u, 0u, 0u};
                            if (t01 + s + 1 >= sl1) a2 = (u32x4){0u, 0u, 0u, 0u};
                            float o[8];
#pragma unroll
                            for (int j = 0; j < 4; ++j) {
                                o[2 * j] = fsilu(cb[2 * j] + cw[0][2 * j] * bflo(a0[j]) + cw[1][2 * j] * bflo(a1[j]) + cw[2][2 * j] * bflo(a2[j]));
                                o[2 * j + 1] = fsilu(cb[2 * j + 1] + cw[0][2 * j + 1] * bfhi(a0[j]) + cw[1][2 * j + 1] * bfhi(a1[j]) + cw[2][2 * j + 1] * bfhi(a2[j])); }
                            *(LAS u32x4*)(KP + s * PQK + c8 * 16) = pack8(o, WB[s]); }
                    } else {
                        const LAS unsigned char* LR = base + P3_LR + (j1 & 1) * 2048;
                        f32x4 la[4];
#pragma unroll
                        for (int mt = 0; mt < 4; ++mt) { bf16x8 af = (bf16x8){0, 0, 0, 0, 0, 0, 0, 0}; if (g < 2) af = *(const LAS bf16x8*)(LR + (16 * mt + l15) * 32 + g * 16);
                            la[mt] = MFMA16(af, w2f, ((f32x4){gbd, gbd, gbd, gbd}));
#pragma unroll
                            for (int rg = 0; rg < 4; ++rg) la[mt][rg] = fast_logsigmoid(la[mt][rg]) * (1.0f / 16.0f); }
                        float tmt[4];
#pragma unroll
                        for (int mt = 0; mt < 4; ++mt) {
                            if (dir == 0) { la[mt][1] += la[mt][0]; la[mt][2] += la[mt][1]; la[mt][3] += la[mt][2]; }
                            else { la[mt][2] += la[mt][3]; la[mt][1] += la[mt][2]; la[mt][0] += la[mt][1]; }
                            const float tg = dir == 0 ? la[mt][3] : la[mt][0];
                            const float t0 = __shfl(tg, l15), t1 = __shfl(tg, l15 + 16), t2 = __shfl(tg, l15 + 32), t3 = __shfl(tg, l15 + 48);
                            float og;
                            if (dir == 0) og = (g > 0 ? t0 : 0.f) + (g > 1 ? t1 : 0.f) + (g > 2 ? t2 : 0.f);
                            else og = (g < 3 ? t3 : 0.f) + (g < 2 ? t2 : 0.f) + (g < 1 ? t1 : 0.f);
#pragma unroll
                            for (int rg = 0; rg < 4; ++rg) la[mt][rg] += og;
                            tmt[mt] = (t0 + t1) + (t2 + t3); }
                        const float tot = (tmt[0] + tmt[1]) + (tmt[2] + tmt[3]);
#pragma unroll
                        for (int mt = 0; mt < 4; ++mt) { float om;
                            if (dir == 0) om = (mt > 0 ? tmt[0] : 0.f) + (mt > 1 ? tmt[1] : 0.f) + (mt > 2 ? tmt[2] : 0.f);
                            else om = (mt < 3 ? tmt[3] : 0.f) + (mt < 2 ? tmt[2] : 0.f) + (mt < 1 ? tmt[1] : 0.f);
#pragma unroll
                            for (int rg = 0; rg < 4; ++rg) { const int s = 16 * mt + 4 * g + rg, d = 16 * gw4 + l15;
                                const float kv = bf2f(*(const LAS unsigned short*)(RK + (s + 1) * 128 + d * 2));
                                *(LAS unsigned short*)(KP + s * PQK + d * 2) = (unsigned short)f2bf(kv * __expf(tot - (om + la[mt][rg]))); } }
                        if (g == 0) WB[16 * gw4 + l15] = __expf(tot);
                    }
                }
            }
            if (it >= 0) { P3_CHUNK(it, lat0, c0, t00, sb0, sl0); (void)t00; (void)sb0; (void)sl0;
                const LAS unsigned char* KP = base + P3_KP + (it & 1) * 9216; const LAS unsigned char* VT = base + P3_VT + (it & 1) * 16384;
                const LAS float* WB = (const LAS float*)(base + P3_WB + (it % 3) * P3_WBS);
                if (lat0) {
                    bf16* dst = ST + ((((size_t)(type * 2 + dir) * 32 + b) * 4 + h) * 32 + c0) * 8192;
#pragma unroll
                    for (int mt = 0; mt < 4; ++mt)
#pragma unroll
                        for (int nt = 0; nt < 2; ++nt) { u32x2 w; w.x = pk2(acc[mt][nt][0], acc[mt][nt][1]); w.y = pk2(acc[mt][nt][2], acc[mt][nt][3]);
                            const int F = (((2 * gw4 + nt) * 2 + (mt >> 1)) * 64 + (2 * (mt & 1) + (g >> 1)) * 16 + l15);
                            *(u32x2*)(dst + F * 8 + (g & 1) * 4) = w; }
                    if (type == 0 && gw4 == 0 && l15 == 0) { float* nd = NST + ((((size_t)dir * 32 + b) * 4 + h) * 32 + c0) * 64;
#pragma unroll
                        for (int mt = 0; mt < 4; ++mt) *(f32x4*)(nd + 16 * mt + 4 * g) = accn[mt]; }
                }
                if (type == 0) { const float et = WB[64];
#pragma unroll
                    for (int mt = 0; mt < 4; ++mt) { accn[mt] *= et;
#pragma unroll
                        for (int nt = 0; nt < 2; ++nt) acc[mt][nt] *= et; }
                } else {
#pragma unroll
                    for (int mt = 0; mt < 4; ++mt) { const f32x4 e4 = *(const LAS f32x4*)(WB + 16 * mt + 4 * g);
#pragma unroll
                        for (int nt = 0; nt < 2; ++nt) acc[mt][nt] *= e4; }
                }
#pragma unroll
                for (int ks = 0; ks < 2; ++ks) {
                    bf16x8 af[4], bfr[2];
#pragma unroll
                    for (int mt = 0; mt < 4; ++mt) { const LAS unsigned char* pa = KP + (32 * ks + 8 * g + q) * PQK + (16 * mt + 4 * p) * 2; af[mt] = cat8(trr(pa), trr(pa + 4 * PQK)); }
#pragma unroll
                    for (int nt = 0; nt < 2; ++nt) { const int r0 = 32 * ks + 8 * g + q, ch = 4 * gw4 + 2 * nt + (p >> 1);
                        const LAS unsigned char* pb0 = VT + r0 * 256 + ((ch ^ vswz(r0)) * 16) + 8 * (p & 1); const LAS unsigned char* pb1 = VT + (r0 + 4) * 256 + ((ch ^ vswz(r0 + 4)) * 16) + 8 * (p & 1);
                        bfr[nt] = cat8(trr(pb0), trr(pb1)); }
#pragma unroll
                    for (int mt = 0; mt < 4; ++mt) {
#pragma unroll
                        for (int nt = 0; nt < 2; ++nt) acc[mt][nt] = MFMA16(af[mt], bfr[nt], acc[mt][nt]);
                        if (type == 0 && gw4 == 0) accn[mt] = MFMA16(af[mt], onesf, accn[mt]); }
                }
            }
            { const bool st = it >= 4;
              if (!st) VM_WAIT(); else if (type == 0 && gw4 == 0) asm volatile("s_waitcnt vmcnt(12)" ::: "memory"); else asm volatile("s_waitcnt vmcnt(8)" ::: "memory"); }
            BAR_LDS();
        }
#undef P3_CHUNK
    }
}

constexpr int P4_QR = 0, P4_KR = 8448, P4_LR = 16896, P4_VT = 20992, P4_CT = 37376, P4_QP = 70144, P4_KP = 88576, P4_SW = 107008, P4_H = 70144, P4_WB = 125440, P4_CW = 127488;
constexpr int P4_TS = 9216, P4_HS = 17408, PH = 272;
__device__ __forceinline__ void p4_outputs(const Args& a, LAS unsigned char* lds, int vcu, int G) {
    const int tid = threadIdx.x, lane = tid & 63, wave = __builtin_amdgcn_readfirstlane(tid >> 6);
    const int dg = wave >> 2, gw4 = wave & 3, gt = tid & 255;
    const int g = lane >> 4, q = (lane & 15) >> 2, p = lane & 3, l15 = lane & 15;
    const bf16* Z = (const bf16*)(a.ws + WS_Z);
    const bf16* ST = (const bf16*)(a.ws + WS_ST); const float* NST = (const float*)(a.ws + WS_NST);
    bf16* MG = (bf16*)(a.ws + WS_U);
    LAS unsigned char* QR = lds + P4_QR; LAS unsigned char* KR = lds + P4_KR; LAS unsigned char* LR = lds + P4_LR + dg * 2048; LAS unsigned char* VT = lds + P4_VT; LAS unsigned char* CTl = lds + P4_CT + dg * 16384;
    LAS unsigned char* QP = lds + P4_QP + dg * P4_TS; LAS unsigned char* KP = lds + P4_KP + dg * P4_TS; LAS unsigned char* SW = lds + P4_SW + dg * P4_TS;
    LAS unsigned char* Hme = lds + P4_H + dg * P4_HS;
    LAS float* CW = (LAS float*)(lds + P4_CW);
    const int c8 = gt & 7;
    for (int i = tid; i < 2048; i += NTHR) CW[i] = i < 1536 ? a.in[I_CONVW][i] : a.in[I_CONVB][i - 1536];
    if (tid < 16) CW[2048 + tid] = a.in[I_MLGB][tid];
#define P4_DEC(u_, b_, ty_, h_, c_) const int b_ = (u_) >> 8, r_##b_ = (u_) & 255, ty_ = (r_##b_ + b_) & 1, h_ = (r_##b_ >> 1) & 3, c_ = r_##b_ >> 3
#define P4_ISSUE_QK(u_) do { P4_DEC(u_, ib, ity, ih, ic); const int it0 = 64 * ic, isb = ib * T; \
        const bf16* zq = Z + plane64(ity ? F_GQ : F_MLQ, ih); const bf16* zk = Z + plane64(ity ? F_GK : F_MLK, ih); \
        { const int row = 8 * wave + (lane >> 3); int t = it0 - 1 + row; t = t < 0 ? 0 : t; const size_t so = (size_t)(isb + t) * 64 + (lane & 7) * 8; \
          glds16nt(zq + so, QR + wave * 1024); glds16nt(zk + so, KR + wave * 1024); } \
        if (wave < 2 && lane < 16) { const int row = 64 + (lane >> 3); int t = it0 - 1 + row; t = t >= T ? T - 1 : t; \
          glds16nt((wave ? zk : zq) + (size_t)(isb + t) * 64 + (lane & 7) * 8, (wave ? KR : QR) + 8192); } \
        if (gw4 < 2) { const int row = 32 * gw4 + (lane >> 1); glds16nt(Z + Z_MISC + (size_t)(isb + it0 + row) * 64 + M_LR + dg * 16 + (lane & 1) * 8, LR + gw4 * 1024); } } while (0)
#define P4_ISSUE_VC(u_) do { P4_DEC(u_, ib, ity, ih, ic); const int it0 = 64 * ic, isb = ib * T; const bf16* zv = Z + plane128(ity ? F_GV : F_MLV, ih); \
        _Pragma("unroll") for (int i = 0; i < 2; ++i) { const int qi = wave * 2 + i, row = 4 * qi + (lane >> 4); glds16nt(zv + (size_t)(isb + it0 + row) * 128 + ((lane & 15) ^ vswz(row)) * 8, VT + qi * 1024); } \
        const bf16* src = ST + ((((size_t)(ity * 2 + dg) * 32 + ib) * 4 + ih) * 32 + ic) * 8192; \
        _Pragma("unroll") for (int i = 0; i < 4; ++i) { const int qi = gw4 * 4 + i; glds16nt(src + qi * 512 + lane * 8, CTl + qi * 1024); } } while (0)
#define P4_GATES_LOAD(u_, gi_, gf_, gh_) do { P4_DEC(u_, ib, ity, ih, ic); (void)ity; const bf16* zr = Z + Z_MISC + (size_t)(ib * T + 64 * ic + lane) * 64 + M_MLG; \
        gi_ = zr[(2 * dg) * 4 + ih]; gf_ = zr[(2 * dg + 1) * 4 + ih]; gh_ = ih; } while (0)
#define P4_GATES_SCAN(slot_, gi_, gf_, gh_) do { LAS float* WBs = (LAS float*)(lds + P4_WB + ((slot_) * 2 + dg) * 512); const LAS float* GBt = (const LAS float*)(lds + P4_CW + 8192); \
        const float lf = fast_logsigmoid(bf2f(gf_) + GBt[(2 * dg + 1) * 4 + (gh_)]), gi2 = bf2f(gi_) + GBt[(2 * dg) * 4 + (gh_)]; \
        const float B = lane_scan(lf, lane, dg); WBs[lane] = __expf(B) * 0.125f; WBs[64 + lane] = __expf(gi2 - B); } while (0)
    bf16x8 w2h[4]; float gbh[4];
#pragma unroll
    for (int hh = 0; hh < 4; ++hh) { const int d = hh * 64 + 16 * gw4 + l15; const float* w2 = a.in[I_GW2] + (size_t)dg * 16 * 256 + d;
#pragma unroll
        for (int j = 0; j < 8; ++j) { float v = 0.f; if (g < 2) v = w2[(8 * g + j) * 256]; w2h[hh][j] = (short)f2bf(v); }
        gbh[hh] = a.in[I_GGB][dg * 256 + d]; }
    int u = vcu;
    if (u < 8192) {
        P4_ISSUE_QK(u); P4_ISSUE_VC(u);
    }
    VM_WAIT();
    __syncthreads();
    if (u < 8192 && gw4 == 0) { unsigned short gi, gf; int gh; P4_GATES_LOAD(u, gi, gf, gh); P4_GATES_SCAN(0, gi, gf, gh); }
    __syncthreads();
    for (int iter = 0; u < 8192; u += G, ++iter) {
        P4_DEC(u, b, type, h, c);
        const int t0 = 64 * c, segbase = b * T;
        const int un = u + G; const bool has_next = un < 8192;
        const int et = tid >> 3, evc = (tid & 7) * 16, erow = segbase + t0 + et;
        const bf16* zg = Z + plane128(type ? F_GG : F_MLO, h) + (size_t)erow * 128 + evc;
        const u32x4 eg0 = *(const u32x4*)zg, eg1 = *(const u32x4*)(zg + 8);
        f32x4 ngv[4];
        { const float* ngm = a.in[I_MLNG]; const float* ngg = a.in[I_GNG]; asm volatile("" : "+s"(ngm), "+s"(ngg)); const float* ng = (type ? ngg : ngm) + h * 128 + evc;
#pragma unroll
          for (int j = 0; j < 4; ++j) ngv[j] = *(const f32x4*)(ng + 4 * j); }
        f32x4 nsa[2][2];
#pragma unroll
        for (int ks = 0; ks < 2; ++ks) { nsa[ks][0] = (f32x4){0.f, 0.f, 0.f, 0.f}; nsa[ks][1] = nsa[ks][0]; }
        if (type == 0 && l15 == 0) { const float* nd = NST + ((((size_t)dg * 32 + b) * 4 + h) * 32 + c) * 64;
#pragma unroll
            for (int ks = 0; ks < 2; ++ks) { nsa[ks][0] = *(const f32x4*)(nd + 32 * ks + 8 * g); nsa[ks][1] = *(const f32x4*)(nd + 32 * ks + 8 * g + 4); } }
        unsigned short ngi = 0, ngf = 0; int ngh = 0;
        if (gw4 == 0 && has_next) P4_GATES_LOAD(un, ngi, ngf, ngh);
        if (type == 0) {
            const int qk = tid >> 8;
            const LAS float* WB0 = (const LAS float*)(lds + P4_WB + ((iter & 1) * 2 + 0) * 512) + qk * 64; const LAS float* WB1 = (const LAS float*)(lds + P4_WB + ((iter & 1) * 2 + 1) * 512) + qk * 64;
            float cw[3][8], cb[8];
            const int chn = qk * 256 + h * 64 + c8 * 8;
#pragma unroll
            for (int j4 = 0; j4 < 2; ++j4) { const f32x4 x0 = *(const LAS f32x4*)(CW + chn + 4 * j4), x1 = *(const LAS f32x4*)(CW + 512 + chn + 4 * j4), x2 = *(const LAS f32x4*)(CW + 1024 + chn + 4 * j4), x3 = *(const LAS f32x4*)(CW + 1536 + chn + 4 * j4);
#pragma unroll
                for (int i = 0; i < 4; ++i) { cw[0][4 * j4 + i] = x0[i]; cw[1][4 * j4 + i] = x1[i]; cw[2][4 * j4 + i] = x2[i]; cb[4 * j4 + i] = x3[i]; } }
            const LAS unsigned char* RAW = qk ? KR : QR; LAS unsigned char* DST = lds + (qk ? P4_KP : P4_QP);
#pragma unroll
            for (int pss = 0; pss < 2; ++pss) { const int s = (gt >> 3) + 32 * pss;
                u32x4 a0 = *(const LAS u32x4*)(RAW + (s + 0) * 128 + c8 * 16); const u32x4 a1 = *(const LAS u32x4*)(RAW + (s + 1) * 128 + c8 * 16); u32x4 a2 = *(const LAS u32x4*)(RAW + (s + 2) * 128 + c8 * 16);
                if (t0 + s - 1 < 0) a0 = (u32x4){0u, 0u, 0u, 0u};
                if (t0 + s + 1 >= T) a2 = (u32x4){0u, 0u, 0u, 0u};
                float o[8];
#pragma unroll
                for (int j = 0; j < 4; ++j) {
                    o[2 * j] = fsilu(cb[2 * j] + cw[0][2 * j] * bflo(a0[j]) + cw[1][2 * j] * bflo(a1[j]) + cw[2][2 * j] * bflo(a2[j]));
                    o[2 * j + 1] = fsilu(cb[2 * j + 1] + cw[0][2 * j + 1] * bfhi(a0[j]) + cw[1][2 * j + 1] * bfhi(a1[j]) + cw[2][2 * j + 1] * bfhi(a2[j])); }
                *(LAS u32x4*)(DST + s * PQK + c8 * 16) = pack8(o, WB0[s]);
                *(LAS u32x4*)(DST + P4_TS + s * PQK + c8 * 16) = pack8(o, WB1[s]); }
        } else {
            const bf16x8 w2f = h == 0 ? w2h[0] : h == 1 ? w2h[1] : h == 2 ? w2h[2] : w2h[3]; const float gbd = h == 0 ? gbh[0] : h == 1 ? gbh[1] : h == 2 ? gbh[2] : gbh[3];
            f32x4 la[4];
#pragma unroll
            for (int mt = 0; mt < 4; ++mt) { bf16x8 af = (bf16x8){0, 0, 0, 0, 0, 0, 0, 0}; if (g < 2) af = *(const LAS bf16x8*)(LR + (16 * mt + l15) * 32 + g * 16);
                la[mt] = MFMA16(af, w2f, ((f32x4){gbd, gbd, gbd, gbd}));
#pragma unroll
                for (int rg = 0; rg < 4; ++rg) la[mt][rg] = fast_logsigmoid(la[mt][rg]) * (1.0f / 16.0f); }
            float tmt[4];
#pragma unroll
            for (int mt = 0; mt < 4; ++mt) {
                if (dg == 0) { la[mt][1] += la[mt][0]; la[mt][2] += la[mt][1]; la[mt][3] += la[mt][2]; }
                else { la[mt][2] += la[mt][3]; la[mt][1] += la[mt][2]; la[mt][0] += la[mt][1]; }
                const float tg = dg == 0 ? la[mt][3] : la[mt][0];
                const float t0g = __shfl(tg, l15), t1g = __shfl(tg, l15 + 16), t2g = __shfl(tg, l15 + 32), t3g = __shfl(tg, l15 + 48);
                float og;
                if (dg == 0) og = (g > 0 ? t0g : 0.f) + (g > 1 ? t1g : 0.f) + (g > 2 ? t2g : 0.f);
                else og = (g < 3 ? t3g : 0.f) + (g < 2 ? t2g : 0.f) + (g < 1 ? t1g : 0.f);
#pragma unroll
                for (int rg = 0; rg < 4; ++rg) la[mt][rg] += og;
                tmt[mt] = (t0g + t1g) + (t2g + t3g); }
#pragma unroll
            for (int mt = 0; mt < 4; ++mt) { float om;
                if (dg == 0) om = (mt > 0 ? tmt[0] : 0.f) + (mt > 1 ? tmt[1] : 0.f) + (mt > 2 ? tmt[2] : 0.f);
                else om = (mt < 3 ? tmt[3] : 0.f) + (mt < 2 ? tmt[2] : 0.f) + (mt < 1 ? tmt[1] : 0.f);
#pragma unroll
                for (int rg = 0; rg < 4; ++rg) { const int s = 16 * mt + 4 * g + rg, d = 16 * gw4 + l15; const float B = om + la[mt][rg];
                    const float qv = bf2f(*(const LAS unsigned short*)(QR + (s + 1) * 128 + d * 2)), kv = bf2f(*(const LAS unsigned short*)(KR + (s + 1) * 128 + d * 2));
                    *(LAS unsigned short*)(QP + s * PQK + d * 2) = (unsigned short)f2bf(qv * 0.125f * __expf(B));
                    *(LAS unsigned short*)(KP + s * PQK + d * 2) = (unsigned short)f2bf(kv * __expf(-B)); } }
        }
        asm volatile("" :: "v"(eg0), "v"(eg1), "v"(ngi), "v"(ngf), "v"(nsa[0][0]), "v"(nsa[0][1]), "v"(nsa[1][0]), "v"(nsa[1][1]), "v"(ngv[0]), "v"(ngv[1]), "v"(ngv[2]), "v"(ngv[3]));
        VM_WAIT();
        BAR_LDS();
        if (has_next) P4_ISSUE_QK(un);
        bf16x8 qf[2];
#pragma unroll
        for (int ks = 0; ks < 2; ++ks) qf[ks] = *(const LAS bf16x8*)(QP + (16 * gw4 + l15) * PQK + (32 * ks + 8 * g) * 2);
        float rs = 0.f;
        {
            f32x4 sa[4];
#pragma unroll
            for (int mt = 0; mt < 4; ++mt) sa[mt] = (f32x4){0.f, 0.f, 0.f, 0.f};
#pragma unroll
            for (int ks = 0; ks < 2; ++ks)
#pragma unroll
                for (int mt = 0; mt < 4; ++mt) { const bf16x8 kf = *(const LAS bf16x8*)(KP + (16 * mt + l15) * PQK + (32 * ks + 8 * g) * 2); sa[mt] = MFMA16(kf, qf[ks], sa[mt]); }
            const int t = 16 * gw4 + l15;
#pragma unroll
            for (int mt = 0; mt < 4; ++mt) { float v[4];
#pragma unroll
                for (int rg = 0; rg < 4; ++rg) { const int sI = 16 * mt + 4 * g + rg; const bool keep = dg == 0 ? (sI <= t) : (sI >= t); v[rg] = keep ? sa[mt][rg] : 0.f; rs += v[rg]; }
                u32x2 w; w.x = pk2(v[0], v[1]); w.y = pk2(v[2], v[3]);
                *(LAS u32x2*)(SW + t * PQK + (16 * mt + 4 * g) * 2) = w; }
            rs += __shfl_xor(rs, 16); rs += __shfl_xor(rs, 32);
        }
        f32x4 na[8], nn = (f32x4){0.f, 0.f, 0.f, 0.f};
#pragma unroll
        for (int mt = 0; mt < 8; ++mt) na[mt] = (f32x4){0.f, 0.f, 0.f, 0.f};
#pragma unroll
        for (int ks = 0; ks < 2; ++ks) { const bf16x8 sf = *(const LAS bf16x8*)(SW + (16 * gw4 + l15) * PQK + (32 * ks + 8 * g) * 2);
            const int r0 = 32 * ks + 8 * g + q, x0 = vswz(r0), x1 = vswz(r0 + 4);
#pragma unroll
            for (int mt = 0; mt < 8; ++mt) { const int ch = 2 * mt + (p >> 1); const LAS unsigned char* pa0 = VT + r0 * 256 + ((ch ^ x0) * 16) + 8 * (p & 1); const LAS unsigned char* pa1 = VT + (r0 + 4) * 256 + ((ch ^ x1) * 16) + 8 * (p & 1);
                na[mt] = MFMA16(cat8(trr(pa0), trr(pa1)), sf, na[mt]); } }
#pragma unroll
        for (int ks = 0; ks < 2; ++ks) {
#pragma unroll
            for (int mt = 0; mt < 8; ++mt) { const bf16x8 cf = *(const LAS bf16x8*)(CTl + ((mt * 2 + ks) * 64 + lane) * 16); na[mt] = MFMA16(cf, qf[ks], na[mt]); }
            if (type == 0) { bf16x8 nf;
#pragma unroll
                for (int j = 0; j < 4; ++j) { nf[j] = (short)f2bf(nsa[ks][0][j]); nf[4 + j] = (short)f2bf(nsa[ks][1][j]); }
                nn = MFMA16(nf, qf[ks], nn); } }
        float inv = 1.0f;
        if (type == 0) { const float qn = __shfl(nn[0], l15); inv = 1.0f / fmaxf(fabsf(rs + qn), 1.0f); }
        BAR_LDS();
        if (has_next) P4_ISSUE_VC(un);
#pragma unroll
        for (int mt = 0; mt < 8; ++mt) { u32x2 w; w.x = pk2(na[mt][0] * inv, na[mt][1] * inv); w.y = pk2(na[mt][2] * inv, na[mt][3] * inv);
            *(LAS u32x2*)(Hme + (16 * gw4 + l15) * PH + (16 * mt + 4 * g) * 2) = w; }
        if (gw4 == 0 && has_next) P4_GATES_SCAN((iter + 1) & 1, ngi, ngf, ngh);
        BAR_LDS();
        {
            const LAS unsigned char* H0 = lds + P4_H + et * PH + evc * 2; float hv[16]; float ss = 0.f;
#pragma unroll
            for (int j = 0; j < 2; ++j) { const u32x4 x0 = *(const LAS u32x4*)(H0 + 16 * j), x1 = *(const LAS u32x4*)(H0 + P4_HS + 16 * j);
#pragma unroll
                for (int i = 0; i < 4; ++i) { const float v0 = bflo(x0[i]) + bflo(x1[i]), v1 = bfhi(x0[i]) + bfhi(x1[i]); hv[8 * j + 2 * i] = v0; hv[8 * j + 2 * i + 1] = v1; ss += v0 * v0 + v1 * v1; } }
            ss += __shfl_xor(ss, 1); ss += __shfl_xor(ss, 2); ss += __shfl_xor(ss, 4);
            const float rn = 1.0f / sqrtf(ss * (1.0f / 128.0f) + EPS);
            float gate[16];
#pragma unroll
            for (int j = 0; j < 4; ++j) { gate[2 * j] = bflo(eg0[j]); gate[2 * j + 1] = bfhi(eg0[j]); gate[8 + 2 * j] = bflo(eg1[j]); gate[8 + 2 * j + 1] = bfhi(eg1[j]); }
            float o[16];
#pragma unroll
            for (int i = 0; i < 16; ++i) { const float gv = type ? fsilu(gate[i]) : fsigmoid(gate[i]); o[i] = hv[i] * rn * ngv[i >> 2][i & 3] * gv; }
            bf16* dst = MG + (size_t)erow * D + type * 512 + h * 128 + evc;
            u32x4 w0, w1; w0.x = pk2(o[0], o[1]); w0.y = pk2(o[2], o[3]); w0.z = pk2(o[4], o[5]); w0.w = pk2(o[6], o[7]); w1.x = pk2(o[8], o[9]); w1.y = pk2(o[10], o[11]); w1.z = pk2(o[12], o[13]); w1.w = pk2(o[14], o[15]);
            *(u32x4*)dst = w0; *(u32x4*)(dst + 8) = w1;
        }
        asm volatile("s_waitcnt vmcnt(8)" ::: "memory");
        BAR_LDS();
    }
#undef P4_DEC
#undef P4_ISSUE_QK
#undef P4_ISSUE_VC
#undef P4_GATES_LOAD
#undef P4_GATES_SCAN
}

constexpr int P6_LG = 131072, P6_PE = 132096, P6_PP = 136192, P6_PR = 140288, P6_LC = 144384;
constexpr int P6_RWH = 0, P6_RR = 65536, P6_LGT = 66560, P6_AS = 83968;
__device__ __forceinline__ void p6_router(const Args& a, LAS unsigned char* lds, int vcu, int G) {
    const int tid = threadIdx.x, lane = tid & 63, wave = __builtin_amdgcn_readfirstlane(tid >> 6);
    const int g = lane >> 4, l15 = lane & 15;
    const float* mods = (const float*)(a.ws + WS_MODS); const float* rwt = (const float*)(a.ws + WS_RWT); const float* g2 = a.in[I_N2G]; const float* rb = a.in[I_RB];
    const bf16* X1 = (const bf16*)(a.ws + WS_X1B); unsigned char* U2 = a.ws + WS_U;
    int* ltok = (int*)(a.ws + WS_LTOK); float* lp = (float*)(a.ws + WS_LP); int* tgp = (int*)(a.ws + WS_TGP);
    unsigned* cntw = (unsigned*)(a.ws + WS_CTL) + CW_CNT;
    LAS unsigned char* RWH = lds + P6_RWH; LAS float* RR = (LAS float*)(lds + P6_RR) + wave * 32; LAS float* LGT = (LAS float*)(lds + P6_LGT) + wave * 512;
    LAS float* AS = (LAS float*)(lds + P6_AS);
    LAS int* PE = (LAS int*)(lds + P6_PE); LAS float* PP = (LAS float*)(lds + P6_PP); LAS int* PR = (LAS int*)(lds + P6_PR);
    LAS int* LC = (LAS int*)(lds + P6_LC); LAS int* GB = LC + 32;
    for (int f = wave * 8; f < wave * 8 + 8; ++f) { const int mt = f >> 5, ks = f & 31; const float* src = rwt + (size_t)(16 * mt + l15) * 1024 + 32 * ks + 8 * g;
        const f32x4 x0 = *(const f32x4*)src, x1 = *(const f32x4*)(src + 4);
        u32x4 w; w.x = pk2(x0.x, x0.y); w.y = pk2(x0.z, x0.w); w.z = pk2(x1.x, x1.y); w.w = pk2(x1.z, x1.w);
        *(LAS u32x4*)(RWH + (f * 64 + lane) * 16) = w; }
    f32x4 gv[4];
#pragma unroll
    for (int j = 0; j < 4; ++j) gv[j] = *(const f32x4*)(g2 + 4 * lane + 256 * j);
    for (int rbk = vcu; rbk < NLAT / 256; rbk += G) {
        const int mbase = rbk * 256 + wave * 32, b = mbase >> 11;
        const float* md = mods + (size_t)b * 6144;
        if (tid < 32) LC[tid] = 0;
        for (int i = tid; i < 1024; i += NTHR) { AS[i] = g2[i] * (1.0f + md[4 * 1024 + i]); AS[1024 + i] = md[3 * 1024 + i]; }
        __syncthreads();
        f32x4 vn[2][4];
#pragma unroll
        for (int r = 0; r < 2; ++r)
#pragma unroll
            for (int j = 0; j < 4; ++j) vn[r][j] = ldbf4(X1 + (size_t)(mbase + r) * D + 4 * lane + 256 * j);
        for (int i = 0; i < 32; i += 2) {
            f32x4 v[2][4];
#pragma unroll
            for (int r = 0; r < 2; ++r)
#pragma unroll
                for (int j = 0; j < 4; ++j) v[r][j] = vn[r][j];
            if (i + 2 < 32) {
#pragma unroll
                for (int r = 0; r < 2; ++r)
#pragma unroll
                    for (int j = 0; j < 4; ++j) vn[r][j] = ldbf4(X1 + (size_t)(mbase + i + 2 + r) * D + 4 * lane + 256 * j); }
#pragma unroll
            for (int r = 0; r < 2; ++r) { float s = 0.f;
#pragma unroll
                for (int j = 0; j < 4; ++j) s += (v[r][j].x * v[r][j].x + v[r][j].y * v[r][j].y) + (v[r][j].z * v[r][j].z + v[r][j].w * v[r][j].w);
                const float rr = 1.0f / sqrtf(wave_sum(s) * (1.0f / D) + EPS);
                if (lane == 0) RR[i + r] = rr;
                unsigned* o4 = (unsigned*)(U2 + (size_t)(mbase + i + r) * D) + lane;
#pragma unroll
                for (int j = 0; j < 4; ++j) { const f32x4 aa = *(const LAS f32x4*)(AS + 4 * lane + 256 * j), sh = *(const LAS f32x4*)(AS + 1024 + 4 * lane + 256 * j);
                    const f32x4 y = v[r][j] * rr * aa + sh;
                    o4[64 * j] = pg8::pk4_fp8(y.x, y.y, y.z, y.w); } }
        }
        LDS_WAIT(); asm volatile("" ::: "memory");
#pragma unroll 1
        for (int tl = 0; tl < 2; ++tl) {
            const int row = mbase + 16 * tl + l15; const float rr = RR[16 * tl + l15];
            const bf16* xr = X1 + (size_t)row * D + 8 * g;
            f32x4 acc[2]; acc[0] = (f32x4){0.f, 0.f, 0.f, 0.f}; acc[1] = acc[0];
            f32x4 xc[4][2], xn[4][2];
#pragma unroll
            for (int k4 = 0; k4 < 4; ++k4) { xc[k4][0] = ldbf4(xr + 32 * k4); xc[k4][1] = ldbf4(xr + 32 * k4 + 4); }
#pragma unroll 1
            for (int kb = 0; kb < 8; ++kb) {
                const int kn = kb < 7 ? kb + 1 : kb;
#pragma unroll
                for (int k4 = 0; k4 < 4; ++k4) { xn[k4][0] = ldbf4(xr + 32 * (4 * kn + k4)); xn[k4][1] = ldbf4(xr + 32 * (4 * kn + k4) + 4); }
#pragma unroll
                for (int k4 = 0; k4 < 4; ++k4) { const int ks = 4 * kb + k4;
                    const f32x4 a0 = *(const LAS f32x4*)(AS + 32 * ks + 8 * g), a1 = *(const LAS f32x4*)(AS + 32 * ks + 8 * g + 4);
                    const f32x4 s0 = *(const LAS f32x4*)(AS + 1024 + 32 * ks + 8 * g), s1 = *(const LAS f32x4*)(AS + 1024 + 32 * ks + 8 * g + 4);
                    const f32x4 u0 = xc[k4][0] * rr * a0 + s0, u1 = xc[k4][1] * rr * a1 + s1;
                    bf16x8 bh, bl;
#pragma unroll
                    for (int j = 0; j < 4; ++j) { const unsigned h0 = f2bf(u0[j]), h1 = f2bf(u1[j]); bh[j] = (short)h0; bh[4 + j] = (short)h1;
                        bl[j] = (short)f2bf(u0[j] - __builtin_bit_cast(float, h0 << 16)); bl[4 + j] = (short)f2bf(u1[j] - __builtin_bit_cast(float, h1 << 16)); }
#pragma unroll
                    for (int mt = 0; mt < 2; ++mt) { const bf16x8 af = *(const LAS bf16x8*)(RWH + ((mt * 32 + ks) * 64 + lane) * 16); acc[mt] = MFMA16(af, bh, acc[mt]); acc[mt] = MFMA16(af, bl, acc[mt]); } }
#pragma unroll
                for (int k4 = 0; k4 < 4; ++k4) { xc[k4][0] = xn[k4][0]; xc[k4][1] = xn[k4][1]; }
            }
#pragma unroll
            for (int mt = 0; mt < 2; ++mt) { const f32x4 bb = *(const f32x4*)(rb + 16 * mt + 4 * g); *(LAS f32x4*)(LGT + l15 * 32 + 16 * mt + 4 * g) = acc[mt] + bb; }
            LDS_WAIT(); asm volatile("" ::: "memory");
            if (lane < 16) {
                float lv[32];
#pragma unroll
                for (int j = 0; j < 8; ++j) { const f32x4 t4 = *(const LAS f32x4*)(LGT + lane * 32 + 4 * j); lv[4 * j] = t4[0]; lv[4 * j + 1] = t4[1]; lv[4 * j + 2] = t4[2]; lv[4 * j + 3] = t4[3]; }
                unsigned taken = 0u; int sel[4]; float val[4];
#pragma unroll
                for (int k = 0; k < 4; ++k) { float best = -3.0e38f; int bi = 0;
#pragma unroll
                    for (int e = 0; e < 32; ++e) { const bool okk = ((taken >> e) & 1u) == 0u && lv[e] > best; best = okk ? lv[e] : best; bi = okk ? e : bi; }
                    sel[k] = bi; val[k] = best; taken |= 1u << bi; }
                const float e1 = __expf(val[1] - val[0]), e2 = __expf(val[2] - val[0]), e3 = __expf(val[3] - val[0]); const float inv = 1.0f / (1.0f + e1 + e2 + e3);
                const int rl = wave * 32 + 16 * tl + lane; const float pr[4] = {inv, e1 * inv, e2 * inv, e3 * inv};
#pragma unroll
                for (int k = 0; k < 4; ++k) { const int rk = __hip_atomic_fetch_add(LC + sel[k], 1, __ATOMIC_RELAXED, __HIP_MEMORY_SCOPE_WORKGROUP);
                    PE[rl * 4 + k] = sel[k]; PP[rl * 4 + k] = pr[k]; PR[rl * 4 + k] = rk; }
            }
            LDS_WAIT(); asm volatile("" ::: "memory");
        }
        __syncthreads();
        if (tid < 32) GB[tid] = (int)__hip_atomic_fetch_add(cntw + tid * 64, (unsigned)LC[tid], __ATOMIC_RELAXED, __HIP_MEMORY_SCOPE_AGENT);
        __syncthreads();
        for (int pi = tid; pi < 1024; pi += NTHR) { const int e = PE[pi], gg = e, pos = GB[e] + PR[pi], tok = rbk * 256 + (pi >> 2);
            ltok[(size_t)gg * LCAP + pos] = tok; lp[(size_t)gg * LCAP + pos] = PP[pi]; tgp[tok * 4 + (pi & 3)] = (gg << 16) | pos; }
        __syncthreads();
    }
    __syncthreads();
}
__device__ __forceinline__ void p6_convert(const Args& a, LAS unsigned char* lds, int vcu, int G) {
    const int tid = threadIdx.x, lane = tid & 63, wave = __builtin_amdgcn_readfirstlane(tid >> 6);
    {
        const int gw = vcu * NWAVES + wave, NGW = G * NWAVES; LAS float* scr = (LAS float*)(lds + wave * 16384);
        unsigned char* wgut = a.ws + WS_WGU; unsigned char* wdt = a.ws + WS_WD;
        constexpr int I_GU = 32 * 16 * 64, I_DN = 32 * 16 * 32;
        for (int it = gw; it < I_GU + I_DN; it += NGW) {
            if (it < I_GU) { const int e = it >> 10, r = it & 1023, kb = r >> 6, nb = r & 63, n0 = 32 * nb, hf = n0 >> 10, j0 = n0 & 1023;
                transpose_item_f8(a.in[I_WGU] + (size_t)e * 1024 * 2048, 2048, wgut + (size_t)e * 2048 * 1024, 64 * kb, n0, 256 * (j0 >> 7) + 128 * hf + (j0 & 127), pg8::WSC, scr, lane); }
            else { const int r0 = it - I_GU, e = r0 >> 9, r = r0 & 511, kb = r >> 5, nb = r & 31;
                transpose_item_f8(a.in[I_WD] + (size_t)e * 1024 * 1024, 1024, wdt + (size_t)e * 1024 * 1024, 64 * kb, 32 * nb, 32 * nb, pg8::WSC, scr, lane); }
        }
    }
}

__device__ __forceinline__ int moe_tables(const Args& a, LAS unsigned char* lds) {
    const int tid = threadIdx.x;
    LAS int* CN = (LAS int*)(lds + TAB_OFF); LAS int* TS = CN + 64; LAS int* TAB = CN + 128;
    unsigned* cntw = (unsigned*)(a.ws + WS_CTL) + CW_CNT;
    __syncthreads();
    if (tid < 32) { int c = (int)__hip_atomic_load(cntw + tid * 64, __ATOMIC_RELAXED, __HIP_MEMORY_SCOPE_AGENT); CN[tid] = c > LCAP ? LCAP : c; }
    __syncthreads();
    if (tid == 0) { int s = 0; for (int e = 0; e < 32; ++e) { TS[e] = s; s += (CN[e] + 255) >> 8; } TS[32] = s > MAXTILES ? MAXTILES : s; }
    __syncthreads();
    const int nt = TS[32];
    for (int tau = tid; tau < nt; tau += NTHR) { int e = 0;
#pragma unroll 1
        for (int k = 1; k < 32; ++k) if (TS[k] <= tau) e = k;
        TAB[tau] = (e << 16) | (tau - TS[e]); }
    __syncthreads();
    return nt;
}

__device__ __forceinline__ void p9_combine(const Args& a, LAS unsigned char* lds, int vcu, int G, bool dry = false) {
    const int tid = threadIdx.x, lane = tid & 63, wave = __builtin_amdgcn_readfirstlane(tid >> 6);
    (void)moe_tables(a, lds);
    const LAS int* TS = (const LAS int*)(lds + TAB_OFF) + 64;
    const float* mods = (const float*)(a.ws + WS_MODS); const float* fg = a.in[I_FNG]; const int* tgp = (const int*)(a.ws + WS_TGP); const unsigned char* Y = a.ws + WS_Y;
    float* O = a.out; const bf16* X1 = (const bf16*)(a.ws + WS_X1B);
    const int gw = vcu * NWAVES + wave, NGW = G * NWAVES;
    f32x4 gv[4];
#pragma unroll
    for (int j = 0; j < 4; ++j) gv[j] = *(const f32x4*)(fg + 4 * lane + 256 * j);
    for (int i0 = gw; i0 < NLAT; i0 += 2 * NGW) {
        int gpv[2][4];
#pragma unroll
        for (int r = 0; r < 2; ++r) { const int i = i0 + r * NGW; const int m = i < NLAT ? i : i0;
#pragma unroll
            for (int k = 0; k < 4; ++k) gpv[r][k] = tgp[m * 4 + k]; }
        f32x4 acc[2][4], x1v[2][4];
#pragma unroll
        for (int r = 0; r < 2; ++r) { const int i = i0 + r * NGW; const int m = i < NLAT ? i : i0;
#pragma unroll
            for (int j = 0; j < 4; ++j) { acc[r][j] = (f32x4){0.f, 0.f, 0.f, 0.f}; x1v[r][j] = ldbf4(X1 + (size_t)m * D + 4 * lane + 256 * j); }
#pragma unroll
            for (int k = 0; k < 4; ++k) { const int gp = gpv[r][k], g = (gp >> 16) & 31, pos = gp & 0xffff; const size_t prow = (size_t)TS[g] * 256 + pos;
                const int* yr = (const int*)(Y + prow * D) + lane;
#pragma unroll
                for (int j = 0; j < 4; ++j) { const int w = yr[64 * j]; const f32x2 lo = __builtin_amdgcn_cvt_pk_f32_fp8(w, false), hi = __builtin_amdgcn_cvt_pk_f32_fp8(w, true); acc[r][j] += (f32x4){lo.x, lo.y, hi.x, hi.y}; } } }
#pragma unroll
        for (int r = 0; r < 2; ++r) { const int i = i0 + r * NGW; if (i >= NLAT) continue;
            const int m = i, b = m >> 11; const float* md = mods + (size_t)b * 6144 + 5 * 1024;
            f32x4 v[4]; float s = 0.f;
#pragma unroll
            for (int j = 0; j < 4; ++j) { const f32x4 g5 = *(const f32x4*)(md + 4 * lane + 256 * j) * pg8::YSCI;
                v[j] = x1v[r][j] + g5 * acc[r][j]; s += (v[j].x * v[j].x + v[j].y * v[j].y) + (v[j].z * v[j].z + v[j].w * v[j].w); }
            const float rr = 1.0f / sqrtf(wave_sum(s) * (1.0f / D) + EPS);
#pragma unroll
            for (int j = 0; j < 4; ++j) { const f32x4 ov = v[j] * rr * gv[j]; if (!dry) *(f32x4*)(O + (size_t)m * D + 4 * lane + 256 * j) = ov; else asm volatile("" :: "v"(ov)); } }
    }
}

constexpr int NPH = 10;
__global__ void __launch_bounds__(NTHR, 2) fwd_kernel(Args args) {
    extern __shared__ __attribute__((aligned(16))) unsigned char lds_raw[];
    LAS unsigned char* lds = (LAS unsigned char*)lds_raw;
    const int tid = threadIdx.x, G = gridDim.x, bx = blockIdx.x;
    const int vcu = (G % 8 == 0) ? (bx % 8) * (G / 8) + bx / 8 : bx;
    volatile LAS unsigned* MISC = (volatile LAS unsigned*)(lds + MISC_OFF);
    if (tid < 64) MISC[tid] = 0u;
    __syncthreads();
    unsigned* ctl = (unsigned*)(args.ws + WS_CTL);
    const int lo = args.ph_lo, hi = args.ph_hi;
    XcdBarrier bar; bar.bar = ctl + CW_BAR + args.li * XCD_BAR_WORDS; bar.x = 0; bar.st = MISC + 8;
    if (hi - lo > 1) bar = xcd_barrier_post(ctl + CW_BAR + args.li * XCD_BAR_WORDS, MISC + 8);
#ifndef PHMASK
#define PHMASK 0x3ff
#endif
#define IN(k) (((PHMASK >> (k)) & 1) && lo <= (k) && (k) < hi)
#define SEAM(k) do { if (IN(k) && IN((k) + 1)) xcd_barrier(bar); } while (0)
    unsigned char* ws = args.ws;
#ifndef PROBE_DUP
#define PROBE_DUP 0
#endif
#define REPS(k) (1 + ((PROBE_DUP >> (k)) & 1))
    if (IN(0)) { for (int rep = 0; rep < REPS(0); ++rep) { p0_prologue(args, lds, vcu, G); __syncthreads(); } SEAM(0); }
    if (IN(1)) { for (int rep = 0; rep < REPS(1); ++rep) p1_norm1(args, vcu, G); p1_weight_copies(args, lds, vcu, G); SEAM(1); }
    if (IN(2)) {
        { pg8::ProbIn2<false> P{(const char*)(ws + WS_U), (const char*)(ws + WS_WIN), G, bx};
          pg8::EpiZ E{(bf16*)(ws + WS_Z), 1.0f};
          pg8::gemm_phase<pg8::EpiZ, pg8::ProbIn2<false>, true>(lds, P, E); }
        { pg8::ProbIn2<true> P{(const char*)(ws + WS_U8), (const char*)(ws + WS_WIN8), G, G - 1 - bx};
          pg8::EpiZ E{(bf16*)(ws + WS_Z), 1.0f / (USC * pg8::WSC)};
          pg8::gemm_phase<pg8::EpiZ, pg8::ProbIn2<true>, true>(lds, P, E); }
        SEAM(2);
    }
    if (IN(3)) { p3_chains(args, lds, vcu, G); if (REPS(3) > 1) { __syncthreads(); p3_chains(args, lds, vcu, G); } SEAM(3); }
    if (IN(4)) { p4_outputs(args, lds, vcu, G); if (REPS(4) > 1) { __syncthreads(); p4_outputs(args, lds, vcu, G); } SEAM(4); }
    if (IN(5)) {
        pg8::ProbDense P{(const char*)(ws + WS_U), (const char*)(ws + WS_WOUT), NLAT / 256, D / 256, G, bx};
        pg8::EpiX1 E{args.in[I_X], (const float*)(ws + WS_POS), (const float*)(ws + WS_MODS), (bf16*)(ws + WS_X1B)};
        pg8::gemm_phase<pg8::EpiX1, pg8::ProbDense, true>(lds, P, E);
        if (REPS(5) > 1) pg8::gemm_phase<pg8::EpiX1, pg8::ProbDense, true>(lds, P, E);
        SEAM(5);
    }
    if (IN(6)) { p6_router(args, lds, vcu, G);
        if (REPS(12) > 1) { xcd_barrier(bar); if (bx == 0 && tid < 64) (ctl + CW_CNT)[tid * 64] = 0u; xcd_barrier(bar); p6_router(args, lds, vcu, G); }
        p6_convert(args, lds, vcu, G); if (REPS(6) > 1) p6_convert(args, lds, vcu, G); SEAM(6); }
    if (IN(7)) {
        const int ntl = moe_tables(args, lds);
        pg8::ProbMoe<true> P{(const char*)(ws + WS_U), (const char*)(ws + WS_WGU), (const int*)(ws + WS_LTOK), (const LAS int*)(lds + TAB_OFF) + 128, (const LAS int*)(lds + TAB_OFF), ntl, 8, G, bx, (size_t)2048 * 1024, args.in[I_BGU], nullptr};
        pg8::EpiGU E{ws + WS_ACT, lds + PF_OFF};
        pg8::gemm_phase<pg8::EpiGU, pg8::ProbMoe<true>, true>(lds, P, E);
        if (REPS(7) > 1) pg8::gemm_phase<pg8::EpiGU, pg8::ProbMoe<true>, true>(lds, P, E);
        SEAM(7);
    }
    if (IN(8)) {
        const int ntl = moe_tables(args, lds);
        pg8::ProbMoe<false> P{(const char*)(ws + WS_ACT), (const char*)(ws + WS_WD), (const int*)(ws + WS_LTOK), (const LAS int*)(lds + TAB_OFF) + 128, (const LAS int*)(lds + TAB_OFF), ntl, 4, G, bx, (size_t)1024 * 1024, args.in[I_BD], (const float*)(ws + WS_LP)};
        pg8::EpiDown E{ws + WS_Y, lds + PF_OFF, (const LAS int*)(lds + TAB_OFF)};
        pg8::gemm_phase<pg8::EpiDown, pg8::ProbMoe<false>, true>(lds, P, E);
        if (REPS(8) > 1) pg8::gemm_phase<pg8::EpiDown, pg8::ProbMoe<false>, true>(lds, P, E);
        SEAM(8);
    }
    if (IN(9)) { if (REPS(9) > 1) p9_combine(args, lds, vcu, G, true); p9_combine(args, lds, vcu, G); }
#undef IN
#undef SEAM
#undef REPS
}

extern "C" void kernel_launch(void* const* d_in, const int* in_sizes, int n_in, void* d_out, int out_size, void* d_ws, size_t ws_size, hipStream_t stream) {
    static int grid = 0;
    if (grid == 0) {
        if (n_in != 24 || in_sizes[0] != NLAT * D || out_size != NLAT * D || ws_size < WS_END) { fprintf(stderr, "kernel_launch: unexpected shapes (n_in %d, in0 %d, out %d, ws %zu); nothing launched\n", n_in, n_in > 0 ? in_sizes[0] : -1, out_size, ws_size); grid = -1; return; }
        int dev = 0, cus = 0, per_cu = 0;
        if (hipGetDevice(&dev) != hipSuccess || hipDeviceGetAttribute(&cus, hipDeviceAttributeMultiprocessorCount, dev) != hipSuccess) { grid = -1; return; }
        if (hipFuncSetAttribute((const void*)fwd_kernel, hipFuncAttributeMaxDynamicSharedMemorySize, LDS_BYTES) != hipSuccess) { fprintf(stderr, "kernel_launch: hipFuncSetAttribute failed\n"); grid = -1; return; }
        if (hipOccupancyMaxActiveBlocksPerMultiprocessor(&per_cu, (const void*)fwd_kernel, NTHR, LDS_BYTES) != hipSuccess || per_cu < 1) { fprintf(stderr, "kernel_launch: occupancy query reports %d workgroups per CU\n", per_cu); }
        (void)hipGetLastError();
        grid = cus;
    }
    if (grid < 0) return;
    if (hipMemsetAsync((char*)d_ws + WS_CTL, 0, CTL_ZERO_BYTES, stream) != hipSuccess) return;
    Args a{};
    for (int i = 0; i < 24; ++i) a.in[i] = (const float*)d_in[i];
    a.out = (float*)d_out; a.ws = (unsigned char*)d_ws; a.pad = 0;
#if MK_N_LAUNCHES == 1
    a.ph_lo = 0; a.ph_hi = NPH; a.li = 0;
    hipLaunchKernelGGL(fwd_kernel, dim3(grid), dim3(NTHR), LDS_BYTES, stream, a);
#else
    for (int ph = 0; ph < NPH; ++ph) { a.ph_lo = ph; a.ph_hi = ph + 1; a.li = ph; hipLaunchKernelGGL(fwd_kernel, dim3(grid), dim3(NTHR), LDS_BYTES, stream, a); }
#endif
}
```

```cpp
#include <hip/hip_runtime.h>
#include <cstdio>
#include <cstdint>

#ifndef MK_N_LAUNCHES
#define MK_N_LAUNCHES 1
#endif

#define GAS __attribute__((address_space(1)))
#define LAS __attribute__((address_space(3)))
typedef unsigned short bf16;
typedef short bf16x8 __attribute__((ext_vector_type(8)));
typedef short s16x4 __attribute__((ext_vector_type(4)));
typedef float f32x4 __attribute__((ext_vector_type(4)));
typedef float f32x2 __attribute__((ext_vector_type(2)));
typedef unsigned u32x4 __attribute__((ext_vector_type(4)));
typedef unsigned u32x2 __attribute__((ext_vector_type(2)));

constexpr int NB = 32, T = 2048, D = 1024, CT = 256;
constexpr int NLAT = NB * T, NCTX = NB * CT, NTOK = NLAT + NCTX;
constexpr int INW = 3120, ZW = 3328;
constexpr size_t PL64 = (size_t)NTOK * 64, PL128 = (size_t)NTOK * 128;
constexpr int F_MLQ = 0, F_MLK = 1, F_GQ = 2, F_GK = 3, F_MLV = 0, F_MLO = 1, F_GV = 2, F_GG = 3;
__host__ __device__ constexpr size_t plane64(int f, int h) { return (size_t)(f * 4 + h) * PL64; }
__host__ __device__ constexpr size_t plane128(int f, int h) { return 16 * PL64 + (size_t)(f * 4 + h) * PL128; }
constexpr size_t Z_MISC = 16 * PL64 + 16 * PL128;
constexpr int M_MLG = 0, M_LR = 16;
constexpr int NE = 32, TOPK = 4, DE = 1024;
constexpr int LCAP = 65536;
constexpr int MAXTILES = 1056;
constexpr float EPS = 1e-6f;

constexpr size_t MiB = 1u << 20;
constexpr size_t WS_CTL = 0, CTL_ZERO_BYTES = 1 * MiB;
constexpr size_t WS_MODS = 1 * MiB;
constexpr size_t WS_POS = 2 * MiB;
constexpr size_t WS_WIN = 10 * MiB;
constexpr size_t WS_WOUT = 17 * MiB;
constexpr size_t WS_RWT = 19 * MiB;
constexpr size_t WS_LTOK = 20 * MiB;
constexpr size_t WS_LP = 28 * MiB;
constexpr size_t WS_TGP = 36 * MiB;
constexpr size_t WS_NST = 37 * MiB;
constexpr size_t WS_U = 40 * MiB;
constexpr size_t WS_Z = 184 * MiB;
constexpr size_t WS_ST = 652 * MiB;
constexpr size_t WS_WGU = 104 * MiB;
constexpr size_t WS_WD = 168 * MiB;
constexpr size_t WS_ACT = 200 * MiB;
constexpr size_t WS_Y = 472 * MiB;
constexpr size_t WS_X1B = 736 * MiB;
constexpr size_t WS_U8 = 652 * MiB;
constexpr size_t WS_WIN8 = 20 * MiB;
constexpr size_t WS_END = 908 * MiB;
constexpr int CW_CNT = 2048;
constexpr int CW_BAR = 8192;

constexpr int RING_BYTES = 131072;
constexpr int LDS_BYTES = 147456;
constexpr int MISC_OFF = LDS_BYTES - 256;
constexpr int TAB_OFF = RING_BYTES;
constexpr int PF_OFF = TAB_OFF + 5120, PF_SLOT = 3072;
constexpr int NWAVES = 8, NTHR = 512;

#define LDS_WAIT() asm volatile("s_waitcnt lgkmcnt(0)" ::: "memory")
#define VM_WAIT() asm volatile("s_waitcnt vmcnt(0)" ::: "memory")
#define BAR_LDS() do { asm volatile("s_waitcnt lgkmcnt(0)" ::: "memory"); __builtin_amdgcn_s_barrier(); asm volatile("" ::: "memory"); } while (0)
__device__ __forceinline__ unsigned f2bf(float f) { unsigned u = __builtin_bit_cast(unsigned, f); return (u + 0x7fffu + ((u >> 16) & 1u)) >> 16; }
__device__ __forceinline__ unsigned pk2(float lo, float hi) { unsigned r; asm("v_cvt_pk_bf16_f32 %0, %1, %2" : "=v"(r) : "v"(lo), "v"(hi)); return r; }
__device__ __forceinline__ float bf2f(unsigned short b) { return __builtin_bit_cast(float, ((unsigned)b) << 16); }
__device__ __forceinline__ float bflo(unsigned w) { return __builtin_bit_cast(float, w << 16); }
__device__ __forceinline__ float bfhi(unsigned w) { return __builtin_bit_cast(float, w & 0xffff0000u); }
__device__ __forceinline__ float fsigmoid(float x) { return __builtin_amdgcn_rcpf(1.0f + __expf(-x)); }
__device__ __forceinline__ float fsilu(float x) { return x * __builtin_amdgcn_rcpf(1.0f + __expf(-x)); }
__device__ __forceinline__ float flogsigmoid(float x) { return fminf(x, 0.f) - log1pf(__expf(-fabsf(x))); }
__device__ __forceinline__ f32x4 ldbf4(const bf16* p) { const u32x2 w = *(const u32x2*)p; return (f32x4){bflo(w.x), bfhi(w.x), bflo(w.y), bfhi(w.y)}; }
__device__ __forceinline__ float wave_sum(float v) {
#pragma unroll
    for (int o = 1; o < 64; o <<= 1) v += __shfl_xor(v, o);
    return v;
}

namespace pg8 {
#define PG8_LAS __attribute__((address_space(3)))
typedef unsigned short bf16_t;
constexpr int BM = 256, BK = 64, HALF = 128, HTB = HALF * BK * 2, STAGE_BYTES = 8 * HTB, NXCD = 8, WGM = 8, GK = 1024;
__host__ __device__ __forceinline__ int lds_byte(int r, int c) { const int st = (r >> 4) * 2 + (c >> 5), rr = r & 15, cc = c & 31, ob = rr * 64 + cc * 2; return st * 1024 + (ob ^ (((ob >> 9) & 1) << 5)); }
__host__ __device__ __forceinline__ void stage_rc(int b, int& R, int& C) { const int st = b / 1024, sb = b % 1024, swz = sb ^ (((sb >> 9) & 1) << 5); R = (st >> 1) * 16 + swz / 64; C = (st & 1) * 32 + (swz % 64) / 2; }
__host__ __device__ __forceinline__ int perm32(int rho) { const int n = rho >> 4, i = rho & 15; return 8 * (i >> 2) + 4 * n + (i & 3); }
__host__ __device__ __forceinline__ int perm32w(int rho) { const int n = rho >> 4, i = rho & 15; return 16 * (i >> 2) + 4 * n + (i & 3); }
__device__ __forceinline__ unsigned cvt_pk_bf16(float lo, float hi) { unsigned r; asm volatile("v_cvt_pk_bf16_f32 %0, %1, %2" : "=v"(r) : "v"(lo), "v"(hi)); return r; }

typedef int i32x8 __attribute__((ext_vector_type(8)));
__device__ __forceinline__ i32x8 cat16(bf16x8 a, bf16x8 b) { typedef int i32x4 __attribute__((ext_vector_type(4))); const i32x4 x = __builtin_bit_cast(i32x4, a), y = __builtin_bit_cast(i32x4, b); return __builtin_shufflevector(x, y, 0, 1, 2, 3, 4, 5, 6, 7); }
__device__ __forceinline__ void mfma_f8(f32x4& acc, const i32x8& a, const i32x8& b, int sc) {
    asm volatile("s_nop 1\n\tv_mfma_scale_f32_16x16x128_f8f6f4 %0, %1, %2, %0, %3, %3 op_sel_hi:[0,0,0]" : "+v"(acc) : "v"(a), "v"(b), "v"(sc));
}
__device__ __forceinline__ void dma16(const void* g, PG8_LAS unsigned char* l) {
    unsigned keep; const unsigned dst = (unsigned)(size_t)l;
    asm volatile("s_mov_b32 %0, m0\n\ts_mov_b32 m0, %2\n\ts_nop 0\n\tglobal_load_lds_dwordx4 %1, off\n\ts_mov_b32 m0, %0" : "=&s"(keep) : "v"(g), "s"(dst) : "memory");
}
struct Unit { int pm, pn, g, r0, slot; };

__device__ __forceinline__ bool order_next(int i, int G, int c, int nM, int nN, int& pm, int& pn, const int WGM = pg8::WGM) {
    const int nwg = nM * nN; const long L = (long)i * G + c; if (L >= nwg) return false;
    int wgid = (int)L; { const int q = nwg / NXCD, r = nwg % NXCD, xcd = wgid % NXCD, off = wgid / NXCD; wgid = (xcd < r ? xcd * (q + 1) : r * (q + 1) + (xcd - r) * q) + off; }
    const int nig = WGM * nN, gid = wgid / nig, fm = gid * WGM, gsz = (nM - fm) < WGM ? (nM - fm) : WGM;
    pm = fm + ((wgid % nig) % gsz); pn = (wgid % nig) / gsz; return true;
}

template <class Epi, class Prob, bool ALIGN_EPI>
__device__ __forceinline__ void gemm_phase(PG8_LAS unsigned char* lds, const Prob& P, const Epi& E) {
    const int tid = threadIdx.x, wid = __builtin_amdgcn_readfirstlane(tid >> 6), lane = tid & 63, wr = wid >> 2, wc = wid & 3, fr = lane & 15, fq = lane >> 4;
    constexpr bool F8 = Prob::FP8; constexpr bool CM = Epi::CMAP == 1; constexpr int NST = Epi::NST; static_assert(GK / (F8 ? 128 : 64) >= 6, "peeled K loop");
    constexpr int RSB = F8 ? GK : GK * 2, nt = RSB / 128;
    unsigned vB, vA, cA2;
    { int R, C; stage_rc(tid * 16, R, C); const int Rb = CM ? 64 * (R >> 5) + perm32w(R & 31) : Epi::PERM ? ((R & ~31) + perm32(R & 31)) : R; vB = (unsigned)(Rb * RSB + C * 2); vA = (unsigned)(R * RSB + C * 2); cA2 = (unsigned)(C * 2); }
    constexpr size_t kstep = (size_t)(BK * 2);
    constexpr size_t hstep = (size_t)(CM ? 8 : HALF) * RSB;
    const unsigned ldsw = (unsigned)wid * 1024u;
    const int aoff = lds_byte(wr * 64 + fr, fq * 8), boff = lds_byte(wc * 32 + fr, fq * 8);
#define PG8_SA(b, h) (((b) * 2 + (h)) * HTB)
#define PG8_SB(b, h) ((4 + (b) * 2 + (h)) * HTB)
#define PG8_STAGE_B(bufoff, gbase) do { _Pragma("unroll") for (int _i = 0; _i < 2; ++_i) \
        __builtin_amdgcn_global_load_lds((const unsigned*)((const char*)(gbase) + (size_t)(_i * (CM ? 128 : 64) * RSB) + vB), (PG8_LAS unsigned*)(lds + (bufoff) + ldsw + _i * 8192), 16, 0, 0); } while (0)
#define PG8_STAGE_A(bufoff, abase, tk, h) do { _Pragma("unroll") for (int _i = 0; _i < 2; ++_i) { \
        if constexpr (GATH) { const unsigned _t = _i ? ((tk)[h] >> 16) : ((tk)[h] & 0xffffu); \
            __builtin_amdgcn_global_load_lds((const unsigned*)((abase) + (size_t)(_t * (unsigned)RSB + cA2)), (PG8_LAS unsigned*)(lds + (bufoff) + ldsw + _i * 8192), 16, 0, 0); } \
        else __builtin_amdgcn_global_load_lds((const unsigned*)((abase) + (size_t)(((h) * 128 + _i * 64) * RSB) + vA), (PG8_LAS unsigned*)(lds + (bufoff) + ldsw + _i * 8192), 16, 0, 0); } } while (0)
#define PG8_LDA(dst, b, h) do { _Pragma("unroll") for (int m = 0; m < 4; ++m) _Pragma("unroll") for (int k = 0; k < 2; ++k) dst[m][k] = *(const PG8_LAS bf16x8*)(lds + PG8_SA(b, h) + aoff + m * 2048 + k * 1024); } while (0)
#define PG8_LDB(dst, b, h) do { _Pragma("unroll") for (int n = 0; n < 2; ++n) _Pragma("unroll") for (int k = 0; k < 2; ++k) dst[n][k] = *(const PG8_LAS bf16x8*)(lds + PG8_SB(b, h) + boff + n * 2048 + k * 1024); } while (0)
#define PG8_MMA(ai, bj, At, Bt) do { __builtin_amdgcn_s_setprio(1); _Pragma("unroll") for (int m = 0; m < 4; ++m) _Pragma("unroll") for (int n = 0; n < 2; ++n) { \
        if constexpr (F8) { mfma_f8(acc[ai][bj][m][n], cat16(Bt[n][0], Bt[n][1]), cat16(At[m][0], At[m][1]), sc127); } \
        else { _Pragma("unroll") for (int k = 0; k < 2; ++k) acc[ai][bj][m][n] = __builtin_amdgcn_mfma_f32_16x16x32_bf16(Bt[n][k], At[m][k], acc[ai][bj][m][n], 0, 0, 0); } } \
        __builtin_amdgcn_s_setprio(0); } while (0)
#define PG8_WAIT_V(n) asm volatile("s_waitcnt vmcnt(" #n ")" ::: "memory")
#define PG8_WAIT_VN(n) asm volatile("s_waitcnt vmcnt(%0)" :: "n"(n) : "memory")
#define PG8_WAIT_L(n) asm volatile("s_waitcnt lgkmcnt(" #n ")" ::: "memory")
#define PG8_BAR __builtin_amdgcn_s_barrier()
#define PG8_SCHED __builtin_amdgcn_sched_barrier(0)
    Unit cur, nxt; int ui = 0;
    if (!P.next(0, cur)) return;
    f32x4 acc[2][2][4][2];
#pragma unroll
    for (int a = 0; a < 2; ++a)
#pragma unroll
        for (int b = 0; b < 2; ++b)
#pragma unroll
            for (int m = 0; m < 4; ++m)
#pragma unroll
                for (int n = 0; n < 2; ++n) acc[a][b][m][n] = (f32x4){0.f, 0.f, 0.f, 0.f};
    bf16x8 At[4][2], B0[2][2], B1[2][2];
    constexpr bool GATH = Prob::GATHERS;
    int sc127 = 127; asm volatile("" : "+v"(sc127));
    unsigned tc[2] = {0u, 0u}, tn[2] = {0u, 0u};
    constexpr bool PF = Prob::PREFETCH;
    cur.slot = 0;
    if constexpr (PF) { P.pf_issue(cur, 0, wid, lane, lds); PG8_WAIT_V(0); PG8_BAR; asm volatile("" ::: "memory"); }
    if constexpr (GATH) P.a_tok(cur, tid, tc, lds);
    const char* cA = P.a_ptr(cur);
    const char* cB = P.b_ptr(cur);
    PG8_STAGE_B(PG8_SB(0, 0), cB); PG8_STAGE_B(PG8_SB(0, 1), cB + hstep); PG8_STAGE_A(PG8_SA(0, 0), cA, tc, 0); PG8_STAGE_A(PG8_SA(0, 1), cA, tc, 1);
    if (wr == 1) PG8_BAR;
    PG8_WAIT_V(2); PG8_BAR;
    PG8_STAGE_B(PG8_SB(1, 0), cB + kstep); PG8_STAGE_A(PG8_SA(1, 0), cA + kstep, tc, 0); PG8_STAGE_B(PG8_SB(1, 1), cB + hstep + kstep); PG8_STAGE_A(PG8_SA(1, 1), cA + kstep, tc, 1);
    PG8_WAIT_V(0); PG8_BAR;
    bool relax = false;
    for (;;) {
        const bool has_next = P.next(ui + 1, nxt);
        const char* nB = cB; const char* nA = cA;
        nxt.slot = (ui + 1) % 3;
        if (has_next) { if constexpr (PF) P.pf_issue(nxt, nxt.slot, wid, lane, lds); nA = P.a_ptr(nxt); nB = P.b_ptr(nxt); }
        tn[0] = tc[0]; tn[1] = tc[1];
        {
            const char* a2 = cA + (size_t)2 * kstep; const char* a3 = a2 + kstep; const char* b2 = cB + (size_t)2 * kstep; const char* b3 = b2 + kstep;
            PG8_LDB(B0, 0, 0); PG8_LDB(B1, 0, 1); PG8_SCHED; PG8_LDA(At, 0, 0);
            if (relax) PG8_WAIT_VN(8 + NST); else PG8_WAIT_V(8);
            PG8_WAIT_L(0); PG8_BAR; PG8_MMA(0, 0, At, B0); PG8_MMA(0, 1, At, B1); PG8_BAR; PG8_SCHED;
            PG8_LDA(At, 0, 1); PG8_STAGE_B(PG8_SB(0, 0), b2); PG8_STAGE_B(PG8_SB(0, 1), b2 + hstep); PG8_STAGE_A(PG8_SA(0, 0), a2, tc, 0);
            if (relax) PG8_WAIT_VN(8 + NST); else PG8_WAIT_V(8);
            PG8_WAIT_L(0); PG8_BAR; PG8_MMA(1, 0, At, B0); PG8_MMA(1, 1, At, B1); PG8_BAR; PG8_SCHED;
            PG8_LDB(B0, 1, 0); PG8_LDB(B1, 1, 1); PG8_SCHED; PG8_LDA(At, 1, 0); PG8_STAGE_A(PG8_SA(0, 1), a2, tc, 1);
            if (relax) PG8_WAIT_VN(8 + NST); else PG8_WAIT_V(8);
            PG8_WAIT_L(0); PG8_BAR; PG8_MMA(0, 0, At, B0); PG8_MMA(0, 1, At, B1); PG8_BAR; PG8_SCHED;
            PG8_LDA(At, 1, 1); PG8_STAGE_B(PG8_SB(1, 0), b3); PG8_STAGE_B(PG8_SB(1, 1), b3 + hstep); PG8_STAGE_A(PG8_SA(1, 0), a3, tc, 0);
            if (relax) PG8_WAIT_VN(8); else PG8_WAIT_V(8);
            PG8_WAIT_L(0); PG8_BAR; PG8_MMA(1, 0, At, B0); PG8_MMA(1, 1, At, B1); PG8_BAR; PG8_SCHED;
        }
#pragma unroll 1
        for (int t = 2; t < nt; t += 2) {
            const bool last = (t == nt - 2);
            if constexpr (GATH) { if (t == nt - 4 && has_next) P.a_tok(nxt, tid, tn, lds); }
            const char* a1 = cA + (size_t)(t + 1) * kstep;
            const char* a2 = last ? nA : cA + (size_t)(t + 2) * kstep; const char* a3 = a2 + kstep;
            const char* b2 = last ? nB : cB + (size_t)(t + 2) * kstep; const char* b3 = b2 + kstep;
            PG8_LDB(B0, 0, 0); PG8_LDB(B1, 0, 1); PG8_SCHED; PG8_LDA(At, 0, 0); PG8_STAGE_A(PG8_SA(1, 1), a1, tc, 1);
            PG8_WAIT_V(8); PG8_WAIT_L(0); PG8_BAR; PG8_MMA(0, 0, At, B0); PG8_MMA(0, 1, At, B1); PG8_BAR; PG8_SCHED;
            PG8_LDA(At, 0, 1); PG8_STAGE_B(PG8_SB(0, 0), b2); PG8_STAGE_B(PG8_SB(0, 1), b2 + hstep); { unsigned t2[2] = {last ? tn[0] : tc[0], last ? tn[1] : tc[1]}; PG8_STAGE_A(PG8_SA(0, 0), a2, t2, 0); }
            PG8_WAIT_V(8); PG8_WAIT_L(0); PG8_BAR; PG8_MMA(1, 0, At, B0); PG8_MMA(1, 1, At, B1); PG8_BAR; PG8_SCHED;
            PG8_LDB(B0, 1, 0); PG8_LDB(B1, 1, 1); PG8_SCHED; PG8_LDA(At, 1, 0); { unsigned t2[2] = {last ? tn[0] : tc[0], last ? tn[1] : tc[1]}; PG8_STAGE_A(PG8_SA(0, 1), a2, t2, 1); }
            PG8_WAIT_V(8); PG8_WAIT_L(0); PG8_BAR; PG8_MMA(0, 0, At, B0); PG8_MMA(0, 1, At, B1); PG8_BAR; PG8_SCHED;
            PG8_LDA(At, 1, 1); PG8_STAGE_B(PG8_SB(1, 0), b3); PG8_STAGE_B(PG8_SB(1, 1), b3 + hstep); { unsigned t2[2] = {last ? tn[0] : tc[0], last ? tn[1] : tc[1]}; PG8_STAGE_A(PG8_SA(1, 0), a3, t2, 0); }
            PG8_WAIT_V(8); PG8_WAIT_L(0); PG8_BAR; PG8_MMA(1, 0, At, B0); PG8_MMA(1, 1, At, B1); PG8_BAR; PG8_SCHED;
        }
        PG8_STAGE_A(PG8_SA(1, 1), nA + kstep, tn, 1);
        if constexpr (ALIGN_EPI) { if (wr == 0) PG8_BAR; }
        E(acc, cur, wr, wc, fr, fq);
        if (!has_next) break;
        relax = NST > 0 && E.full(cur, wc);
#pragma unroll
        for (int a = 0; a < 2; ++a)
#pragma unroll
            for (int b = 0; b < 2; ++b)
#pragma unroll
                for (int m = 0; m < 4; ++m)
#pragma unroll
                    for (int n = 0; n < 2; ++n) acc[a][b][m][n] = (f32x4){0.f, 0.f, 0.f, 0.f};
        cur = nxt; cB = nB; cA = nA; ++ui; tc[0] = tn[0]; tc[1] = tn[1];
        if constexpr (ALIGN_EPI) { if (wr == 1) PG8_BAR; }
    }
    PG8_WAIT_V(0);
    if constexpr (!ALIGN_EPI) { if (wr == 0) PG8_BAR; }
    PG8_BAR;
#undef PG8_SA
#undef PG8_SB
#undef PG8_STAGE_A
#undef PG8_STAGE_B
#undef PG8_LDA
#undef PG8_LDB
#undef PG8_MMA
#undef PG8_WAIT_V
#undef PG8_WAIT_VN
#undef PG8_WAIT_L
#undef PG8_BAR
#undef PG8_SCHED
}
}

#define XB_TMO      128
#define XB_XCNT(j)  (256  + 64 * (j))
#define XB_XSUB(j)  (1280 + 64 * (j))
#define XB_XGEN(j)  (2304 + 64 * (j))
#define XB_TOP      3328
#define XB_TOPGEN   3392
#define XCD_BAR_WORDS 3456
#define XB_SPIN_CAP (1u << 18)
__device__ __forceinline__ unsigned xb_ld(unsigned* p)              { return __hip_atomic_load(p, __ATOMIC_RELAXED, __HIP_MEMORY_SCOPE_AGENT); }
__device__ __forceinline__ unsigned xb_add(unsigned* p, unsigned v) { return __hip_atomic_fetch_add(p, v, __ATOMIC_RELAXED, __HIP_MEMORY_SCOPE_AGENT); }
__device__ __forceinline__ unsigned xb_xcc_id() { return (unsigned)__builtin_amdgcn_s_getreg((3 << 11) | 20) & 0xFu; }
#define XB_SPIN(cond, bar) do { unsigned _sp = 0; while (cond) { __builtin_amdgcn_s_sleep(1); \
    if ((++_sp & 255u) == 0u) { if (xb_ld(&(bar)[XB_TMO])) break; if (_sp > XB_SPIN_CAP) { atomicAdd(&(bar)[XB_TMO], 1u); break; } } } } while (0)
struct XcdBarrier { unsigned* bar; unsigned x; volatile LAS unsigned* st; };
__device__ __forceinline__ XcdBarrier xcd_barrier_post(unsigned* bar, volatile LAS unsigned* st) {
    XcdBarrier b; b.bar = bar; b.x = xb_xcc_id(); b.st = st;
    if (threadIdx.x == 0) (void)xb_add(&bar[XB_XCNT(b.x)], 1u);
    return b;
}
__device__ __forceinline__ void xcd_barrier_complete(unsigned* bar, unsigned x, unsigned& nloc, unsigned& nx) {
    const unsigned G = gridDim.x * gridDim.y * gridDim.z;
    unsigned sum, cnt, mine, sp = 0u;
    for (;;) {
        sum = 0u; cnt = 0u; mine = 0u;
#pragma unroll
        for (unsigned j = 0; j < 16; ++j) { const unsigned c = xb_ld(&bar[XB_XCNT(j)]); sum += c; cnt += (c > 0u) ? 1u : 0u; mine = (j == x) ? c : mine; }
        if (sum == G) break;
        __builtin_amdgcn_s_sleep(1);
        if ((++sp & 255u) == 0u) { if (xb_ld(&bar[XB_TMO])) break; if (sp > XB_SPIN_CAP) { atomicAdd(&bar[XB_TMO], 1u); break; } }
    }
    nloc = mine > 0u ? mine : 1u; nx = cnt > 0u ? cnt : 1u;
}
__device__ __forceinline__ void xcd_barrier(const XcdBarrier& b) {
    asm volatile("s_waitcnt vmcnt(0)" ::: "memory");
    __syncthreads();
    if (threadIdx.x == 0) {
        unsigned* bar = b.bar;
        __builtin_amdgcn_s_waitcnt(0);
        unsigned nloc = b.st[0], nx = b.st[1];
        if (nloc == 0u) { xcd_barrier_complete(bar, b.x, nloc, nx); b.st[0] = nloc; b.st[1] = nx; }
        const unsigned old = xb_add(&bar[XB_XSUB(b.x)], 1u);
        const unsigned gen = old / nloc;
        if (old + 1u == (gen + 1u) * nloc) {
            __builtin_amdgcn_fence(__ATOMIC_RELEASE, "agent");
            asm volatile("s_waitcnt vmcnt(0)" ::: "memory");
            const unsigned og = xb_add(&bar[XB_TOP], 1u);
            const unsigned tg = og / nx;
            if (og + 1u == (tg + 1u) * nx) xb_add(&bar[XB_TOPGEN], 1u);
            else XB_SPIN(xb_ld(&bar[XB_TOPGEN]) == tg, bar);
            __builtin_amdgcn_fence(__ATOMIC_ACQUIRE, "agent");
            xb_add(&bar[XB_XGEN(b.x)], 1u);
            asm volatile("s_waitcnt vmcnt(0)" ::: "memory");
        } else {
            XB_SPIN(xb_ld(&bar[XB_XGEN(b.x)]) == gen, bar);
            __builtin_amdgcn_fence(__ATOMIC_ACQUIRE, "agent");
            asm volatile("s_waitcnt vmcnt(0)" ::: "memory");
        }
    }
    __syncthreads();
}

namespace pg8 {
struct ProbDense {
    static constexpr bool FP8 = false, GATHERS = false, PREFETCH = false; const char* A; const char* Bt; int nM, nN, G, c;
    __device__ __forceinline__ bool next(int i, Unit& u) const { u.g = 0; u.r0 = 0; return order_next(i, G, c, nM, nN, u.pm, u.pn); }
    __device__ __forceinline__ const char* a_ptr(const Unit& u) const { return A + (size_t)u.pm * (256 * 2048); }
    __device__ __forceinline__ void a_tok(const Unit&, int, unsigned (&)[2], PG8_LAS unsigned char*) const {}
    __device__ __forceinline__ const char* b_ptr(const Unit& u) const { return Bt + (size_t)u.pn * (256 * 2048); }
};
struct ProbIn {
    static constexpr bool FP8 = false, GATHERS = false, PREFETCH = false; const char* A; const char* Bt; int G, c;
    __device__ __forceinline__ bool next(int i, Unit& u) const { u.g = 0; u.r0 = 0;
        const int L = i * G + c;
        if (L < 256 * 13) return order_next(i, G, c, 256, 13, u.pm, u.pn);
        const int L2 = L - 256 * 13; if (L2 >= 32 * 7) return false;
        const int k = L2 % 7; u.pm = 256 + L2 / 7; u.pn = k < 3 ? k + 1 : k < 6 ? k + 4 : 12; return true; }
    __device__ __forceinline__ const char* a_ptr(const Unit& u) const { return A + (size_t)u.pm * (256 * 2048); }
    __device__ __forceinline__ void a_tok(const Unit&, int, unsigned (&)[2], PG8_LAS unsigned char*) const {}
    __device__ __forceinline__ const char* b_ptr(const Unit& u) const { return Bt + (size_t)u.pn * (256 * 2048); }
};
template <bool F8> struct ProbIn2 {
    static constexpr bool FP8 = F8, GATHERS = false, PREFETCH = false; const char* A; const char* Bt; int G, c;
    static constexpr int NT = F8 ? 8 : 5, NC = F8 ? 4 : 3, RS = F8 ? 1024 : 2048;
    __device__ __forceinline__ bool next(int i, Unit& u) const { u.g = 0; u.r0 = 0;
        const int L = i * G + c; int k;
        if (L < 256 * NT) { if (!order_next(i, G, c, 256, NT, u.pm, k)) return false; u.pn = F8 ? (k < 4 ? 2 + k : 4 + k) : (k < 2 ? k : k < 4 ? k + 4 : 12); return true; }
        const int L2 = L - 256 * NT; if (L2 >= 32 * NC) return false;
        k = L2 % NC; u.pm = 256 + L2 / NC; u.pn = F8 ? (k < 2 ? 2 + k : 6 + k) : (k == 0 ? 1 : k == 1 ? 7 : 12); return true; }
    __device__ __forceinline__ const char* a_ptr(const Unit& u) const { return A + (size_t)u.pm * (256 * RS); }
    __device__ __forceinline__ void a_tok(const Unit&, int, unsigned (&)[2], PG8_LAS unsigned char*) const {}
    __device__ __forceinline__ const char* b_ptr(const Unit& u) const { return Bt + (size_t)u.pn * (256 * RS); }
};
template <bool GATHER> struct ProbMoe {
    static constexpr bool FP8 = true, GATHERS = GATHER, PREFETCH = true;
    const char* A; const char* W; const int* ltok; const LAS int* tab; const LAS int* cnts; int nM, nN, G, c; size_t wstride; const float* bias; const float* lp;
    __device__ __forceinline__ bool next(int i, Unit& u) const {
        if (!order_next(i, G, c, nM, nN, u.pm, u.pn, GATHER ? 4 : 8)) return false;
        const int e = tab[u.pm]; u.g = e >> 16; u.r0 = (e & 0xffff) * 256; return true;
    }
    __device__ __forceinline__ const char* a_ptr(const Unit& u) const { return GATHER ? A : A + (size_t)u.pm * (256 * 1024); }
    __device__ __forceinline__ void pf_issue(const Unit& u, int slot, int wid, int lane, PG8_LAS unsigned char* lds) const {
        PG8_LAS unsigned char* sl = lds + PF_OFF + slot * PF_SLOT;
        if (GATHER && wid == 0) dma16(ltok + (size_t)u.g * LCAP + u.r0 + 4 * lane, sl);
        if (wid == 1) { const float* src = GATHER ? bias + (size_t)(u.g & 31) * 2048 + (lane >> 5) * 1024 + u.pn * 128 + (lane & 31) * 4 : bias + (size_t)(u.g & 31) * 1024 + u.pn * 256 + lane * 4; dma16(src, sl + 1024); }
        if (!GATHER && wid == 2) dma16(lp + (size_t)u.g * LCAP + u.r0 + 4 * lane, sl + 2048);
    }
    __device__ __forceinline__ void a_tok(const Unit& u, int tid, unsigned (&tk)[2], PG8_LAS unsigned char* lds) const {
        if constexpr (GATHER) {
            int R, C; stage_rc(tid * 16, R, C); (void)C; const int cnt = cnts[u.g]; const PG8_LAS int* T = (const PG8_LAS int*)(lds + PF_OFF + u.slot * PF_SLOT);
#pragma unroll
            for (int h = 0; h < 2; ++h) { unsigned t[2];
#pragma unroll
                for (int i = 0; i < 2; ++i) { const int row = h * 128 + i * 64 + R; const int tok = T[row]; t[i] = (u.r0 + row < cnt) ? (unsigned)tok : 0u; }
                tk[h] = t[0] | (t[1] << 16); }
        }
    }
    __device__ __forceinline__ const char* b_ptr(const Unit& u) const { return W + (size_t)(u.g & 31) * wstride + (size_t)u.pn * (256 * 1024); }
};

struct EpiZ {
    static constexpr bool PERM = true; static constexpr int CMAP = 0, NST = 16; bf16_t* O; float sc;
    __device__ __forceinline__ bool full(const Unit& u, int) const { return u.pn != 12; }
    __device__ __forceinline__ void operator()(const f32x4 (&acc)[2][2][4][2], const Unit& u, int wr, int wc, int fr, int fq) const {
        const int row0 = u.pm * BM + wr * 64 + fr, pn = u.pn;
        int kind, f, hb;
        if (pn == 0) { kind = 0; f = F_MLQ; hb = 0; } else if (pn == 1) { kind = 0; f = F_MLK; hb = 0; } else if (pn == 6) { kind = 0; f = F_GQ; hb = 0; } else if (pn == 7) { kind = 0; f = F_GK; hb = 0; }
        else if (pn < 4) { kind = 1; f = F_MLV; hb = 2 * (pn - 2); } else if (pn < 6) { kind = 1; f = F_MLO; hb = 2 * (pn - 4); } else if (pn < 10) { kind = 1; f = F_GV; hb = 2 * (pn - 8); }
        else if (pn < 12) { kind = 1; f = F_GG; hb = 2 * (pn - 10); } else { kind = 2; f = 0; hb = 0; }
#pragma unroll
        for (int bj = 0; bj < 2; ++bj) {
            bf16_t* base; int pitch; bool ok = true;
            if (kind == 0) { base = O + plane64(f, 2 * bj + (wc >> 1)) + (wc & 1) * 32 + 8 * fq; pitch = 64; }
            else if (kind == 1) { base = O + plane128(f, hb + bj) + wc * 32 + 8 * fq; pitch = 128; }
            else { base = O + Z_MISC + wc * 32 + 8 * fq; pitch = 64; ok = (bj == 0) && (wc < 2); }
            if (ok) {
#pragma unroll
                for (int ai = 0; ai < 2; ++ai)
#pragma unroll
                    for (int m = 0; m < 4; ++m) { const f32x4 v0 = acc[ai][bj][m][0] * sc, v1 = acc[ai][bj][m][1] * sc;
                        u32x4 w; w.x = cvt_pk_bf16(v0[0], v0[1]); w.y = cvt_pk_bf16(v0[2], v0[3]); w.z = cvt_pk_bf16(v1[0], v1[1]); w.w = cvt_pk_bf16(v1[2], v1[3]);
                        *(u32x4*)(base + (size_t)(row0 + ai * HALF + m * 16) * pitch) = w; } }
        }
    }
};
struct EpiX1 {
    static constexpr bool PERM = true; static constexpr int CMAP = 0, NST = 16; const float* x; const float* pos; const float* mods; bf16_t* O;
    __device__ __forceinline__ bool full(const Unit&, int) const { return true; }
    __device__ __forceinline__ void operator()(const f32x4 (&acc)[2][2][4][2], const Unit& u, int wr, int wc, int fr, int fq) const {
        const int row0 = u.pm * BM + wr * 64 + fr, col0 = u.pn * BM + wc * 32 + 8 * fq;
        const int b = (u.pm * BM) >> 11;
        const float* g1 = mods + (size_t)b * 6144 + 2 * 1024 + col0;
        f32x4 gv[2][2];
#pragma unroll
        for (int bj = 0; bj < 2; ++bj)
#pragma unroll
            for (int n = 0; n < 2; ++n) gv[bj][n] = *(const f32x4*)(g1 + bj * HALF + 4 * n);
#pragma unroll
        for (int ai = 0; ai < 2; ++ai)
#pragma unroll
            for (int m = 0; m < 4; ++m) { const int row = row0 + ai * HALF + m * 16; const size_t off = (size_t)row * D + col0; const float* pp = pos + (size_t)(row & (T - 1)) * D + col0;
#pragma unroll
                for (int bj = 0; bj < 2; ++bj) { f32x4 r[2];
#pragma unroll
                    for (int n = 0; n < 2; ++n) { const f32x4 xv = *(const f32x4*)(x + off + bj * HALF + 4 * n); const f32x4 pv = *(const f32x4*)(pp + bj * HALF + 4 * n); r[n] = xv + pv + gv[bj][n] * acc[ai][bj][m][n]; }
                    u32x4 w; w.x = cvt_pk_bf16(r[0][0], r[0][1]); w.y = cvt_pk_bf16(r[0][2], r[0][3]); w.z = cvt_pk_bf16(r[1][0], r[1][1]); w.w = cvt_pk_bf16(r[1][2], r[1][3]);
                    *(u32x4*)(O + off + bj * HALF) = w; }
                if (m & 1) asm volatile("" ::: "memory"); }
    }
};
__device__ __forceinline__ unsigned pk4_fp8(float a, float b, float c, float d) { int w = 0; w = __builtin_amdgcn_cvt_pk_fp8_f32(a, b, w, false); w = __builtin_amdgcn_cvt_pk_fp8_f32(c, d, w, true); return (unsigned)w; }
constexpr float WSC = 32.0f, WSCI = 1.0f / 32.0f;
struct EpiGU {
    static constexpr bool PERM = true; static constexpr int CMAP = 0, NST = 8; unsigned char* O; PG8_LAS unsigned char* pf;
    __device__ __forceinline__ bool full(const Unit&, int) const { return true; }
    __device__ __forceinline__ void operator()(const f32x4 (&acc)[2][2][4][2], const Unit& u, int wr, int wc, int fr, int fq) const {
        const int row0 = u.pm * BM + wr * 64 + fr, j0 = u.pn * HALF + wc * 32 + 8 * fq;
        const PG8_LAS float* bg = (const PG8_LAS float*)(pf + u.slot * PF_SLOT + 1024) + wc * 32 + 8 * fq;
        f32x4 bgv[2], buv[2];
#pragma unroll
        for (int n = 0; n < 2; ++n) { bgv[n] = *(const PG8_LAS f32x4*)(bg + 4 * n); buv[n] = *(const PG8_LAS f32x4*)(bg + 128 + 4 * n) + 1.0f; }
        typedef float f32x2 __attribute__((ext_vector_type(2)));
        constexpr float NC = -1.702f * 1.44269504088896f;
#pragma unroll
        for (int ai = 0; ai < 2; ++ai)
#pragma unroll
            for (int m = 0; m < 4; ++m) { unsigned char* rowp = O + (size_t)(row0 + ai * HALF + m * 16) * DE + j0; float r[8];
#pragma unroll
                for (int n = 0; n < 2; ++n) { const f32x4 gt = acc[ai][0][m][n] * WSCI + bgv[n], up = acc[ai][1][m][n] * WSCI + buv[n];
#pragma unroll
                    for (int i = 0; i < 4; i += 2) { const f32x2 g = {fminf(gt[i], 7.0f), fminf(gt[i + 1], 7.0f)}, uu = {fminf(fmaxf(up[i], -6.0f), 8.0f), fminf(fmaxf(up[i + 1], -6.0f), 8.0f)};
                        const f32x2 t = g * NC; const f32x2 d = (f32x2){__builtin_amdgcn_exp2f(t[0]), __builtin_amdgcn_exp2f(t[1])} + 1.0f;
                        const f32x2 rc = {__builtin_amdgcn_rcpf(d[0]), __builtin_amdgcn_rcpf(d[1])}; const f32x2 o = (g * uu) * rc; r[4 * n + i] = o[0]; r[4 * n + i + 1] = o[1]; } }
                u32x2 w; w.x = pk4_fp8(r[0], r[1], r[2], r[3]); w.y = pk4_fp8(r[4], r[5], r[6], r[7]);
                *(u32x2*)rowp = w; }
    }
};
constexpr float YSC = 16.0f, YSCI = 1.0f / 16.0f;
#ifndef YST_NT
#define YST_NT 0
#endif
#if YST_NT
#define YST(p_, w_) __builtin_nontemporal_store((w_), (u32x4*)(p_))
#else
#define YST(p_, w_) (*(u32x4*)(p_) = (w_))
#endif
struct EpiDown {
    static constexpr bool PERM = true; static constexpr int CMAP = 1, NST = 8; unsigned char* O; PG8_LAS unsigned char* pf; const LAS int* cnts;
    __device__ __forceinline__ bool full(const Unit&, int) const { return true; }
    __device__ __forceinline__ void operator()(const f32x4 (&acc)[2][2][4][2], const Unit& u, int wr, int wc, int fr, int fq) const {
        const int row0 = u.pm * BM + wr * 64 + fr, col0 = u.pn * BM + wc * 64 + 16 * fq;
        const PG8_LAS float* bb = (const PG8_LAS float*)(pf + u.slot * PF_SLOT + 1024) + wc * 64 + 16 * fq; const PG8_LAS float* lpl = (const PG8_LAS float*)(pf + u.slot * PF_SLOT + 2048); const int cnt = cnts[u.g];
        f32x4 bv[2][2]; float pv[2][4];
#pragma unroll
        for (int ai = 0; ai < 2; ++ai)
#pragma unroll
            for (int m = 0; m < 4; ++m) pv[ai][m] = lpl[wr * 64 + fr + ai * HALF + m * 16];
#pragma unroll
        for (int bj = 0; bj < 2; ++bj)
#pragma unroll
            for (int n = 0; n < 2; ++n) bv[bj][n] = *(const PG8_LAS f32x4*)(bb + bj * 8 + 4 * n);
#pragma unroll
        for (int ai = 0; ai < 2; ++ai)
#pragma unroll
            for (int m = 0; m < 4; ++m) { const int rt = wr * 64 + fr + ai * HALF + m * 16; const float p = (u.r0 + rt < cnt) ? pv[ai][m] * YSC : 0.f;
                unsigned char* rowp = O + (size_t)(row0 + ai * HALF + m * 16) * D + col0; u32x4 w;
#pragma unroll
                for (int bj = 0; bj < 2; ++bj) { const f32x4 v0 = (acc[ai][bj][m][0] * WSCI + bv[bj][0]) * p, v1 = (acc[ai][bj][m][1] * WSCI + bv[bj][1]) * p;
                    w[2 * bj] = pk4_fp8(v0[0], v0[1], v0[2], v0[3]); w[2 * bj + 1] = pk4_fp8(v1[0], v1[1], v1[2], v1[3]); }
                YST(rowp, w); }
    }
};
}

struct Args { const float* in[24]; float* out; unsigned char* ws; int ph_lo, ph_hi, li, pad; };
enum { I_X = 0, I_C, I_CTX, I_CCTX, I_ADAW, I_ADAB, I_N1G, I_WIN, I_CONVW, I_CONVB, I_MLGB, I_MLNG, I_GW2, I_GGB, I_GNG, I_WOUT, I_N2G, I_RW, I_RB, I_WGU, I_BGU, I_WD, I_BD, I_FNG };

__device__ __forceinline__ void transpose_item(const float* W, int N, bf16* WT, int k0, int n0, int orow0, LAS float* scr, int lane, int orow1 = -1) {
    if (orow1 < 0) orow1 = orow0 + 16;
    const int n = n0 + (lane & 31);
#pragma unroll 8
    for (int i = 0; i < 32; ++i) { const int kk = 2 * i + (lane >> 5); float v = 0.f; if (n < N) v = W[(size_t)(k0 + kk) * N + n]; scr[kk * 33 + (lane & 31)] = v; }
    LDS_WAIT(); asm volatile("" ::: "memory");
    const int c = lane & 7;
#pragma unroll
    for (int j = 0; j < 4; ++j) { const int nn = (lane >> 3) + 8 * j; const LAS float* s = scr + (8 * c) * 33 + nn;
        u32x4 o; o.x = pk2(s[0 * 33], s[1 * 33]); o.y = pk2(s[2 * 33], s[3 * 33]); o.z = pk2(s[4 * 33], s[5 * 33]); o.w = pk2(s[6 * 33], s[7 * 33]);
        *(u32x4*)(WT + (size_t)(nn < 16 ? orow0 + nn : orow1 + nn - 16) * 1024 + k0 + 8 * c) = o; }
    LDS_WAIT(); asm volatile("" ::: "memory");
}

__device__ __forceinline__ void transpose_item_f8(const float* W, int N, unsigned char* WT, int k0, int n0, int orow0, float sc, LAS float* scr, int lane) {
    const int n = n0 + (lane & 31);
#pragma unroll 8
    for (int i = 0; i < 32; ++i) { const int kk = 2 * i + (lane >> 5); float v = 0.f; if (n < N) v = W[(size_t)(k0 + kk) * N + n]; scr[kk * 33 + (lane & 31)] = v * sc; }
    LDS_WAIT(); asm volatile("" ::: "memory");
    const int c = lane & 7;
#pragma unroll
    for (int j = 0; j < 4; ++j) { const int nn = (lane >> 3) + 8 * j; const LAS float* s = scr + (8 * c) * 33 + nn;
        u32x2 o; o.x = pg8::pk4_fp8(s[0 * 33], s[1 * 33], s[2 * 33], s[3 * 33]); o.y = pg8::pk4_fp8(s[4 * 33], s[5 * 33], s[6 * 33], s[7 * 33]);
        *(u32x2*)(WT + (size_t)(orow0 + nn) * 1024 + k0 + 8 * c) = o; }
    LDS_WAIT(); asm volatile("" ::: "memory");
}

__host__ __device__ constexpr int zperm(int n) { return n < 1536 ? n : n < 1552 ? 3072 + (n - 1536) : n < 3088 ? n - 16 : n; }
__device__ __forceinline__ void p0_prologue(const Args& a, LAS unsigned char* lds, int vcu, int G) {
    const int tid = threadIdx.x, lane = tid & 63, wave = __builtin_amdgcn_readfirstlane(tid >> 6);
    unsigned char* ws = a.ws;
    {
        float* mods = (float*)(ws + WS_MODS);
        const float* c = a.in[I_C]; const float* cc = a.in[I_CCTX]; const float* aw = a.in[I_ADAW]; const float* ab = a.in[I_ADAB];
        LAS float* sl = (LAS float*)lds + wave * 4224;
        for (int item = vcu; item < 96; item += G) {
            const int n0 = item * 64;
            for (int idx = lane; idx < 33 * 128; idx += 64) { const int r = idx >> 7, kk = idx & 127, k = 128 * wave + kk; const float cv = r < 32 ? c[r * 1024 + k] : cc[k]; sl[idx] = fsilu(cv); }
            LDS_WAIT(); asm volatile("" ::: "memory");
            float acc[33];
#pragma unroll
            for (int r = 0; r < 33; ++r) acc[r] = 0.f;
            const float* wp = aw + (size_t)(128 * wave) * 6144 + n0 + lane;
            for (int kk = 0; kk < 128; kk += 4) {
                const float w0 = wp[(size_t)(kk + 0) * 6144], w1 = wp[(size_t)(kk + 1) * 6144], w2 = wp[(size_t)(kk + 2) * 6144], w3 = wp[(size_t)(kk + 3) * 6144];
#pragma unroll
                for (int r = 0; r < 33; ++r) { const f32x4 s = *(const LAS f32x4*)(sl + r * 128 + kk); acc[r] += s[0] * w0 + s[1] * w1 + s[2] * w2 + s[3] * w3; }
            }
            __syncthreads();
            LAS float* red = (LAS float*)lds;
#pragma unroll
            for (int r = 0; r < 33; ++r) red[(wave * 33 + r) * 64 + lane] = acc[r];
            __syncthreads();
            for (int idx = tid; idx < 33 * 64; idx += NTHR) { const int r = idx >> 6, l = idx & 63; float s = ab[n0 + l];
#pragma unroll
                for (int w = 0; w < 8; ++w) s += red[(w * 33 + r) * 64 + l];
                mods[(size_t)r * 6144 + n0 + l] = s; }
            __syncthreads();
        }
    }
    const int gw = vcu * NWAVES + wave, NGW = G * NWAVES;
    {
        float* pos = (float*)(ws + WS_POS);
        for (int t = gw; t < T; t += NGW) { const float rr = (float)(t >> 6), cl = (float)(t & 63);
#pragma unroll
            for (int j = 0; j < 16; ++j) { const int d = lane + 64 * j; const int q = d >> 8, i = d & 255;
                const float om = exp2f(-13.287712379549449f * (float)i * (1.0f / 256.0f));
                const float ang = ((q < 2) ? rr : cl) * om * 0.15915494309189535f;
                const float v = (q & 1) ? __builtin_amdgcn_cosf(ang) : __builtin_amdgcn_sinf(ang);
                pos[(size_t)t * D + d] = v; } }
    }
}

__device__ __forceinline__ void p1_weight_copies(const Args& a, LAS unsigned char* lds, int vcu, int G) {
    const int tid = threadIdx.x, lane = tid & 63, wave = __builtin_amdgcn_readfirstlane(tid >> 6);
    unsigned char* ws = a.ws;
    const int gw = vcu * NWAVES + wave, NGW = G * NWAVES;
    {
        LAS float* scr = (LAS float*)(lds + wave * 16384);
        bf16* wint = (bf16*)(ws + WS_WIN); bf16* woutt = (bf16*)(ws + WS_WOUT);
        constexpr int I_IN = 16 * 104, I_OUT = 16 * 32;
        for (int it = gw; it < I_IN + I_OUT; it += NGW) {
            if (it < I_IN) { const int kb = it / 104, nb = it % 104, n0 = 32 * nb;
                transpose_item(a.in[I_WIN], INW, wint, 64 * kb, n0, zperm(n0), scr, lane, zperm(n0 + 16)); }
            else { const int r = it - I_IN, kb = r / 32, nb = r % 32; transpose_item(a.in[I_WOUT], D, woutt, 64 * kb, 32 * nb, 32 * nb, scr, lane); }
        }
        for (int it = gw; it < 16 * 64; it += NGW) { const int kb = it >> 6, nb = it & 63, g0 = nb < 32 ? 512 + 32 * nb : 2048 + 32 * (nb - 32), n0 = g0 < 1536 ? g0 : g0 + 16;
            transpose_item_f8(a.in[I_WIN], INW, ws + WS_WIN8, 64 * kb, n0, g0, pg8::WSC, (LAS float*)(lds + wave * 16384), lane); }
        float* rwt = (float*)(ws + WS_RWT); const float* rw = a.in[I_RW];
        for (int idx = gw * 64 + lane; idx < 32 * 1024; idx += NGW * 64) { const int e = idx >> 10, d = idx & 1023; rwt[idx] = rw[d * 32 + e]; }
    }
}

#define P1C(lane_, j_) (8 * (lane_) + 512 * ((j_) >> 1) + 4 * ((j_) & 1))
__device__ __forceinline__ void p1_load_row(const Args& a, const float* pos, int m, int lane, f32x4 (&v)[4]) {
    if (m < NLAT) { const float* src = a.in[I_X] + (size_t)m * D; const float* pp = pos + (size_t)(m & (T - 1)) * D;
#pragma unroll
        for (int j = 0; j < 4; ++j) v[j] = *(const f32x4*)(src + P1C(lane, j)) + *(const f32x4*)(pp + P1C(lane, j)); }
    else { const float* src = a.in[I_CTX] + (size_t)((m < NTOK ? m : NTOK - 1) - NLAT) * D;
#pragma unroll
        for (int j = 0; j < 4; ++j) v[j] = *(const f32x4*)(src + P1C(lane, j)); }
}
constexpr float USC = 16.0f;
__device__ __forceinline__ void p1_norm1(const Args& a, int vcu, int G) {
    const int tid = threadIdx.x, lane = tid & 63, wave = __builtin_amdgcn_readfirstlane(tid >> 6);
    const int gw = vcu * NWAVES + wave, NGW = G * NWAVES;
    const float* mods = (const float*)(a.ws + WS_MODS); const float* pos = (const float*)(a.ws + WS_POS); const float* g1 = a.in[I_N1G];
    bf16* U = (bf16*)(a.ws + WS_U);
    f32x4 gv[4];
#pragma unroll
    for (int j = 0; j < 4; ++j) gv[j] = *(const f32x4*)(g1 + P1C(lane, j));
    f32x4 vn[2][4];
    p1_load_row(a, pos, gw, lane, vn[0]); p1_load_row(a, pos, gw + NGW, lane, vn[1]);
    for (int m0 = gw; m0 < NTOK; m0 += 2 * NGW) {
        f32x4 v[2][4];
#pragma unroll
        for (int r = 0; r < 2; ++r)
#pragma unroll
            for (int j = 0; j < 4; ++j) v[r][j] = vn[r][j];
        if (m0 + 2 * NGW < NTOK) { p1_load_row(a, pos, m0 + 2 * NGW, lane, vn[0]); p1_load_row(a, pos, m0 + 3 * NGW, lane, vn[1]); }
        f32x4 sh[2][4], sc[2][4];
#pragma unroll
        for (int r = 0; r < 2; ++r) { const int m = m0 + r * NGW; const int cr = m < NLAT ? (m >> 11) : 32; const float* md = mods + (size_t)cr * 6144;
#pragma unroll
            for (int j = 0; j < 4; ++j) { sh[r][j] = *(const f32x4*)(md + P1C(lane, j)); sc[r][j] = *(const f32x4*)(md + 1024 + P1C(lane, j)); } }
#pragma unroll
        for (int r = 0; r < 2; ++r) { const int m = m0 + r * NGW; if (m >= NTOK) continue;
            float s = 0.f;
#pragma unroll
            for (int j = 0; j < 4; ++j) s += (v[r][j].x * v[r][j].x + v[r][j].y * v[r][j].y) + (v[r][j].z * v[r][j].z + v[r][j].w * v[r][j].w);
            const float rr = 1.0f / sqrtf(wave_sum(s) * (1.0f / D) + EPS);
            bf16* ub = U + (size_t)m * D + 8 * lane; unsigned char* u8 = a.ws + WS_U8 + (size_t)m * D + 8 * lane;
#pragma unroll
            for (int jp = 0; jp < 2; ++jp) { u32x4 wb; u32x2 w8;
#pragma unroll
                for (int q = 0; q < 2; ++q) { const int j = 2 * jp + q; const f32x4 y = v[r][j] * rr * gv[j] * (sc[r][j] + 1.0f) + sh[r][j];
                    wb[2 * q] = pk2(y.x, y.y); wb[2 * q + 1] = pk2(y.z, y.w);
                    const f32x4 y8 = y * USC; w8[q] = pg8::pk4_fp8(y8.x, y8.y, y8.z, y8.w); }
                *(u32x4*)(ub + 512 * jp) = wb; *(u32x2*)(u8 + 512 * jp) = w8; } }
    }
}

#undef P1C
typedef short v4i16_t __attribute__((ext_vector_type(4)));
__device__ __forceinline__ s16x4 trr(const LAS unsigned char* p) { return __builtin_bit_cast(s16x4, __builtin_amdgcn_ds_read_tr16_b64_v4i16((LAS v4i16_t*)p)); }
__device__ __forceinline__ bf16x8 cat8(s16x4 lo, s16x4 hi) { return __builtin_shufflevector(lo, hi, 0, 1, 2, 3, 4, 5, 6, 7); }
#define MFMA16(a, b, c) __builtin_amdgcn_mfma_f32_16x16x32_bf16((a), (b), (c), 0, 0, 0)
constexpr int PQK = 144, PV = 272;
__device__ __forceinline__ int vswz(int r) { return ((r & 3) << 2) | ((r >> 2) & 3); }
__device__ __forceinline__ float lane_scan(float x, int lane, int rev) {
#pragma unroll
    for (int o = 1; o < 64; o <<= 1) { const float up = __shfl_up(x, o), dn = __shfl_down(x, o); if (rev) { if (lane + o < 64) x += dn; } else { if (lane >= o) x += up; } }
    return x;
}
__device__ __forceinline__ u32x4 ldz8(const bf16* Z, int segbase, int seglen, int t, int col) {
    u32x4 v = (u32x4){0u, 0u, 0u, 0u};
    if (t >= 0 && t < seglen) v = *(const u32x4*)(Z + (size_t)(segbase + t) * ZW + col);
    return v;
}
__device__ __forceinline__ void conv8(const LAS unsigned char* raw, int s, int c8, const float (&cw)[3][8], const float (&cb)[8], float (&o)[8]) {
    const u32x4 a0 = *(const LAS u32x4*)(raw + (s + 0) * PQK + c8 * 16), a1 = *(const LAS u32x4*)(raw + (s + 1) * PQK + c8 * 16), a2 = *(const LAS u32x4*)(raw + (s + 2) * PQK + c8 * 16);
#pragma unroll
    for (int j = 0; j < 4; ++j) {
        const float l0 = bflo(a0[j]), h0 = bfhi(a0[j]), l1 = bflo(a1[j]), h1 = bfhi(a1[j]), l2 = bflo(a2[j]), h2 = bfhi(a2[j]);
        o[2 * j] = fsilu(cb[2 * j] + cw[0][2 * j] * l0 + cw[1][2 * j] * l1 + cw[2][2 * j] * l2);
        o[2 * j + 1] = fsilu(cb[2 * j + 1] + cw[0][2 * j + 1] * h0 + cw[1][2 * j + 1] * h1 + cw[2][2 * j + 1] * h2);
    }
}
__device__ __forceinline__ u32x4 pack8(const float (&o)[8], float s) { u32x4 w; w.x = pk2(o[0] * s, o[1] * s); w.y = pk2(o[2] * s, o[3] * s); w.z = pk2(o[4] * s, o[5] * s); w.w = pk2(o[6] * s, o[7] * s); return w; }

constexpr int P3_GRP = 73152, P3_RK = 0, P3_VT = 16896, P3_KP = 49664, P3_LR = 68096, P3_WB = 72192, P3_WBS = 320;
__device__ __forceinline__ float fast_logsigmoid(float x) { return fminf(x, 0.f) - __logf(1.0f + __expf(-fabsf(x))); }
__device__ __forceinline__ void glds16(const void* g, LAS unsigned char* l) {
    unsigned keep; const unsigned dst = (unsigned)(size_t)l;
    asm volatile("s_mov_b32 %0, m0\n\ts_mov_b32 m0, %2\n\ts_nop 0\n\tglobal_load_lds_dwordx4 %1, off\n\ts_mov_b32 m0, %0" : "=&s"(keep) : "v"(g), "s"(dst) : "memory");
}
__device__ __forceinline__ void glds16nt(const void* g, LAS unsigned char* l) {
    unsigned keep; const unsigned dst = (unsigned)(size_t)l;
    asm volatile("s_mov_b32 %0, m0\n\ts_mov_b32 m0, %2\n\ts_nop 0\n\tglobal_load_lds_dwordx4 %1, off nt\n\ts_mov_b32 m0, %0" : "=&s"(keep) : "v"(g), "s"(dst) : "memory");
}
__device__ __forceinline__ void p3_chains(const Args& a, LAS unsigned char* lds, int vcu, int G) {
    const int tid = threadIdx.x, lane = tid & 63, wave = __builtin_amdgcn_readfirstlane(tid >> 6);
    const int grp = wave >> 2, gw4 = wave & 3, gt = tid & 255;
    const int g = lane >> 4, q = (lane & 15) >> 2, p = lane & 3, l15 = lane & 15;
    const bf16* Z = (const bf16*)(a.ws + WS_Z);
    bf16* ST = (bf16*)(a.ws + WS_ST); float* NST = (float*)(a.ws + WS_NST);
    LAS unsigned char* base = lds + grp * P3_GRP;
    const int c8 = gt & 7;
    for (int pair = vcu; pair < 256; pair += G) {
        const int ch = pair * 2 + grp;
        const int h = ch & 3, dir = (ch >> 2) & 1, type = (ch >> 3) & 1, b = ch >> 4;
        const bf16* ZK = Z + plane64(type ? F_GK : F_MLK, h); const bf16* ZV = Z + plane128(type ? F_GV : F_MLV, h); const bf16* ZM = Z + Z_MISC;
        float cw[3][8], cb[8];
        {
            const float* w = a.in[I_CONVW]; const float* bb = a.in[I_CONVB]; const int chn = 256 + h * 64 + c8 * 8;
#pragma unroll
            for (int j = 0; j < 8; ++j) { cw[0][j] = w[chn + j]; cw[1][j] = w[512 + chn + j]; cw[2][j] = w[1024 + chn + j]; cb[j] = bb[chn + j]; }
        }
        const float bias_i = a.in[I_MLGB][(2 * dir) * 4 + h], bias_f = a.in[I_MLGB][(2 * dir + 1) * 4 + h];
        bf16x8 w2f; float gbd;
        {
            const int d = h * 64 + 16 * gw4 + l15; const float* w2 = a.in[I_GW2] + (size_t)dir * 16 * 256 + d;
#pragma unroll
            for (int j = 0; j < 8; ++j) { float v = 0.f; if (g < 2) v = w2[(8 * g + j) * 256]; w2f[j] = (short)f2bf(v); }
            gbd = a.in[I_GGB][dir * 256 + d];
        }
        bf16x8 onesf;
#pragma unroll
        for (int j = 0; j < 8; ++j) onesf[j] = (short)(l15 == 0 ? 0x3F80 : 0);
        f32x4 acc[4][2], accn[4];
#pragma unroll
        for (int mt = 0; mt < 4; ++mt) { accn[mt] = (f32x4){0.f, 0.f, 0.f, 0.f};
#pragma unroll
            for (int nt = 0; nt < 2; ++nt) acc[mt][nt] = (f32x4){0.f, 0.f, 0.f, 0.f}; }
        float rgi = 0.f, rgf = 0.f;
#define P3_CHUNK(j, lat_, c_, t0_, sb_, sl_) const bool lat_ = (j) >= 4; const int c_ = dir == 0 ? (lat_ ? (j) - 4 : (j)) : (lat_ ? 35 - (j) : 3 - (j)); \
        const int t0_ = 64 * c_, sb_ = lat_ ? b * T : NLAT + b * CT, sl_ = lat_ ? T : CT
        for (int it = -3; it < 36; ++it) {
            if (type == 0 && gw4 == 0) {
                const int j2 = it + 2;
                if (j2 >= 0 && j2 < 36) { LAS float* WB = (LAS float*)(base + P3_WB + (j2 % 3) * P3_WBS);
                    const float lf = fast_logsigmoid(rgf + bias_f), ig = rgi + bias_i; const float B = lane_scan(lf, lane, dir);
                    const float tot = __shfl(B, dir ? 0 : 63); WB[lane] = __expf(tot - B + ig); if (lane == 0) WB[64] = __expf(tot); }
                const int j3 = it + 3;
                if (j3 < 36) { P3_CHUNK(j3, lat3, c3, t03, sb3, sl3); (void)sl3; (void)lat3; const bf16* zr = ZM + (size_t)(sb3 + t03 + lane) * 64 + M_MLG; rgi = bf2f(zr[(2 * dir) * 4 + h]); rgf = bf2f(zr[(2 * dir + 1) * 4 + h]); }
            }
            {
                const int j2 = it + 2;
                if (j2 >= 0 && j2 < 36) { P3_CHUNK(j2, lat2, c2, t02, sb2, sl2); (void)lat2;
                    LAS unsigned char* RK = base + P3_RK + (j2 & 1) * 8448;
#pragma unroll
                    for (int i = 0; i < 2; ++i) { const int qi = gw4 + 4 * i, row = 8 * qi + (lane >> 3); int t = t02 - 1 + row; t = t < 0 ? 0 : t;
                        glds16(ZK + (size_t)(sb2 + t) * 64 + (lane & 7) * 8, RK + qi * 1024); }
                    if (gw4 == 0 && lane < 16) { const int row = 64 + (lane >> 3); int t = t02 - 1 + row; t = t >= sl2 ? sl2 - 1 : t;
                        glds16(ZK + (size_t)(sb2 + t) * 64 + (lane & 7) * 8, RK + 8192); }
                    if (type == 1 && gw4 < 2) { LAS unsigned char* LR = base + P3_LR + (j2 & 1) * 2048; const int row = 32 * gw4 + (lane >> 1);
                        glds16(ZM + (size_t)(sb2 + t02 + row) * 64 + M_LR + dir * 16 + (lane & 1) * 8, LR + gw4 * 1024); }
                }
                const int j1 = it + 1;
                if (j1 >= 0 && j1 < 36) { P3_CHUNK(j1, lat1, c1, t01, sb1, sl1); (void)lat1; (void)sl1;
                    LAS unsigned char* VT = base + P3_VT + (j1 & 1) * 16384;
#pragma unroll
                    for (int i = 0; i < 4; ++i) { const int qi = gw4 * 4 + i, row = 4 * qi + (lane >> 4);
                        glds16(ZV + (size_t)(sb1 + t01 + row) * 128 + ((lane & 15) ^ vswz(row)) * 8, VT + qi * 1024); }
                }
            }
            {
                const int j1 = it + 1;
                if (j1 >= 0 && j1 < 36) { P3_CHUNK(j1, lat1, c1, t01, sb1, sl1); (void)lat1; (void)sb1;
                    const LAS unsigned char* RK = base + P3_RK + (j1 & 1) * 8448; LAS unsigned char* KP = base + P3_KP + (j1 & 1) * 9216;
                    LAS float* WB = (LAS float*)(base + P3_WB + (j1 % 3) * P3_WBS);
                    if (type == 0) {
#pragma unroll
                        for (int pss = 0; pss < 2; ++pss) { const int s = (gt >> 3) + 32 * pss;
                            u32x4 a0 = *(const LAS u32x4*)(RK + (s + 0) * 128 + c8 * 16); const u32x4 a1 = *(const LAS u32x4*)(RK + (s + 1) * 128 + c8 * 16); u32x4 a2 = *(const LAS u32x4*)(RK + (s + 2) * 128 + c8 * 16);
                            if (t01 + s - 1 < 0) a0 = (u32x4){0u, 0u, 0u, 0u};
                            if (t01 + s + 1 >= sl1) a2 = (u32x4){0u, 0u, 0u, 0u};
                            float o[8];
#pragma unroll
                            for (int j = 0; j < 4; ++j) {
                                o[2 * j] = fsilu(cb[2 * j] + cw[0][2 * j] * bflo(a0[j]) + cw[1][2 * j] * bflo(a1[j]) + cw[2][2 * j] * bflo(a2[j]));
                                o[2 * j + 1] = fsilu(cb[2 * j + 1] + cw[0][2 * j + 1] * bfhi(a0[j]) + cw[1][2 * j + 1] * bfhi(a1[j]) + cw[2][2 * j + 1] * bfhi(a2[j])); }
                            *(LAS u32x4*)(KP + s * PQK + c8 * 16) = pack8(o, WB[s]); }
                    } else {
                        const LAS unsigned char* LR = base + P3_LR + (j1 & 1) * 2048;
                        f32x4 la[4];
#pragma unroll
                        for (int mt = 0; mt < 4; ++mt) { bf16x8 af = (bf16x8){0, 0, 0, 0, 0, 0, 0, 0}; if (g < 2) af = *(const LAS bf16x8*)(LR + (16 * mt + l15) * 32 + g * 16);
                            la[mt] = MFMA16(af, w2f, ((f32x4){gbd, gbd, gbd, gbd}));
#pragma unroll
                            for (int rg = 0; rg < 4; ++rg) la[mt][rg] = fast_logsigmoid(la[mt][rg]) * (1.0f / 16.0f); }
                        float tmt[4];
#pragma unroll
                        for (int mt = 0; mt < 4; ++mt) {
                            if (dir == 0) { la[mt][1] += la[mt][0]; la[mt][2] += la[mt][1]; la[mt][3] += la[mt][2]; }
                            else { la[mt][2] += la[mt][3]; la[mt][1] += la[mt][2]; la[mt][0] += la[mt][1]; }
                            const float tg = dir == 0 ? la[mt][3] : la[mt][0];
                            const float t0 = __shfl(tg, l15), t1 = __shfl(tg, l15 + 16), t2 = __shfl(tg, l15 + 32), t3 = __shfl(tg, l15 + 48);
                            float og;
                            if (dir == 0) og = (g > 0 ? t0 : 0.f) + (g > 1 ? t1 : 0.f) + (g > 2 ? t2 : 0.f);
                            else og = (g < 3 ? t3 : 0.f) + (g < 2 ? t2 : 0.f) + (g < 1 ? t1 : 0.f);
#pragma unroll
                            for (int rg = 0; rg < 4; ++rg) la[mt][rg] += og;
                            tmt[mt] = (t0 + t1) + (t2 + t3); }
                        const float tot = (tmt[0] + tmt[1]) + (tmt[2] + tmt[3]);
#pragma unroll
                        for (int mt = 0; mt < 4; ++mt) { float om;
                            if (dir == 0) om = (mt > 0 ? tmt[0] : 0.f) + (mt > 1 ? tmt[1] : 0.f) + (mt > 2 ? tmt[2] : 0.f);
                            else om = (mt < 3 ? tmt[3] : 0.f) + (mt < 2 ? tmt[2] : 0.f) + (mt < 1 ? tmt[1] : 0.f);
#pragma unroll
                            for (int rg = 0; rg < 4; ++rg) { const int s = 16 * mt + 4 * g + rg, d = 16 * gw4 + l15;
                                const float kv = bf2f(*(const LAS unsigned short*)(RK + (s + 1) * 128 + d * 2));
                                *(LAS unsigned short*)(KP + s * PQK + d * 2) = (unsigned short)f2bf(kv * __expf(tot - (om + la[mt][rg]))); } }
                        if (g == 0) WB[16 * gw4 + l15] = __expf(tot);
                    }
                }
            }
            if (it >= 0) { P3_CHUNK(it, lat0, c0, t00, sb0, sl0); (void)t00; (void)sb0; (void)sl0;
                const LAS unsigned char* KP = base + P3_KP + (it & 1) * 9216; const LAS unsigned char* VT = base + P3_VT + (it & 1) * 16384;
                const LAS float* WB = (const LAS float*)(base + P3_WB + (it % 3) * P3_WBS);
                if (lat0) {
                    bf16* dst = ST + ((((size_t)(type * 2 + dir) * 32 + b) * 4 + h) * 32 + c0) * 8192;
#pragma unroll
                    for (int mt = 0; mt < 4; ++mt)
#pragma unroll
                        for (int nt = 0; nt < 2; ++nt) { u32x2 w; w.x = pk2(acc[mt][nt][0], acc[mt][nt][1]); w.y = pk2(acc[mt][nt][2], acc[mt][nt][3]);
                            const int F = (((2 * gw4 + nt) * 2 + (mt >> 1)) * 64 + (2 * (mt & 1) + (g >> 1)) * 16 + l15);
                            *(u32x2*)(dst + F * 8 + (g & 1) * 4) = w; }
                    if (type == 0 && gw4 == 0 && l15 == 0) { float* nd = NST + ((((size_t)dir * 32 + b) * 4 + h) * 32 + c0) * 64;
#pragma unroll
                        for (int mt = 0; mt < 4; ++mt) *(f32x4*)(nd + 16 * mt + 4 * g) = accn[mt]; }
                }
                if (type == 0) { const float et = WB[64];
#pragma unroll
                    for (int mt = 0; mt < 4; ++mt) { accn[mt] *= et;
#pragma unroll
                        for (int nt = 0; nt < 2; ++nt) acc[mt][nt] *= et; }
                } else {
#pragma unroll
                    for (int mt = 0; mt < 4; ++mt) { const f32x4 e4 = *(const LAS f32x4*)(WB + 16 * mt + 4 * g);
#pragma unroll
                        for (int nt = 0; nt < 2; ++nt) acc[mt][nt] *= e4; }
                }
#pragma unroll
                for (int ks = 0; ks < 2; ++ks) {
                    bf16x8 af[4], bfr[2];
#pragma unroll
                    for (int mt = 0; mt < 4; ++mt) { const LAS unsigned char* pa = KP + (32 * ks + 8 * g + q) * PQK + (16 * mt + 4 * p) * 2; af[mt] = cat8(trr(pa), trr(pa + 4 * PQK)); }
#pragma unroll
                    for (int nt = 0; nt < 2; ++nt) { const int r0 = 32 * ks + 8 * g + q, ch = 4 * gw4 + 2 * nt + (p >> 1);
                        const LAS unsigned char* pb0 = VT + r0 * 256 + ((ch ^ vswz(r0)) * 16) + 8 * (p & 1); const LAS unsigned char* pb1 = VT + (r0 + 4) * 256 + ((ch ^ vswz(r0 + 4)) * 16) + 8 * (p & 1);
                        bfr[nt] = cat8(trr(pb0), trr(pb1)); }
#pragma unroll
                    for (int mt = 0; mt < 4; ++mt) {
#pragma unroll
                        for (int nt = 0; nt < 2; ++nt) acc[mt][nt] = MFMA16(af[mt], bfr[nt], acc[mt][nt]);
                        if (type == 0 && gw4 == 0) accn[mt] = MFMA16(af[mt], onesf, accn[mt]); }
                }
            }
            { const bool st = it >= 4;
              if (!st) VM_WAIT(); else if (type == 0 && gw4 == 0) asm volatile("s_waitcnt vmcnt(12)" ::: "memory"); else asm volatile("s_waitcnt vmcnt(8)" ::: "memory"); }
            BAR_LDS();
        }
#undef P3_CHUNK
    }
}

constexpr int P4_QR = 0, P4_KR = 8448, P4_LR = 16896, P4_VT = 20992, P4_CT = 37376, P4_QP = 70144, P4_KP = 88576, P4_SW = 107008, P4_H = 70144, P4_WB = 125440, P4_CW = 127488;
constexpr int P4_TS = 9216, P4_HS = 17408, PH = 272;
__device__ __forceinline__ void p4_outputs(const Args& a, LAS unsigned char* lds, int vcu, int G) {
    const int tid = threadIdx.x, lane = tid & 63, wave = __builtin_amdgcn_readfirstlane(tid >> 6);
    const int dg = wave >> 2, gw4 = wave & 3, gt = tid & 255;
    const int g = lane >> 4, q = (lane & 15) >> 2, p = lane & 3, l15 = lane & 15;
    const bf16* Z = (const bf16*)(a.ws + WS_Z);
    const bf16* ST = (const bf16*)(a.ws + WS_ST); const float* NST = (const float*)(a.ws + WS_NST);
    bf16* MG = (bf16*)(a.ws + WS_U);
    LAS unsigned char* QR = lds + P4_QR; LAS unsigned char* KR = lds + P4_KR; LAS unsigned char* LR = lds + P4_LR + dg * 2048; LAS unsigned char* VT = lds + P4_VT; LAS unsigned char* CTl = lds + P4_CT + dg * 16384;
    LAS unsigned char* QP = lds + P4_QP + dg * P4_TS; LAS unsigned char* KP = lds + P4_KP + dg * P4_TS; LAS unsigned char* SW = lds + P4_SW + dg * P4_TS;
    LAS unsigned char* Hme = lds + P4_H + dg * P4_HS;
    LAS float* CW = (LAS float*)(lds + P4_CW);
    const int c8 = gt & 7;
    for (int i = tid; i < 2048; i += NTHR) CW[i] = i < 1536 ? a.in[I_CONVW][i] : a.in[I_CONVB][i - 1536];
    if (tid < 16) CW[2048 + tid] = a.in[I_MLGB][tid];
#define P4_DEC(u_, b_, ty_, h_, c_) const int b_ = (u_) >> 8, r_##b_ = (u_) & 255, ty_ = (r_##b_ + b_) & 1, h_ = (r_##b_ >> 1) & 3, c_ = r_##b_ >> 3
#define P4_ISSUE_QK(u_) do { P4_DEC(u_, ib, ity, ih, ic); const int it0 = 64 * ic, isb = ib * T; \
        const bf16* zq = Z + plane64(ity ? F_GQ : F_MLQ, ih); const bf16* zk = Z + plane64(ity ? F_GK : F_MLK, ih); \
        { const int row = 8 * wave + (lane >> 3); int t = it0 - 1 + row; t = t < 0 ? 0 : t; const size_t so = (size_t)(isb + t) * 64 + (lane & 7) * 8; \
          glds16nt(zq + so, QR + wave * 1024); glds16nt(zk + so, KR + wave * 1024); } \
        if (wave < 2 && lane < 16) { const int row = 64 + (lane >> 3); int t = it0 - 1 + row; t = t >= T ? T - 1 : t; \
          glds16nt((wave ? zk : zq) + (size_t)(isb + t) * 64 + (lane & 7) * 8, (wave ? KR : QR) + 8192); } \
        if (gw4 < 2) { const int row = 32 * gw4 + (lane >> 1); glds16nt(Z + Z_MISC + (size_t)(isb + it0 + row) * 64 + M_LR + dg * 16 + (lane & 1) * 8, LR + gw4 * 1024); } } while (0)
#define P4_ISSUE_VC(u_) do { P4_DEC(u_, ib, ity, ih, ic); const int it0 = 64 * ic, isb = ib * T; const bf16* zv = Z + plane128(ity ? F_GV : F_MLV, ih); \
        _Pragma("unroll") for (int i = 0; i < 2; ++i) { const int qi = wave * 2 + i, row = 4 * qi + (lane >> 4); glds16nt(zv + (size_t)(isb + it0 + row) * 128 + ((lane & 15) ^ vswz(row)) * 8, VT + qi * 1024); } \
        const bf16* src = ST + ((((size_t)(ity * 2 + dg) * 32 + ib) * 4 + ih) * 32 + ic) * 8192; \
        _Pragma("unroll") for (int i = 0; i < 4; ++i) { const int qi = gw4 * 4 + i; glds16nt(src + qi * 512 + lane * 8, CTl + qi * 1024); } } while (0)
#define P4_GATES_LOAD(u_, gi_, gf_, gh_) do { P4_DEC(u_, ib, ity, ih, ic); (void)ity; const bf16* zr = Z + Z_MISC + (size_t)(ib * T + 64 * ic + lane) * 64 + M_MLG; \
        gi_ = zr[(2 * dg) * 4 + ih]; gf_ = zr[(2 * dg + 1) * 4 + ih]; gh_ = ih; } while (0)
#define P4_GATES_SCAN(slot_, gi_, gf_, gh_) do { LAS float* WBs = (LAS float*)(lds + P4_WB + ((slot_) * 2 + dg) * 512); const LAS float* GBt = (const LAS float*)(lds + P4_CW + 8192); \
        const float lf = fast_logsigmoid(bf2f(gf_) + GBt[(2 * dg + 1) * 4 + (gh_)]), gi2 = bf2f(gi_) + GBt[(2 * dg) * 4 + (gh_)]; \
        const float B = lane_scan(lf, lane, dg); WBs[lane] = __expf(B) * 0.125f; WBs[64 + lane] = __expf(gi2 - B); } while (0)
    bf16x8 w2h[4]; float gbh[4];
#pragma unroll
    for (int hh = 0; hh < 4; ++hh) { const int d = hh * 64 + 16 * gw4 + l15; const float* w2 = a.in[I_GW2] + (size_t)dg * 16 * 256 + d;
#pragma unroll
        for (int j = 0; j < 8; ++j) { float v = 0.f; if (g < 2) v = w2[(8 * g + j) * 256]; w2h[hh][j] = (short)f2bf(v); }
        gbh[hh] = a.in[I_GGB][dg * 256 + d]; }
    int u = vcu;
    if (u < 8192) {
        P4_ISSUE_QK(u); P4_ISSUE_VC(u);
    }
    VM_WAIT();
    __syncthreads();
    if (u < 8192 && gw4 == 0) { unsigned short gi, gf; int gh; P4_GATES_LOAD(u, gi, gf, gh); P4_GATES_SCAN(0, gi, gf, gh); }
    __syncthreads();
    for (int iter = 0; u < 8192; u += G, ++iter) {
        P4_DEC(u, b, type, h, c);
        const int t0 = 64 * c, segbase = b * T;
        const int un = u + G; const bool has_next = un < 8192;
        const int et = tid >> 3, evc = (tid & 7) * 16, erow = segbase + t0 + et;
        const bf16* zg = Z + plane128(type ? F_GG : F_MLO, h) + (size_t)erow * 128 + evc;
        const u32x4 eg0 = *(const u32x4*)zg, eg1 = *(const u32x4*)(zg + 8);
        f32x4 ngv[4];
        { const float* ngm = a.in[I_MLNG]; const float* ngg = a.in[I_GNG]; asm volatile("" : "+s"(ngm), "+s"(ngg)); const float* ng = (type ? ngg : ngm) + h * 128 + evc;
#pragma unroll
          for (int j = 0; j < 4; ++j) ngv[j] = *(const f32x4*)(ng + 4 * j); }
        f32x4 nsa[2][2];
#pragma unroll
        for (int ks = 0; ks < 2; ++ks) { nsa[ks][0] = (f32x4){0.f, 0.f, 0.f, 0.f}; nsa[ks][1] = nsa[ks][0]; }
        if (type == 0 && l15 == 0) { const float* nd = NST + ((((size_t)dg * 32 + b) * 4 + h) * 32 + c) * 64;
#pragma unroll
            for (int ks = 0; ks < 2; ++ks) { nsa[ks][0] = *(const f32x4*)(nd + 32 * ks + 8 * g); nsa[ks][1] = *(const f32x4*)(nd + 32 * ks + 8 * g + 4); } }
        unsigned short ngi = 0, ngf = 0; int ngh = 0;
        if (gw4 == 0 && has_next) P4_GATES_LOAD(un, ngi, ngf, ngh);
        if (type == 0) {
            const int qk = tid >> 8;
            const LAS float* WB0 = (const LAS float*)(lds + P4_WB + ((iter & 1) * 2 + 0) * 512) + qk * 64; const LAS float* WB1 = (const LAS float*)(lds + P4_WB + ((iter & 1) * 2 + 1) * 512) + qk * 64;
            float cw[3][8], cb[8];
            const int chn = qk * 256 + h * 64 + c8 * 8;
#pragma unroll
            for (int j4 = 0; j4 < 2; ++j4) { const f32x4 x0 = *(const LAS f32x4*)(CW + chn + 4 * j4), x1 = *(const LAS f32x4*)(CW + 512 + chn + 4 * j4), x2 = *(const LAS f32x4*)(CW + 1024 + chn + 4 * j4), x3 = *(const LAS f32x4*)(CW + 1536 + chn + 4 * j4);
#pragma unroll
                for (int i = 0; i < 4; ++i) { cw[0][4 * j4 + i] = x0[i]; cw[1][4 * j4 + i] = x1[i]; cw[2][4 * j4 + i] = x2[i]; cb[4 * j4 + i] = x3[i]; } }
            const LAS unsigned char* RAW = qk ? KR : QR; LAS unsigned char* DST = lds + (qk ? P4_KP : P4_QP);
#pragma unroll
            for (int pss = 0; pss < 2; ++pss) { const int s = (gt >> 3) + 32 * pss;
                u32x4 a0 = *(const LAS u32x4*)(RAW + (s + 0) * 128 + c8 * 16); const u32x4 a1 = *(const LAS u32x4*)(RAW + (s + 1) * 128 + c8 * 16); u32x4 a2 = *(const LAS u32x4*)(RAW + (s + 2) * 128 + c8 * 16);
                if (t0 + s - 1 < 0) a0 = (u32x4){0u, 0u, 0u, 0u};
                if (t0 + s + 1 >= T) a2 = (u32x4){0u, 0u, 0u, 0u};
                float o[8];
#pragma unroll
                for (int j = 0; j < 4; ++j) {
                    o[2 * j] = fsilu(cb[2 * j] + cw[0][2 * j] * bflo(a0[j]) + cw[1][2 * j] * bflo(a1[j]) + cw[2][2 * j] * bflo(a2[j]));
                    o[2 * j + 1] = fsilu(cb[2 * j + 1] + cw[0][2 * j + 1] * bfhi(a0[j]) + cw[1][2 * j + 1] * bfhi(a1[j]) + cw[2][2 * j + 1] * bfhi(a2[j])); }
                *(LAS u32x4*)(DST + s * PQK + c8 * 16) = pack8(o, WB0[s]);
                *(LAS u32x4*)(DST + P4_TS + s * PQK + c8 * 16) = pack8(o, WB1[s]); }
        } else {
            const bf16x8 w2f = h == 0 ? w2h[0] : h == 1 ? w2h[1] : h == 2 ? w2h[2] : w2h[3]; const float gbd = h == 0 ? gbh[0] : h == 1 ? gbh[1] : h == 2 ? gbh[2] : gbh[3];
            f32x4 la[4];
#pragma unroll
            for (int mt = 0; mt < 4; ++mt) { bf16x8 af = (bf16x8){0, 0, 0, 0, 0, 0, 0, 0}; if (g < 2) af = *(const LAS bf16x8*)(LR + (16 * mt + l15) * 32 + g * 16);
                la[mt] = MFMA16(af, w2f, ((f32x4){gbd, gbd, gbd, gbd}));
#pragma unroll
                for (int rg = 0; rg < 4; ++rg) la[mt][rg] = fast_logsigmoid(la[mt][rg]) * (1.0f / 16.0f); }
            float tmt[4];
#pragma unroll
            for (int mt = 0; mt < 4; ++mt) {
                if (dg == 0) { la[mt][1] += la[mt][0]; la[mt][2] += la[mt][1]; la[mt][3] += la[mt][2]; }
                else { la[mt][2] += la[mt][3]; la[mt][1] += la[mt][2]; la[mt][0] += la[mt][1]; }
                const float tg = dg == 0 ? la[mt][3] : la[mt][0];
                const float t0g = __shfl(tg, l15), t1g = __shfl(tg, l15 + 16), t2g = __shfl(tg, l15 + 32), t3g = __shfl(tg, l15 + 48);
                float og;
                if (dg == 0) og = (g > 0 ? t0g : 0.f) + (g > 1 ? t1g : 0.f) + (g > 2 ? t2g : 0.f);
                else og = (g < 3 ? t3g : 0.f) + (g < 2 ? t2g : 0.f) + (g < 1 ? t1g : 0.f);
#pragma unroll
                for (int rg = 0; rg < 4; ++rg) la[mt][rg] += og;
                tmt[mt] = (t0g + t1g) + (t2g + t3g); }
#pragma unroll
            for (int mt = 0; mt < 4; ++mt) { float om;
                if (dg == 0) om = (mt > 0 ? tmt[0] : 0.f) + (mt > 1 ? tmt[1] : 0.f) + (mt > 2 ? tmt[2] : 0.f);
                else om = (mt < 3 ? tmt[3] : 0.f) + (mt < 2 ? tmt[2] : 0.f) + (mt < 1 ? tmt[1] : 0.f);
#pragma unroll
                for (int rg = 0; rg < 4; ++rg) { const int s = 16 * mt + 4 * g + rg, d = 16 * gw4 + l15; const float B = om + la[mt][rg];
                    const float qv = bf2f(*(const LAS unsigned short*)(QR + (s + 1) * 128 + d * 2)), kv = bf2f(*(const LAS unsigned short*)(KR + (s + 1) * 128 + d * 2));
                    *(LAS unsigned short*)(QP + s * PQK + d * 2) = (unsigned short)f2bf(qv * 0.125f * __expf(B));
                    *(LAS unsigned short*)(KP + s * PQK + d * 2) = (unsigned short)f2bf(kv * __expf(-B)); } }
        }
        asm volatile("" :: "v"(eg0), "v"(eg1), "v"(ngi), "v"(ngf), "v"(nsa[0][0]), "v"(nsa[0][1]), "v"(nsa[1][0]), "v"(nsa[1][1]), "v"(ngv[0]), "v"(ngv[1]), "v"(ngv[2]), "v"(ngv[3]));
        VM_WAIT();
        BAR_LDS();
        if (has_next) P4_ISSUE_QK(un);
        bf16x8 qf[2];
#pragma unroll
        for (int ks = 0; ks < 2; ++ks) qf[ks] = *(const LAS bf16x8*)(QP + (16 * gw4 + l15) * PQK + (32 * ks + 8 * g) * 2);
        float rs = 0.f;
        {
            f32x4 sa[4];
#pragma unroll
            for (int mt = 0; mt < 4; ++mt) sa[mt] = (f32x4){0.f, 0.f, 0.f, 0.f};
#pragma unroll
            for (int ks = 0; ks < 2; ++ks)
#pragma unroll
                for (int mt = 0; mt < 4; ++mt) { const bf16x8 kf = *(const LAS bf16x8*)(KP + (16 * mt + l15) * PQK + (32 * ks + 8 * g) * 2); sa[mt] = MFMA16(kf, qf[ks], sa[mt]); }
            const int t = 16 * gw4 + l15;
#pragma unroll
            for (int mt = 0; mt < 4; ++mt) { float v[4];
#pragma unroll
                for (int rg = 0; rg < 4; ++rg) { const int sI = 16 * mt + 4 * g + rg; const bool keep = dg == 0 ? (sI <= t) : (sI >= t); v[rg] = keep ? sa[mt][rg] : 0.f; rs += v[rg]; }
                u32x2 w; w.x = pk2(v[0], v[1]); w.y = pk2(v[2], v[3]);
                *(LAS u32x2*)(SW + t * PQK + (16 * mt + 4 * g) * 2) = w; }
            rs += __shfl_xor(rs, 16); rs += __shfl_xor(rs, 32);
        }
        f32x4 na[8], nn = (f32x4){0.f, 0.f, 0.f, 0.f};
#pragma unroll
        for (int mt = 0; mt < 8; ++mt) na[mt] = (f32x4){0.f, 0.f, 0.f, 0.f};
#pragma unroll
        for (int ks = 0; ks < 2; ++ks) { const bf16x8 sf = *(const LAS bf16x8*)(SW + (16 * gw4 + l15) * PQK + (32 * ks + 8 * g) * 2);
            const int r0 = 32 * ks + 8 * g + q, x0 = vswz(r0), x1 = vswz(r0 + 4);
#pragma unroll
            for (int mt = 0; mt < 8; ++mt) { const int ch = 2 * mt + (p >> 1); const LAS unsigned char* pa0 = VT + r0 * 256 + ((ch ^ x0) * 16) + 8 * (p & 1); const LAS unsigned char* pa1 = VT + (r0 + 4) * 256 + ((ch ^ x1) * 16) + 8 * (p & 1);
                na[mt] = MFMA16(cat8(trr(pa0), trr(pa1)), sf, na[mt]); } }
#pragma unroll
        for (int ks = 0; ks < 2; ++ks) {
#pragma unroll
            for (int mt = 0; mt < 8; ++mt) { const bf16x8 cf = *(const LAS bf16x8*)(CTl + ((mt * 2 + ks) * 64 + lane) * 16); na[mt] = MFMA16(cf, qf[ks], na[mt]); }
            if (type == 0) { bf16x8 nf;
#pragma unroll
                for (int j = 0; j < 4; ++j) { nf[j] = (short)f2bf(nsa[ks][0][j]); nf[4 + j] = (short)f2bf(nsa[ks][1][j]); }
                nn = MFMA16(nf, qf[ks], nn); } }
        float inv = 1.0f;
        if (type == 0) { const float qn = __shfl(nn[0], l15); inv = 1.0f / fmaxf(fabsf(rs + qn), 1.0f); }
        BAR_LDS();
        if (has_next) P4_ISSUE_VC(un);
#pragma unroll
        for (int mt = 0; mt < 8; ++mt) { u32x2 w; w.x = pk2(na[mt][0] * inv, na[mt][1] * inv); w.y = pk2(na[mt][2] * inv, na[mt][3] * inv);
            *(LAS u32x2*)(Hme + (16 * gw4 + l15) * PH + (16 * mt + 4 * g) * 2) = w; }
        if (gw4 == 0 && has_next) P4_GATES_SCAN((iter + 1) & 1, ngi, ngf, ngh);
        BAR_LDS();
        {
            const LAS unsigned char* H0 = lds + P4_H + et * PH + evc * 2; float hv[16]; float ss = 0.f;
#pragma unroll
            for (int j = 0; j < 2; ++j) { const u32x4 x0 = *(const LAS u32x4*)(H0 + 16 * j), x1 = *(const LAS u32x4*)(H0 + P4_HS + 16 * j);
#pragma unroll
                for (int i = 0; i < 4; ++i) { const float v0 = bflo(x0[i]) + bflo(x1[i]), v1 = bfhi(x0[i]) + bfhi(x1[i]); hv[8 * j + 2 * i] = v0; hv[8 * j + 2 * i + 1] = v1; ss += v0 * v0 + v1 * v1; } }
            ss += __shfl_xor(ss, 1); ss += __shfl_xor(ss, 2); ss += __shfl_xor(ss, 4);
            const float rn = 1.0f / sqrtf(ss * (1.0f / 128.0f) + EPS);
            float gate[16];
#pragma unroll
            for (int j = 0; j < 4; ++j) { gate[2 * j] = bflo(eg0[j]); gate[2 * j + 1] = bfhi(eg0[j]); gate[8 + 2 * j] = bflo(eg1[j]); gate[8 + 2 * j + 1] = bfhi(eg1[j]); }
            float o[16];
#pragma unroll
            for (int i = 0; i < 16; ++i) { const float gv = type ? fsilu(gate[i]) : fsigmoid(gate[i]); o[i] = hv[i] * rn * ngv[i >> 2][i & 3] * gv; }
            bf16* dst = MG + (size_t)erow * D + type * 512 + h * 128 + evc;
            u32x4 w0, w1; w0.x = pk2(o[0], o[1]); w0.y = pk2(o[2], o[3]); w0.z = pk2(o[4], o[5]); w0.w = pk2(o[6], o[7]); w1.x = pk2(o[8], o[9]); w1.y = pk2(o[10], o[11]); w1.z = pk2(o[12], o[13]); w1.w = pk2(o[14], o[15]);
            *(u32x4*)dst = w0; *(u32x4*)(dst + 8) = w1;
        }
        asm volatile("s_waitcnt vmcnt(8)" ::: "memory");
        BAR_LDS();
    }
#undef P4_DEC
#undef P4_ISSUE_QK
#undef P4_ISSUE_VC
#undef P4_GATES_LOAD
#undef P4_GATES_SCAN
}

constexpr int P6_LG = 131072, P6_PE = 132096, P6_PP = 136192, P6_PR = 140288, P6_LC = 144384;
constexpr int P6_RWH = 0, P6_RR = 65536, P6_LGT = 66560, P6_AS = 83968;
__device__ __forceinline__ void p6_router(const Args& a, LAS unsigned char* lds, int vcu, int G) {
    const int tid = threadIdx.x, lane = tid & 63, wave = __builtin_amdgcn_readfirstlane(tid >> 6);
    const int g = lane >> 4, l15 = lane & 15;
    const float* mods = (const float*)(a.ws + WS_MODS); const float* rwt = (const float*)(a.ws + WS_RWT); const float* g2 = a.in[I_N2G]; const float* rb = a.in[I_RB];
    const bf16* X1 = (const bf16*)(a.ws + WS_X1B); unsigned char* U2 = a.ws + WS_U;
    int* ltok = (int*)(a.ws + WS_LTOK); float* lp = (float*)(a.ws + WS_LP); int* tgp = (int*)(a.ws + WS_TGP);
    unsigned* cntw = (unsigned*)(a.ws + WS_CTL) + CW_CNT;
    LAS unsigned char* RWH = lds + P6_RWH; LAS float* RR = (LAS float*)(lds + P6_RR) + wave * 32; LAS float* LGT = (LAS float*)(lds + P6_LGT) + wave * 512;
    LAS float* AS = (LAS float*)(lds + P6_AS);
    LAS int* PE = (LAS int*)(lds + P6_PE); LAS float* PP = (LAS float*)(lds + P6_PP); LAS int* PR = (LAS int*)(lds + P6_PR);
    LAS int* LC = (LAS int*)(lds + P6_LC); LAS int* GB = LC + 32;
    for (int f = wave * 8; f < wave * 8 + 8; ++f) { const int mt = f >> 5, ks = f & 31; const float* src = rwt + (size_t)(16 * mt + l15) * 1024 + 32 * ks + 8 * g;
        const f32x4 x0 = *(const f32x4*)src, x1 = *(const f32x4*)(src + 4);
        u32x4 w; w.x = pk2(x0.x, x0.y); w.y = pk2(x0.z, x0.w); w.z = pk2(x1.x, x1.y); w.w = pk2(x1.z, x1.w);
        *(LAS u32x4*)(RWH + (f * 64 + lane) * 16) = w; }
    f32x4 gv[4];
#pragma unroll
    for (int j = 0; j < 4; ++j) gv[j] = *(const f32x4*)(g2 + 4 * lane + 256 * j);
    for (int rbk = vcu; rbk < NLAT / 256; rbk += G) {
        const int mbase = rbk * 256 + wave * 32, b = mbase >> 11;
        const float* md = mods + (size_t)b * 6144;
        if (tid < 32) LC[tid] = 0;
        for (int i = tid; i < 1024; i += NTHR) { AS[i] = g2[i] * (1.0f + md[4 * 1024 + i]); AS[1024 + i] = md[3 * 1024 + i]; }
        __syncthreads();
        f32x4 vn[2][4];
#pragma unroll
        for (int r = 0; r < 2; ++r)
#pragma unroll
            for (int j = 0; j < 4; ++j) vn[r][j] = ldbf4(X1 + (size_t)(mbase + r) * D + 4 * lane + 256 * j);
        for (int i = 0; i < 32; i += 2) {
            f32x4 v[2][4];
#pragma unroll
            for (int r = 0; r < 2; ++r)
#pragma unroll
                for (int j = 0; j < 4; ++j) v[r][j] = vn[r][j];
            if (i + 2 < 32) {
#pragma unroll
                for (int r = 0; r < 2; ++r)
#pragma unroll
                    for (int j = 0; j < 4; ++j) vn[r][j] = ldbf4(X1 + (size_t)(mbase + i + 2 + r) * D + 4 * lane + 256 * j); }
#pragma unroll
            for (int r = 0; r < 2; ++r) { float s = 0.f;
#pragma unroll
                for (int j = 0; j < 4; ++j) s += (v[r][j].x * v[r][j].x + v[r][j].y * v[r][j].y) + (v[r][j].z * v[r][j].z + v[r][j].w * v[r][j].w);
                const float rr = 1.0f / sqrtf(wave_sum(s) * (1.0f / D) + EPS);
                if (lane == 0) RR[i + r] = rr;
                unsigned* o4 = (unsigned*)(U2 + (size_t)(mbase + i + r) * D) + lane;
#pragma unroll
                for (int j = 0; j < 4; ++j) { const f32x4 aa = *(const LAS f32x4*)(AS + 4 * lane + 256 * j), sh = *(const LAS f32x4*)(AS + 1024 + 4 * lane + 256 * j);
                    const f32x4 y = v[r][j] * rr * aa + sh;
                    o4[64 * j] = pg8::pk4_fp8(y.x, y.y, y.z, y.w); } }
        }
        LDS_WAIT(); asm volatile("" ::: "memory");
#pragma unroll 1
        for (int tl = 0; tl < 2; ++tl) {
            const int row = mbase + 16 * tl + l15; const float rr = RR[16 * tl + l15];
            const bf16* xr = X1 + (size_t)row * D + 8 * g;
            f32x4 acc[2]; acc[0] = (f32x4){0.f, 0.f, 0.f, 0.f}; acc[1] = acc[0];
            f32x4 xc[4][2], xn[4][2];
#pragma unroll
            for (int k4 = 0; k4 < 4; ++k4) { xc[k4][0] = ldbf4(xr + 32 * k4); xc[k4][1] = ldbf4(xr + 32 * k4 + 4); }
#pragma unroll 1
            for (int kb = 0; kb < 8; ++kb) {
                const int kn = kb < 7 ? kb + 1 : kb;
#pragma unroll
                for (int k4 = 0; k4 < 4; ++k4) { xn[k4][0] = ldbf4(xr + 32 * (4 * kn + k4)); xn[k4][1] = ldbf4(xr + 32 * (4 * kn + k4) + 4); }
#pragma unroll
                for (int k4 = 0; k4 < 4; ++k4) { const int ks = 4 * kb + k4;
                    const f32x4 a0 = *(const LAS f32x4*)(AS + 32 * ks + 8 * g), a1 = *(const LAS f32x4*)(AS + 32 * ks + 8 * g + 4);
                    const f32x4 s0 = *(const LAS f32x4*)(AS + 1024 + 32 * ks + 8 * g), s1 = *(const LAS f32x4*)(AS + 1024 + 32 * ks + 8 * g + 4);
                    const f32x4 u0 = xc[k4][0] * rr * a0 + s0, u1 = xc[k4][1] * rr * a1 + s1;
                    bf16x8 bh, bl;
#pragma unroll
                    for (int j = 0; j < 4; ++j) { const unsigned h0 = f2bf(u0[j]), h1 = f2bf(u1[j]); bh[j] = (short)h0; bh[4 + j] = (short)h1;
                        bl[j] = (short)f2bf(u0[j] - __builtin_bit_cast(float, h0 << 16)); bl[4 + j] = (short)f2bf(u1[j] - __builtin_bit_cast(float, h1 << 16)); }
#pragma unroll
                    for (int mt = 0; mt < 2; ++mt) { const bf16x8 af = *(const LAS bf16x8*)(RWH + ((mt * 32 + ks) * 64 + lane) * 16); acc[mt] = MFMA16(af, bh, acc[mt]); acc[mt] = MFMA16(af, bl, acc[mt]); } }
#pragma unroll
                for (int k4 = 0; k4 < 4; ++k4) { xc[k4][0] = xn[k4][0]; xc[k4][1] = xn[k4][1]; }
            }
#pragma unroll
            for (int mt = 0; mt < 2; ++mt) { const f32x4 bb = *(const f32x4*)(rb + 16 * mt + 4 * g); *(LAS f32x4*)(LGT + l15 * 32 + 16 * mt + 4 * g) = acc[mt] + bb; }
            LDS_WAIT(); asm volatile("" ::: "memory");
            if (lane < 16) {
                float lv[32];
#pragma unroll
                for (int j = 0; j < 8; ++j) { const f32x4 t4 = *(const LAS f32x4*)(LGT + lane * 32 + 4 * j); lv[4 * j] = t4[0]; lv[4 * j + 1] = t4[1]; lv[4 * j + 2] = t4[2]; lv[4 * j + 3] = t4[3]; }
                unsigned taken = 0u; int sel[4]; float val[4];
#pragma unroll
                for (int k = 0; k < 4; ++k) { float best = -3.0e38f; int bi = 0;
#pragma unroll
                    for (int e = 0; e < 32; ++e) { const bool okk = ((taken >> e) & 1u) == 0u && lv[e] > best; best = okk ? lv[e] : best; bi = okk ? e : bi; }
                    sel[k] = bi; val[k] = best; taken |= 1u << bi; }
                const float e1 = __expf(val[1] - val[0]), e2 = __expf(val[2] - val[0]), e3 = __expf(val[3] - val[0]); const float inv = 1.0f / (1.0f + e1 + e2 + e3);
                const int rl = wave * 32 + 16 * tl + lane; const float pr[4] = {inv, e1 * inv, e2 * inv, e3 * inv};
#pragma unroll
                for (int k = 0; k < 4; ++k) { const int rk = __hip_atomic_fetch_add(LC + sel[k], 1, __ATOMIC_RELAXED, __HIP_MEMORY_SCOPE_WORKGROUP);
                    PE[rl * 4 + k] = sel[k]; PP[rl * 4 + k] = pr[k]; PR[rl * 4 + k] = rk; }
            }
            LDS_WAIT(); asm volatile("" ::: "memory");
        }
        __syncthreads();
        if (tid < 32) GB[tid] = (int)__hip_atomic_fetch_add(cntw + tid * 64, (unsigned)LC[tid], __ATOMIC_RELAXED, __HIP_MEMORY_SCOPE_AGENT);
        __syncthreads();
        for (int pi = tid; pi < 1024; pi += NTHR) { const int e = PE[pi], gg = e, pos = GB[e] + PR[pi], tok = rbk * 256 + (pi >> 2);
            ltok[(size_t)gg * LCAP + pos] = tok; lp[(size_t)gg * LCAP + pos] = PP[pi]; tgp[tok * 4 + (pi & 3)] = (gg << 16) | pos; }
        __syncthreads();
    }
    __syncthreads();
}
__device__ __forceinline__ void p6_convert(const Args& a, LAS unsigned char* lds, int vcu, int G) {
    const int tid = threadIdx.x, lane = tid & 63, wave = __builtin_amdgcn_readfirstlane(tid >> 6);
    {
        const int gw = vcu * NWAVES + wave, NGW = G * NWAVES; LAS float* scr = (LAS float*)(lds + wave * 16384);
        unsigned char* wgut = a.ws + WS_WGU; unsigned char* wdt = a.ws + WS_WD;
        constexpr int I_GU = 32 * 16 * 64, I_DN = 32 * 16 * 32;
        for (int it = gw; it < I_GU + I_DN; it += NGW) {
            if (it < I_GU) { const int e = it >> 10, r = it & 1023, kb = r >> 6, nb = r & 63, n0 = 32 * nb, hf = n0 >> 10, j0 = n0 & 1023;
                transpose_item_f8(a.in[I_WGU] + (size_t)e * 1024 * 2048, 2048, wgut + (size_t)e * 2048 * 1024, 64 * kb, n0, 256 * (j0 >> 7) + 128 * hf + (j0 & 127), pg8::WSC, scr, lane); }
            else { const int r0 = it - I_GU, e = r0 >> 9, r = r0 & 511, kb = r >> 5, nb = r & 31;
                transpose_item_f8(a.in[I_WD] + (size_t)e * 1024 * 1024, 1024, wdt + (size_t)e * 1024 * 1024, 64 * kb, 32 * nb, 32 * nb, pg8::WSC, scr, lane); }
        }
    }
}

__device__ __forceinline__ int moe_tables(const Args& a, LAS unsigned char* lds) {
    const int tid = threadIdx.x;
    LAS int* CN = (LAS int*)(lds + TAB_OFF); LAS int* TS = CN + 64; LAS int* TAB = CN + 128;
    unsigned* cntw = (unsigned*)(a.ws + WS_CTL) + CW_CNT;
    __syncthreads();
    if (tid < 32) { int c = (int)__hip_atomic_load(cntw + tid * 64, __ATOMIC_RELAXED, __HIP_MEMORY_SCOPE_AGENT); CN[tid] = c > LCAP ? LCAP : c; }
    __syncthreads();
    if (tid == 0) { int s = 0; for (int e = 0; e < 32; ++e) { TS[e] = s; s += (CN[e] + 255) >> 8; } TS[32] = s > MAXTILES ? MAXTILES : s; }
    __syncthreads();
    const int nt = TS[32];
    for (int tau = tid; tau < nt; tau += NTHR) { int e = 0;
#pragma unroll 1
        for (int k = 1; k < 32; ++k) if (TS[k] <= tau) e = k;
        TAB[tau] = (e << 16) | (tau - TS[e]); }
    __syncthreads();
    return nt;
}

__device__ __forceinline__ void p9_combine(const Args& a, LAS unsigned char* lds, int vcu, int G, bool dry = false) {
    const int tid = threadIdx.x, lane = tid & 63, wave = __builtin_amdgcn_readfirstlane(tid >> 6);
    (void)moe_tables(a, lds);
    const LAS int* TS = (const LAS int*)(lds + TAB_OFF) + 64;
    const float* mods = (const float*)(a.ws + WS_MODS); const float* fg = a.in[I_FNG]; const int* tgp = (const int*)(a.ws + WS_TGP); const unsigned char* Y = a.ws + WS_Y;
    float* O = a.out; const bf16* X1 = (const bf16*)(a.ws + WS_X1B);
    const int gw = vcu * NWAVES + wave, NGW = G * NWAVES;
    f32x4 gv[4];
#pragma unroll
    for (int j = 0; j < 4; ++j) gv[j] = *(const f32x4*)(fg + 4 * lane + 256 * j);
    for (int i0 = gw; i0 < NLAT; i0 += 2 * NGW) {
        int gpv[2][4];
#pragma unroll
        for (int r = 0; r < 2; ++r) { const int i = i0 + r * NGW; const int m = i < NLAT ? i : i0;
#pragma unroll
            for (int k = 0; k < 4; ++k) gpv[r][k] = tgp[m * 4 + k]; }
        f32x4 acc[2][4], x1v[2][4];
#pragma unroll
        for (int r = 0; r < 2; ++r) { const int i = i0 + r * NGW; const int m = i < NLAT ? i : i0;
#pragma unroll
            for (int j = 0; j < 4; ++j) { acc[r][j] = (f32x4){0.f, 0.f, 0.f, 0.f}; x1v[r][j] = ldbf4(X1 + (size_t)m * D + 4 * lane + 256 * j); }
#pragma unroll
            for (int k = 0; k < 4; ++k) { const int gp = gpv[r][k], g = (gp >> 16) & 31, pos = gp & 0xffff; const size_t prow = (size_t)TS[g] * 256 + pos;
                const int* yr = (const int*)(Y + prow * D) + lane;
#pragma unroll
                for (int j = 0; j < 4; ++j) { const int w = yr[64 * j]; const f32x2 lo = __builtin_amdgcn_cvt_pk_f32_fp8(w, false), hi = __builtin_amdgcn_cvt_pk_f32_fp8(w, true); acc[r][j] += (f32x4){lo.x, lo.y, hi.x, hi.y}; } } }
#pragma unroll
        for (int r = 0; r < 2; ++r) { const int i = i0 + r * NGW; if (i >= NLAT) continue;
            const int m = i, b = m >> 11; const float* md = mods + (size_t)b * 6144 + 5 * 1024;
            f32x4 v[4]; float s = 0.f;
#pragma unroll
            for (int j = 0; j < 4; ++j) { const f32x4 g5 = *(const f32x4*)(md + 4 * lane + 256 * j) * pg8::YSCI;
                v[j] = x1v[r][j] + g5 * acc[r][j]; s += (v[j].x * v[j].x + v[j].y * v[j].y) + (v[j].z * v[j].z + v[j].w * v[j].w); }
            const float rr = 1.0f / sqrtf(wave_sum(s) * (1.0f / D) + EPS);
#pragma unroll
            for (int j = 0; j < 4; ++j) { const f32x4 ov = v[j] * rr * gv[j]; if (!dry) *(f32x4*)(O + (size_t)m * D + 4 * lane + 256 * j) = ov; else asm volatile("" :: "v"(ov)); } }
    }
}

constexpr int NPH = 10;
__global__ void __launch_bounds__(NTHR, 2) fwd_kernel(Args args) {
    extern __shared__ __attribute__((aligned(16))) unsigned char lds_raw[];
    LAS unsigned char* lds = (LAS unsigned char*)lds_raw;
    const int tid = threadIdx.x, G = gridDim.x, bx = blockIdx.x;
    const int vcu = (G % 8 == 0) ? (bx % 8) * (G / 8) + bx / 8 : bx;
    volatile LAS unsigned* MISC = (volatile LAS unsigned*)(lds + MISC_OFF);
    if (tid < 64) MISC[tid] = 0u;
    __syncthreads();
    unsigned* ctl = (unsigned*)(args.ws + WS_CTL);
    const int lo = args.ph_lo, hi = args.ph_hi;
    XcdBarrier bar; bar.bar = ctl + CW_BAR + args.li * XCD_BAR_WORDS; bar.x = 0; bar.st = MISC + 8;
    if (hi - lo > 1) bar = xcd_barrier_post(ctl + CW_BAR + args.li * XCD_BAR_WORDS, MISC + 8);
#ifndef PHMASK
#define PHMASK 0x3ff
#endif
#define IN(k) (((PHMASK >> (k)) & 1) && lo <= (k) && (k) < hi)
#define SEAM(k) do { if (IN(k) && IN((k) + 1)) xcd_barrier(bar); } while (0)
    unsigned char* ws = args.ws;
#ifndef PROBE_DUP
#define PROBE_DUP 0
#endif
#define REPS(k) (1 + ((PROBE_DUP >> (k)) & 1))
    if (IN(0)) { for (int rep = 0; rep < REPS(0); ++rep) { p0_prologue(args, lds, vcu, G); __syncthreads(); } SEAM(0); }
    if (IN(1)) { for (int rep = 0; rep < REPS(1); ++rep) p1_norm1(args, vcu, G); p1_weight_copies(args, lds, vcu, G); SEAM(1); }
    if (IN(2)) {
        { pg8::ProbIn2<false> P{(const char*)(ws + WS_U), (const char*)(ws + WS_WIN), G, bx};
          pg8::EpiZ E{(bf16*)(ws + WS_Z), 1.0f};
          pg8::gemm_phase<pg8::EpiZ, pg8::ProbIn2<false>, true>(lds, P, E); }
        { pg8::ProbIn2<true> P{(const char*)(ws + WS_U8), (const char*)(ws + WS_WIN8), G, G - 1 - bx};
          pg8::EpiZ E{(bf16*)(ws + WS_Z), 1.0f / (USC * pg8::WSC)};
          pg8::gemm_phase<pg8::EpiZ, pg8::ProbIn2<true>, true>(lds, P, E); }
        SEAM(2);
    }
    if (IN(3)) { p3_chains(args, lds, vcu, G); if (REPS(3) > 1) { __syncthreads(); p3_chains(args, lds, vcu, G); } SEAM(3); }
    if (IN(4)) { p4_outputs(args, lds, vcu, G); if (REPS(4) > 1) { __syncthreads(); p4_outputs(args, lds, vcu, G); } SEAM(4); }
    if (IN(5)) {
        pg8::ProbDense P{(const char*)(ws + WS_U), (const char*)(ws + WS_WOUT), NLAT / 256, D / 256, G, bx};
        pg8::EpiX1 E{args.in[I_X], (const float*)(ws + WS_POS), (const float*)(ws + WS_MODS), (bf16*)(ws + WS_X1B)};
        pg8::gemm_phase<pg8::EpiX1, pg8::ProbDense, true>(lds, P, E);
        if (REPS(5) > 1) pg8::gemm_phase<pg8::EpiX1, pg8::ProbDense, true>(lds, P, E);
        SEAM(5);
    }
    if (IN(6)) { p6_router(args, lds, vcu, G);
        if (REPS(12) > 1) { xcd_barrier(bar); if (bx == 0 && tid < 64) (ctl + CW_CNT)[tid * 64] = 0u; xcd_barrier(bar); p6_router(args, lds, vcu, G); }
        p6_convert(args, lds, vcu, G); if (REPS(6) > 1) p6_convert(args, lds, vcu, G); SEAM(6); }
    if (IN(7)) {
        const int ntl = moe_tables(args, lds);
        pg8::ProbMoe<true> P{(const char*)(ws + WS_U), (const char*)(ws + WS_WGU), (const int*)(ws + WS_LTOK), (const LAS int*)(lds + TAB_OFF) + 128, (const LAS int*)(lds + TAB_OFF), ntl, 8, G, bx, (size_t)2048 * 1024, args.in[I_BGU], nullptr};
        pg8::EpiGU E{ws + WS_ACT, lds + PF_OFF};
        pg8::gemm_phase<pg8::EpiGU, pg8::ProbMoe<true>, true>(lds, P, E);
        if (REPS(7) > 1) pg8::gemm_phase<pg8::EpiGU, pg8::ProbMoe<true>, true>(lds, P, E);
        SEAM(7);
    }
    if (IN(8)) {
        const int ntl = moe_tables(args, lds);
        pg8::ProbMoe<false> P{(const char*)(ws + WS_ACT), (const char*)(ws + WS_WD), (const int*)(ws + WS_LTOK), (const LAS int*)(lds + TAB_OFF) + 128, (const LAS int*)(lds + TAB_OFF), ntl, 4, G, bx, (size_t)1024 * 1024, args.in[I_BD], (const float*)(ws + WS_LP)};
        pg8::EpiDown E{ws + WS_Y, lds + PF_OFF, (const LAS int*)(lds + TAB_OFF)};
        pg8::gemm_phase<pg8::EpiDown, pg8::ProbMoe<false>, true>(lds, P, E);
        if (REPS(8) > 1) pg8::gemm_phase<pg8::EpiDown, pg8::ProbMoe<false>, true>(lds, P, E);
        SEAM(8);
    }
    if (IN(9)) { if (REPS(9) > 1) p9_combine(args, lds, vcu, G, true); p9_combine(args, lds, vcu, G); }
#undef IN
#undef SEAM
#undef REPS
}

extern "C" void kernel_launch(void* const* d_in, const int* in_sizes, int n_in, void* d_out, int out_size, void* d_ws, size_t ws_size, hipStream_t stream) {
    static int grid = 0;
    if (grid == 0) {
        if (n_in != 24 || in_sizes[0] != NLAT * D || out_size != NLAT * D || ws_size < WS_END) { fprintf(stderr, "kernel_launch: unexpected shapes (n_in %d, in0 %d, out %d, ws %zu); nothing launched\n", n_in, n_in > 0 ? in_sizes[0] : -1, out_size, ws_size); grid = -1; return; }
        int dev = 0, cus = 0, per_cu = 0;
        if (hipGetDevice(&dev) != hipSuccess || hipDeviceGetAttribute(&cus, hipDeviceAttributeMultiprocessorCount, dev) != hipSuccess) { grid = -1; return; }
        if (hipFuncSetAttribute((const void*)fwd_kernel, hipFuncAttributeMaxDynamicSharedMemorySize, LDS_BYTES) != hipSuccess) { fprintf(stderr, "kernel_launch: hipFuncSetAttribute failed\n"); grid = -1; return; }
        if (hipOccupancyMaxActiveBlocksPerMultiprocessor(&per_cu, (const void*)fwd_kernel, NTHR, LDS_BYTES) != hipSuccess || per_cu < 1) { fprintf(stderr, "kernel_launch: occupancy query reports %d workgroups per CU\n", per_cu); }
        (void)hipGetLastError();
        grid = cus;
    }
    if (grid < 0) return;
    if (hipMemsetAsync((char*)d_ws + WS_CTL, 0, CTL_ZERO_BYTES, stream) != hipSuccess) return;
    Args a{};
    for (int i = 0; i < 24; ++i) a.in[i] = (const float*)d_in[i];
    a.out = (float*)d_out; a.ws = (unsigned char*)d_ws; a.pad = 0;
#if MK_N_LAUNCHES == 1
    a.ph_lo = 0; a.ph_hi = NPH; a.li = 0;
    hipLaunchKernelGGL(fwd_kernel, dim3(grid), dim3(NTHR), LDS_BYTES, stream, a);
#else
    for (int ph = 0; ph < NPH; ++ph) { a.ph_lo = ph; a.ph_hi = ph + 1; a.li = ph; hipLaunchKernelGGL(fwd_kernel, dim3(grid), dim3(NTHR), LDS_BYTES, stream, a); }
#endif
}
```

```cpp
#include <hip/hip_runtime.h>
#include <cstdio>
#include <cstdint>

#ifndef MK_N_LAUNCHES
#define MK_N_LAUNCHES 1
#endif

#define GAS __attribute__((address_space(1)))
#define LAS __attribute__((address_space(3)))
typedef unsigned short bf16;
typedef short bf16x8 __attribute__((ext_vector_type(8)));
typedef short s16x4 __attribute__((ext_vector_type(4)));
typedef float f32x4 __attribute__((ext_vector_type(4)));
typedef float f32x2 __attribute__((ext_vector_type(2)));
typedef unsigned u32x4 __attribute__((ext_vector_type(4)));
typedef unsigned u32x2 __attribute__((ext_vector_type(2)));

constexpr int NB = 32, T = 2048, D = 1024, CT = 256;
constexpr int NLAT = NB * T, NCTX = NB * CT, NTOK = NLAT + NCTX;
constexpr int INW = 3120, ZW = 3328;
constexpr size_t PL64 = (size_t)NTOK * 64, PL128 = (size_t)NTOK * 128;
constexpr int F_MLQ = 0, F_MLK = 1, F_GQ = 2, F_GK = 3, F_MLV = 0, F_MLO = 1, F_GV = 2, F_GG = 3;
__host__ __device__ constexpr size_t plane64(int f, int h) { return (size_t)(f * 4 + h) * PL64; }
__host__ __device__ constexpr size_t plane128(int f, int h) { return 16 * PL64 + (size_t)(f * 4 + h) * PL128; }
constexpr size_t Z_MISC = 16 * PL64 + 16 * PL128;
constexpr int M_MLG = 0, M_LR = 16;
constexpr int NE = 32, TOPK = 4, DE = 1024;
constexpr int LCAP = 65536;
constexpr int MAXTILES = 1056;
constexpr float EPS = 1e-6f;

constexpr size_t MiB = 1u << 20;
constexpr size_t WS_CTL = 0, CTL_ZERO_BYTES = 1 * MiB;
constexpr size_t WS_MODS = 1 * MiB;
constexpr size_t WS_POS = 2 * MiB;
constexpr size_t WS_WIN = 10 * MiB;
constexpr size_t WS_WOUT = 17 * MiB;
constexpr size_t WS_RWT = 19 * MiB;
constexpr size_t WS_LTOK = 20 * MiB;
constexpr size_t WS_LP = 28 * MiB;
constexpr size_t WS_TGP = 36 * MiB;
constexpr size_t WS_NST = 37 * MiB;
constexpr size_t WS_U = 40 * MiB;
constexpr size_t WS_Z = 184 * MiB;
constexpr size_t WS_ST = 652 * MiB;
constexpr size_t WS_WGU = 104 * MiB;
constexpr size_t WS_WD = 168 * MiB;
constexpr size_t WS_ACT = 200 * MiB;
constexpr size_t WS_Y = 472 * MiB;
constexpr size_t WS_X1B = 736 * MiB;
constexpr size_t WS_U8 = 652 * MiB;
constexpr size_t WS_WIN8 = 20 * MiB;
constexpr size_t WS_END = 908 * MiB;
constexpr int CW_CNT = 2048;
constexpr int CW_BAR = 8192;

constexpr int RING_BYTES = 131072;
constexpr int LDS_BYTES = 147456;
constexpr int MISC_OFF = LDS_BYTES - 256;
constexpr int TAB_OFF = RING_BYTES;
constexpr int PF_OFF = TAB_OFF + 5120, PF_SLOT = 3072;
constexpr int NWAVES = 8, NTHR = 512;

#define LDS_WAIT() asm volatile("s_waitcnt lgkmcnt(0)" ::: "memory")
#define VM_WAIT() asm volatile("s_waitcnt vmcnt(0)" ::: "memory")
#define BAR_LDS() do { asm volatile("s_waitcnt lgkmcnt(0)" ::: "memory"); __builtin_amdgcn_s_barrier(); asm volatile("" ::: "memory"); } while (0)
__device__ __forceinline__ unsigned f2bf(float f) { unsigned u = __builtin_bit_cast(unsigned, f); return (u + 0x7fffu + ((u >> 16) & 1u)) >> 16; }
__device__ __forceinline__ unsigned pk2(float lo, float hi) { unsigned r; asm("v_cvt_pk_bf16_f32 %0, %1, %2" : "=v"(r) : "v"(lo), "v"(hi)); return r; }
__device__ __forceinline__ float bf2f(unsigned short b) { return __builtin_bit_cast(float, ((unsigned)b) << 16); }
__device__ __forceinline__ float bflo(unsigned w) { return __builtin_bit_cast(float, w << 16); }
__device__ __forceinline__ float bfhi(unsigned w) { return __builtin_bit_cast(float, w & 0xffff0000u); }
__device__ __forceinline__ float fsigmoid(float x) { return __builtin_amdgcn_rcpf(1.0f + __expf(-x)); }
__device__ __forceinline__ float fsilu(float x) { return x * __builtin_amdgcn_rcpf(1.0f + __expf(-x)); }
__device__ __forceinline__ float flogsigmoid(float x) { return fminf(x, 0.f) - log1pf(__expf(-fabsf(x))); }
__device__ __forceinline__ f32x4 ldbf4(const bf16* p) { const u32x2 w = *(const u32x2*)p; return (f32x4){bflo(w.x), bfhi(w.x), bflo(w.y), bfhi(w.y)}; }
__device__ __forceinline__ float wave_sum(float v) {
#pragma unroll
    for (int o = 1; o < 64; o <<= 1) v += __shfl_xor(v, o);
    return v;
}

namespace pg8 {
#define PG8_LAS __attribute__((address_space(3)))
typedef unsigned short bf16_t;
constexpr int BM = 256, BK = 64, HALF = 128, HTB = HALF * BK * 2, STAGE_BYTES = 8 * HTB, NXCD = 8, WGM = 8, GK = 1024;
__host__ __device__ __forceinline__ int lds_byte(int r, int c) { const int st = (r >> 4) * 2 + (c >> 5), rr = r & 15, cc = c & 31, ob = rr * 64 + cc * 2; return st * 1024 + (ob ^ (((ob >> 9) & 1) << 5)); }
__host__ __device__ __forceinline__ void stage_rc(int b, int& R, int& C) { const int st = b / 1024, sb = b % 1024, swz = sb ^ (((sb >> 9) & 1) << 5); R = (st >> 1) * 16 + swz / 64; C = (st & 1) * 32 + (swz % 64) / 2; }
__host__ __device__ __forceinline__ int perm32(int rho) { const int n = rho >> 4, i = rho & 15; return 8 * (i >> 2) + 4 * n + (i & 3); }
__host__ __device__ __forceinline__ int perm32w(int rho) { const int n = rho >> 4, i = rho & 15; return 16 * (i >> 2) + 4 * n + (i & 3); }
__device__ __forceinline__ unsigned cvt_pk_bf16(float lo, float hi) { unsigned r; asm volatile("v_cvt_pk_bf16_f32 %0, %1, %2" : "=v"(r) : "v"(lo), "v"(hi)); return r; }

typedef int i32x8 __attribute__((ext_vector_type(8)));
__device__ __forceinline__ i32x8 cat16(bf16x8 a, bf16x8 b) { typedef int i32x4 __attribute__((ext_vector_type(4))); const i32x4 x = __builtin_bit_cast(i32x4, a), y = __builtin_bit_cast(i32x4, b); return __builtin_shufflevector(x, y, 0, 1, 2, 3, 4, 5, 6, 7); }
__device__ __forceinline__ void mfma_f8(f32x4& acc, const i32x8& a, const i32x8& b, int sc) {
    asm volatile("s_nop 1\n\tv_mfma_scale_f32_16x16x128_f8f6f4 %0, %1, %2, %0, %3, %3 op_sel_hi:[0,0,0]" : "+v"(acc) : "v"(a), "v"(b), "v"(sc));
}
__device__ __forceinline__ void dma16(const void* g, PG8_LAS unsigned char* l) {
    unsigned keep; const unsigned dst = (unsigned)(size_t)l;
    asm volatile("s_mov_b32 %0, m0\n\ts_mov_b32 m0, %2\n\ts_nop 0\n\tglobal_load_lds_dwordx4 %1, off\n\ts_mov_b32 m0, %0" : "=&s"(keep) : "v"(g), "s"(dst) : "memory");
}
struct Unit { int pm, pn, g, r0, slot; };

__device__ __forceinline__ bool order_next(int i, int G, int c, int nM, int nN, int& pm, int& pn, const int WGM = pg8::WGM) {
    const int nwg = nM * nN; const long L = (long)i * G + c; if (L >= nwg) return false;
    int wgid = (int)L; { const int q = nwg / NXCD, r = nwg % NXCD, xcd = wgid % NXCD, off = wgid / NXCD; wgid = (xcd < r ? xcd * (q + 1) : r * (q + 1) + (xcd - r) * q) + off; }
    const int nig = WGM * nN, gid = wgid / nig, fm = gid * WGM, gsz = (nM - fm) < WGM ? (nM - fm) : WGM;
    pm = fm + ((wgid % nig) % gsz); pn = (wgid % nig) / gsz; return true;
}

template <class Epi, class Prob, bool ALIGN_EPI>
__device__ __forceinline__ void gemm_phase(PG8_LAS unsigned char* lds, const Prob& P, const Epi& E) {
    const int tid = threadIdx.x, wid = __builtin_amdgcn_readfirstlane(tid >> 6), lane = tid & 63, wr = wid >> 2, wc = wid & 3, fr = lane & 15, fq = lane >> 4;
    constexpr bool F8 = Prob::FP8; constexpr bool CM = Epi::CMAP == 1; constexpr int NST = Epi::NST; static_assert(GK / (F8 ? 128 : 64) >= 6, "peeled K loop");
    constexpr int RSB = F8 ? GK : GK * 2, nt = RSB / 128;
    unsigned vB, vA, cA2;
    { int R, C; stage_rc(tid * 16, R, C); const int Rb = CM ? 64 * (R >> 5) + perm32w(R & 31) : Epi::PERM ? ((R & ~31) + perm32(R & 31)) : R; vB = (unsigned)(Rb * RSB + C * 2); vA = (unsigned)(R * RSB + C * 2); cA2 = (unsigned)(C * 2); }
    constexpr size_t kstep = (size_t)(BK * 2);
    constexpr size_t hstep = (size_t)(CM ? 8 : HALF) * RSB;
    const unsigned ldsw = (unsigned)wid * 1024u;
    const int aoff = lds_byte(wr * 64 + fr, fq * 8), boff = lds_byte(wc * 32 + fr, fq * 8);
#define PG8_SA(b, h) (((b) * 2 + (h)) * HTB)
#define PG8_SB(b, h) ((4 + (b) * 2 + (h)) * HTB)
#define PG8_STAGE_B(bufoff, gbase) do { _Pragma("unroll") for (int _i = 0; _i < 2; ++_i) \
        __builtin_amdgcn_global_load_lds((const unsigned*)((const char*)(gbase) + (size_t)(_i * (CM ? 128 : 64) * RSB) + vB), (PG8_LAS unsigned*)(lds + (bufoff) + ldsw + _i * 8192), 16, 0, 0); } while (0)
#define PG8_STAGE_A(bufoff, abase, tk, h) do { _Pragma("unroll") for (int _i = 0; _i < 2; ++_i) { \
        if constexpr (GATH) { const unsigned _t = _i ? ((tk)[h] >> 16) : ((tk)[h] & 0xffffu); \
            __builtin_amdgcn_global_load_lds((const unsigned*)((abase) + (size_t)(_t * (unsigned)RSB + cA2)), (PG8_LAS unsigned*)(lds + (bufoff) + ldsw + _i * 8192), 16, 0, 0); } \
        else __builtin_amdgcn_global_load_lds((const unsigned*)((abase) + (size_t)(((h) * 128 + _i * 64) * RSB) + vA), (PG8_LAS unsigned*)(lds + (bufoff) + ldsw + _i * 8192), 16, 0, 0); } } while (0)
#define PG8_LDA(dst, b, h) do { _Pragma("unroll") for (int m = 0; m < 4; ++m) _Pragma("unroll") for (int k = 0; k < 2; ++k) dst[m][k] = *(const PG8_LAS bf16x8*)(lds + PG8_SA(b, h) + aoff + m * 2048 + k * 1024); } while (0)
#define PG8_LDB(dst, b, h) do { _Pragma("unroll") for (int n = 0; n < 2; ++n) _Pragma("unroll") for (int k = 0; k < 2; ++k) dst[n][k] = *(const PG8_LAS bf16x8*)(lds + PG8_SB(b, h) + boff + n * 2048 + k * 1024); } while (0)
#define PG8_MMA(ai, bj, At, Bt) do { __builtin_amdgcn_s_setprio(1); _Pragma("unroll") for (int m = 0; m < 4; ++m) _Pragma("unroll") for (int n = 0; n < 2; ++n) { \
        if constexpr (F8) { mfma_f8(acc[ai][bj][m][n], cat16(Bt[n][0], Bt[n][1]), cat16(At[m][0], At[m][1]), sc127); } \
        else { _Pragma("unroll") for (int k = 0; k < 2; ++k) acc[ai][bj][m][n] = __builtin_amdgcn_mfma_f32_16x16x32_bf16(Bt[n][k], At[m][k], acc[ai][bj][m][n], 0, 0, 0); } } \
        __builtin_amdgcn_s_setprio(0); } while (0)
#define PG8_WAIT_V(n) asm volatile("s_waitcnt vmcnt(" #n ")" ::: "memory")
#define PG8_WAIT_VN(n) asm volatile("s_waitcnt vmcnt(%0)" :: "n"(n) : "memory")
#define PG8_WAIT_L(n) asm volatile("s_waitcnt lgkmcnt(" #n ")" ::: "memory")
#define PG8_BAR __builtin_amdgcn_s_barrier()
#define PG8_SCHED __builtin_amdgcn_sched_barrier(0)
    Unit cur, nxt; int ui = 0;
    if (!P.next(0, cur)) return;
    f32x4 acc[2][2][4][2];
#pragma unroll
    for (int a = 0; a < 2; ++a)
#pragma unroll
        for (int b = 0; b < 2; ++b)
#pragma unroll
            for (int m = 0; m < 4; ++m)
#pragma unroll
                for (int n = 0; n < 2; ++n) acc[a][b][m][n] = (f32x4){0.f, 0.f, 0.f, 0.f};
    bf16x8 At[4][2], B0[2][2], B1[2][2];
    constexpr bool GATH = Prob::GATHERS;
    int sc127 = 127; asm volatile("" : "+v"(sc127));
    unsigned tc[2] = {0u, 0u}, tn[2] = {0u, 0u};
    constexpr bool PF = Prob::PREFETCH;
    cur.slot = 0;
    if constexpr (PF) { P.pf_issue(cur, 0, wid, lane, lds); PG8_WAIT_V(0); PG8_BAR; asm volatile("" ::: "memory"); }
    if constexpr (GATH) P.a_tok(cur, tid, tc, lds);
    const char* cA = P.a_ptr(cur);
    const char* cB = P.b_ptr(cur);
    PG8_STAGE_B(PG8_SB(0, 0), cB); PG8_STAGE_B(PG8_SB(0, 1), cB + hstep); PG8_STAGE_A(PG8_SA(0, 0), cA, tc, 0); PG8_STAGE_A(PG8_SA(0, 1), cA, tc, 1);
    if (wr == 1) PG8_BAR;
    PG8_WAIT_V(2); PG8_BAR;
    PG8_STAGE_B(PG8_SB(1, 0), cB + kstep); PG8_STAGE_A(PG8_SA(1, 0), cA + kstep, tc, 0); PG8_STAGE_B(PG8_SB(1, 1), cB + hstep + kstep); PG8_STAGE_A(PG8_SA(1, 1), cA + kstep, tc, 1);
    PG8_WAIT_V(0); PG8_BAR;
    bool relax = false;
    for (;;) {
        const bool has_next = P.next(ui + 1, nxt);
        const char* nB = cB; const char* nA = cA;
        nxt.slot = (ui + 1) % 3;
        if (has_next) { if constexpr (PF) P.pf_issue(nxt, nxt.slot, wid, lane, lds); nA = P.a_ptr(nxt); nB = P.b_ptr(nxt); }
        tn[0] = tc[0]; tn[1] = tc[1];
        {
            const char* a2 = cA + (size_t)2 * kstep; const char* a3 = a2 + kstep; const char* b2 = cB + (size_t)2 * kstep; const char* b3 = b2 + kstep;
            PG8_LDB(B0, 0, 0); PG8_LDB(B1, 0, 1); PG8_SCHED; PG8_LDA(At, 0, 0);
            if (relax) PG8_WAIT_VN(8 + NST); else PG8_WAIT_V(8);
            PG8_WAIT_L(0); PG8_BAR; PG8_MMA(0, 0, At, B0); PG8_MMA(0, 1, At, B1); PG8_BAR; PG8_SCHED;
            PG8_LDA(At, 0, 1); PG8_STAGE_B(PG8_SB(0, 0), b2); PG8_STAGE_B(PG8_SB(0, 1), b2 + hstep); PG8_STAGE_A(PG8_SA(0, 0), a2, tc, 0);
            if (relax) PG8_WAIT_VN(8 + NST); else PG8_WAIT_V(8);
            PG8_WAIT_L(0); PG8_BAR; PG8_MMA(1, 0, At, B0); PG8_MMA(1, 1, At, B1); PG8_BAR; PG8_SCHED;
            PG8_LDB(B0, 1, 0); PG8_LDB(B1, 1, 1); PG8_SCHED; PG8_LDA(At, 1, 0); PG8_STAGE_A(PG8_SA(0, 1), a2, tc, 1);
            if (relax) PG8_WAIT_VN(8 + NST); else PG8_WAIT_V(8);
            PG8_WAIT_L(0); PG8_BAR; PG8_MMA(0, 0, At, B0); PG8_MMA(0, 1, At, B1); PG8_BAR; PG8_SCHED;
            PG8_LDA(At, 1, 1); PG8_STAGE_B(PG8_SB(1, 0), b3); PG8_STAGE_B(PG8_SB(1, 1), b3 + hstep); PG8_STAGE_A(PG8_SA(1, 0), a3, tc, 0);
            if (relax) PG8_WAIT_VN(8); else PG8_WAIT_V(8);
            PG8_WAIT_L(0); PG8_BAR; PG8_MMA(1, 0, At, B0); PG8_MMA(1, 1, At, B1); PG8_BAR; PG8_SCHED;
        }
#pragma unroll 1
        for (int t = 2; t < nt; t += 2) {
            const bool last = (t == nt - 2);
            if constexpr (GATH) { if (t == nt - 4 && has_next) P.a_tok(nxt, tid, tn, lds); }
            const char* a1 = cA + (size_t)(t + 1) * kstep;
            const char* a2 = last ? nA : cA + (size_t)(t + 2) * kstep; const char* a3 = a2 + kstep;
            const char* b2 = last ? nB : cB + (size_t)(t + 2) * kstep; const char* b3 = b2 + kstep;
            PG8_LDB(B0, 0, 0); PG8_LDB(B1, 0, 1); PG8_SCHED; PG8_LDA(At, 0, 0); PG8_STAGE_A(PG8_SA(1, 1), a1, tc, 1);
            PG8_WAIT_V(8); PG8_WAIT_L(0); PG8_BAR; PG8_MMA(0, 0, At, B0); PG8_MMA(0, 1, At, B1); PG8_BAR; PG8_SCHED;
            PG8_LDA(At, 0, 1); PG8_STAGE_B(PG8_SB(0, 0), b2); PG8_STAGE_B(PG8_SB(0, 1), b2 + hstep); { unsigned t2[2] = {last ? tn[0] : tc[0], last ? tn[1] : tc[1]}; PG8_STAGE_A(PG8_SA(0, 0), a2, t2, 0); }
            PG8_WAIT_V(8); PG8_WAIT_L(0); PG8_BAR; PG8_MMA(1, 0, At, B0); PG8_MMA(1, 1, At, B1); PG8_BAR; PG8_SCHED;
            PG8_LDB(B0, 1, 0); PG8_LDB(B1, 1, 1); PG8_SCHED; PG8_LDA(At, 1, 0); { unsigned t2[2] = {last ? tn[0] : tc[0], last ? tn[1] : tc[1]}; PG8_STAGE_A(PG8_SA(0, 1), a2, t2, 1); }
            PG8_WAIT_V(8); PG8_WAIT_L(0); PG8_BAR; PG8_MMA(0, 0, At, B0); PG8_MMA(0, 1, At, B1); PG8_BAR; PG8_SCHED;
            PG8_LDA(At, 1, 1); PG8_STAGE_B(PG8_SB(1, 0), b3); PG8_STAGE_B(PG8_SB(1, 1), b3 + hstep); { unsigned t2[2] = {last ? tn[0] : tc[0], last ? tn[1] : tc[1]}; PG8_STAGE_A(PG8_SA(1, 0), a3, t2, 0); }
            PG8_WAIT_V(8); PG8_WAIT_L(0); PG8_BAR; PG8_MMA(1, 0, At, B0); PG8_MMA(1, 1, At, B1); PG8_BAR; PG8_SCHED;
        }
        PG8_STAGE_A(PG8_SA(1, 1), nA + kstep, tn, 1);
        if constexpr (ALIGN_EPI) { if (wr == 0) PG8_BAR; }
        E(acc, cur, wr, wc, fr, fq);
        if (!has_next) break;
        relax = NST > 0 && E.full(cur, wc);
#pragma unroll
        for (int a = 0; a < 2; ++a)
#pragma unroll
            for (int b = 0; b < 2; ++b)
#pragma unroll
                for (int m = 0; m < 4; ++m)
#pragma unroll
                    for (int n = 0; n < 2; ++n) acc[a][b][m][n] = (f32x4){0.f, 0.f, 0.f, 0.f};
        cur = nxt; cB = nB; cA = nA; ++ui; tc[0] = tn[0]; tc[1] = tn[1];
        if constexpr (ALIGN_EPI) { if (wr == 1) PG8_BAR; }
    }
    PG8_WAIT_V(0);
    if constexpr (!ALIGN_EPI) { if (wr == 0) PG8_BAR; }
    PG8_BAR;
#undef PG8_SA
#undef PG8_SB
#undef PG8_STAGE_A
#undef PG8_STAGE_B
#undef PG8_LDA
#undef PG8_LDB
#undef PG8_MMA
#undef PG8_WAIT_V
#undef PG8_WAIT_VN
#undef PG8_WAIT_L
#undef PG8_BAR
#undef PG8_SCHED
}
}

#define XB_TMO      128
#define XB_XCNT(j)  (256  + 64 * (j))
#define XB_XSUB(j)  (1280 + 64 * (j))
#define XB_XGEN(j)  (2304 + 64 * (j))
#define XB_TOP      3328
#define XB_TOPGEN   3392
#define XCD_BAR_WORDS 3456
#define XB_SPIN_CAP (1u << 18)
__device__ __forceinline__ unsigned xb_ld(unsigned* p)              { return __hip_atomic_load(p, __ATOMIC_RELAXED, __HIP_MEMORY_SCOPE_AGENT); }
__device__ __forceinline__ unsigned xb_add(unsigned* p, unsigned v) { return __hip_atomic_fetch_add(p, v, __ATOMIC_RELAXED, __HIP_MEMORY_SCOPE_AGENT); }
__device__ __forceinline__ unsigned xb_xcc_id() { return (unsigned)__builtin_amdgcn_s_getreg((3 << 11) | 20) & 0xFu; }
#define XB_SPIN(cond, bar) do { unsigned _sp = 0; while (cond) { __builtin_amdgcn_s_sleep(1); \
    if ((++_sp & 255u) == 0u) { if (xb_ld(&(bar)[XB_TMO])) break; if (_sp > XB_SPIN_CAP) { atomicAdd(&(bar)[XB_TMO], 1u); break; } } } } while (0)
struct XcdBarrier { unsigned* bar; unsigned x; volatile LAS unsigned* st; };
__device__ __forceinline__ XcdBarrier xcd_barrier_post(unsigned* bar, volatile LAS unsigned* st) {
    XcdBarrier b; b.bar = bar; b.x = xb_xcc_id(); b.st = st;
    if (threadIdx.x == 0) (void)xb_add(&bar[XB_XCNT(b.x)], 1u);
    return b;
}
__device__ __forceinline__ void xcd_barrier_complete(unsigned* bar, unsigned x, unsigned& nloc, unsigned& nx) {
    const unsigned G = gridDim.x * gridDim.y * gridDim.z;
    unsigned sum, cnt, mine, sp = 0u;
    for (;;) {
        sum = 0u; cnt = 0u; mine = 0u;
#pragma unroll
        for (unsigned j = 0; j < 16; ++j) { const unsigned c = xb_ld(&bar[XB_XCNT(j)]); sum += c; cnt += (c > 0u) ? 1u : 0u; mine = (j == x) ? c : mine; }
        if (sum == G) break;
        __builtin_amdgcn_s_sleep(1);
        if ((++sp & 255u) == 0u) { if (xb_ld(&bar[XB_TMO])) break; if (sp > XB_SPIN_CAP) { atomicAdd(&bar[XB_TMO], 1u); break; } }
    }
    nloc = mine > 0u ? mine : 1u; nx = cnt > 0u ? cnt : 1u;
}
__device__ __forceinline__ void xcd_barrier(const XcdBarrier& b) {
    asm volatile("s_waitcnt vmcnt(0)" ::: "memory");
    __syncthreads();
    if (threadIdx.x == 0) {
        unsigned* bar = b.bar;
        __builtin_amdgcn_s_waitcnt(0);
        unsigned nloc = b.st[0], nx = b.st[1];
        if (nloc == 0u) { xcd_barrier_complete(bar, b.x, nloc, nx); b.st[0] = nloc; b.st[1] = nx; }
        const unsigned old = xb_add(&bar[XB_XSUB(b.x)], 1u);
        const unsigned gen = old / nloc;
        if (old + 1u == (gen + 1u) * nloc) {
            __builtin_amdgcn_fence(__ATOMIC_RELEASE, "agent");
            asm volatile("s_waitcnt vmcnt(0)" ::: "memory");
            const unsigned og = xb_add(&bar[XB_TOP], 1u);
            const unsigned tg = og / nx;
            if (og + 1u == (tg + 1u) * nx) xb_add(&bar[XB_TOPGEN], 1u);
            else XB_SPIN(xb_ld(&bar[XB_TOPGEN]) == tg, bar);
            __builtin_amdgcn_fence(__ATOMIC_ACQUIRE, "agent");
            xb_add(&bar[XB_XGEN(b.x)], 1u);
            asm volatile("s_waitcnt vmcnt(0)" ::: "memory");
        } else {
            XB_SPIN(xb_ld(&bar[XB_XGEN(b.x)]) == gen, bar);
            __builtin_amdgcn_fence(__ATOMIC_ACQUIRE, "agent");
            asm volatile("s_waitcnt vmcnt(0)" ::: "memory");
        }
    }
    __syncthreads();
}

namespace pg8 {
struct ProbDense {
    static constexpr bool FP8 = false, GATHERS = false, PREFETCH = false; const char* A; const char* Bt; int nM, nN, G, c;
    __device__ __forceinline__ bool next(int i, Unit& u) const { u.g = 0; u.r0 = 0; return order_next(i, G, c, nM, nN, u.pm, u.pn); }
    __device__ __forceinline__ const char* a_ptr(const Unit& u) const { return A + (size_t)u.pm * (256 * 2048); }
    __device__ __forceinline__ void a_tok(const Unit&, int, unsigned (&)[2], PG8_LAS unsigned char*) const {}
    __device__ __forceinline__ const char* b_ptr(const Unit& u) const { return Bt + (size_t)u.pn * (256 * 2048); }
};
struct ProbIn {
    static constexpr bool FP8 = false, GATHERS = false, PREFETCH = false; const char* A; const char* Bt; int G, c;
    __device__ __forceinline__ bool next(int i, Unit& u) const { u.g = 0; u.r0 = 0;
        const int L = i * G + c;
        if (L < 256 * 13) return order_next(i, G, c, 256, 13, u.pm, u.pn);
        const int L2 = L - 256 * 13; if (L2 >= 32 * 7) return false;
        const int k = L2 % 7; u.pm = 256 + L2 / 7; u.pn = k < 3 ? k + 1 : k < 6 ? k + 4 : 12; return true; }
    __device__ __forceinline__ const char* a_ptr(const Unit& u) const { return A + (size_t)u.pm * (256 * 2048); }
    __device__ __forceinline__ void a_tok(const Unit&, int, unsigned (&)[2], PG8_LAS unsigned char*) const {}
    __device__ __forceinline__ const char* b_ptr(const Unit& u) const { return Bt + (size_t)u.pn * (256 * 2048); }
};
template <bool F8> struct ProbIn2 {
    static constexpr bool FP8 = F8, GATHERS = false, PREFETCH = false; const char* A; const char* Bt; int G, c;
    static constexpr int NT = F8 ? 8 : 5, NC = F8 ? 4 : 3, RS = F8 ? 1024 : 2048;
    __device__ __forceinline__ bool next(int i, Unit& u) const { u.g = 0; u.r0 = 0;
        const int L = i * G + c; int k;
        if (L < 256 * NT) { if (!order_next(i, G, c, 256, NT, u.pm, k)) return false; u.pn = F8 ? (k < 4 ? 2 + k : 4 + k) : (k < 2 ? k : k < 4 ? k + 4 : 12); return true; }
        const int L2 = L - 256 * NT; if (L2 >= 32 * NC) return false;
        k = L2 % NC; u.pm = 256 + L2 / NC; u.pn = F8 ? (k < 2 ? 2 + k : 6 + k) : (k == 0 ? 1 : k == 1 ? 7 : 12); return true; }
    __device__ __forceinline__ const char* a_ptr(const Unit& u) const { return A + (size_t)u.pm * (256 * RS); }
    __device__ __forceinline__ void a_tok(const Unit&, int, unsigned (&)[2], PG8_LAS unsigned char*) const {}
    __device__ __forceinline__ const char* b_ptr(const Unit& u) const { return Bt + (size_t)u.pn * (256 * RS); }
};
template <bool GATHER> struct ProbMoe {
    static constexpr bool FP8 = true, GATHERS = GATHER, PREFETCH = true;
    const char* A; const char* W; const int* ltok; const LAS int* tab; const LAS int* cnts; int nM, nN, G, c; size_t wstride; const float* bias; const float* lp;
    __device__ __forceinline__ bool next(int i, Unit& u) const {
        if (!order_next(i, G, c, nM, nN, u.pm, u.pn, GATHER ? 4 : 8)) return false;
        const int e = tab[u.pm]; u.g = e >> 16; u.r0 = (e & 0xffff) * 256; return true;
    }
    __device__ __forceinline__ const char* a_ptr(const Unit& u) const { return GATHER ? A : A + (size_t)u.pm * (256 * 1024); }
    __device__ __forceinline__ void pf_issue(const Unit& u, int slot, int wid, int lane, PG8_LAS unsigned char* lds) const {
        PG8_LAS unsigned char* sl = lds + PF_OFF + slot * PF_SLOT;
        if (GATHER && wid == 0) dma16(ltok + (size_t)u.g * LCAP + u.r0 + 4 * lane, sl);
        if (wid == 1) { const float* src = GATHER ? bias + (size_t)(u.g & 31) * 2048 + (lane >> 5) * 1024 + u.pn * 128 + (lane & 31) * 4 : bias + (size_t)(u.g & 31) * 1024 + u.pn * 256 + lane * 4; dma16(src, sl + 1024); }
        if (!GATHER && wid == 2) dma16(lp + (size_t)u.g * LCAP + u.r0 + 4 * lane, sl + 2048);
    }
    __device__ __forceinline__ void a_tok(const Unit& u, int tid, unsigned (&tk)[2], PG8_LAS unsigned char* lds) const {
        if constexpr (GATHER) {
            int R, C; stage_rc(tid * 16, R, C); (void)C; const int cnt = cnts[u.g]; const PG8_LAS int* T = (const PG8_LAS int*)(lds + PF_OFF + u.slot * PF_SLOT);
#pragma unroll
            for (int h = 0; h < 2; ++h) { unsigned t[2];
#pragma unroll
                for (int i = 0; i < 2; ++i) { const int row = h * 128 + i * 64 + R; const int tok = T[row]; t[i] = (u.r0 + row < cnt) ? (unsigned)tok : 0u; }
                tk[h] = t[0] | (t[1] << 16); }
        }
    }
    __device__ __forceinline__ const char* b_ptr(const Unit& u) const { return W + (size_t)(u.g & 31) * wstride + (size_t)u.pn * (256 * 1024); }
};

struct EpiZ {
    static constexpr bool PERM = true; static constexpr int CMAP = 0, NST = 16; bf16_t* O; float sc;
    __device__ __forceinline__ bool full(const Unit& u, int) const { return u.pn != 12; }
    __device__ __forceinline__ void operator()(const f32x4 (&acc)[2][2][4][2], const Unit& u, int wr, int wc, int fr, int fq) const {
        const int row0 = u.pm * BM + wr * 64 + fr, pn = u.pn;
        int kind, f, hb;
        if (pn == 0) { kind = 0; f = F_MLQ; hb = 0; } else if (pn == 1) { kind = 0; f = F_MLK; hb = 0; } else if (pn == 6) { kind = 0; f = F_GQ; hb = 0; } else if (pn == 7) { kind = 0; f = F_GK; hb = 0; }
        else if (pn < 4) { kind = 1; f = F_MLV; hb = 2 * (pn - 2); } else if (pn < 6) { kind = 1; f = F_MLO; hb = 2 * (pn - 4); } else if (pn < 10) { kind = 1; f = F_GV; hb = 2 * (pn - 8); }
        else if (pn < 12) { kind = 1; f = F_GG; hb = 2 * (pn - 10); } else { kind = 2; f = 0; hb = 0; }
#pragma unroll
        for (int bj = 0; bj < 2; ++bj) {
            bf16_t* base; int pitch; bool ok = true;
            if (kind == 0) { base = O + plane64(f, 2 * bj + (wc >> 1)) + (wc & 1) * 32 + 8 * fq; pitch = 64; }
            else if (kind == 1) { base = O + plane128(f, hb + bj) + wc * 32 + 8 * fq; pitch = 128; }
            else { base = O + Z_MISC + wc * 32 + 8 * fq; pitch = 64; ok = (bj == 0) && (wc < 2); }
            if (ok) {
#pragma unroll
                for (int ai = 0; ai < 2; ++ai)
#pragma unroll
                    for (int m = 0; m < 4; ++m) { const f32x4 v0 = acc[ai][bj][m][0] * sc, v1 = acc[ai][bj][m][1] * sc;
                        u32x4 w; w.x = cvt_pk_bf16(v0[0], v0[1]); w.y = cvt_pk_bf16(v0[2], v0[3]); w.z = cvt_pk_bf16(v1[0], v1[1]); w.w = cvt_pk_bf16(v1[2], v1[3]);
                        *(u32x4*)(base + (size_t)(row0 + ai * HALF + m * 16) * pitch) = w; } }
        }
    }
};
struct EpiX1 {
    static constexpr bool PERM = true; static constexpr int CMAP = 0, NST = 16; const float* x; const float* pos; const float* mods; bf16_t* O;
    __device__ __forceinline__ bool full(const Unit&, int) const { return true; }
    __device__ __forceinline__ void operator()(const f32x4 (&acc)[2][2][4][2], const Unit& u, int wr, int wc, int fr, int fq) const {
        const int row0 = u.pm * BM + wr * 64 + fr, col0 = u.pn * BM + wc * 32 + 8 * fq;
        const int b = (u.pm * BM) >> 11;
        const float* g1 = mods + (size_t)b * 6144 + 2 * 1024 + col0;
        f32x4 gv[2][2];
#pragma unroll
        for (int bj = 0; bj < 2; ++bj)
#pragma unroll
            for (int n = 0; n < 2; ++n) gv[bj][n] = *(const f32x4*)(g1 + bj * HALF + 4 * n);
#pragma unroll
        for (int ai = 0; ai < 2; ++ai)
#pragma unroll
            for (int m = 0; m < 4; ++m) { const int row = row0 + ai * HALF + m * 16; const size_t off = (size_t)row * D + col0; const float* pp = pos + (size_t)(row & (T - 1)) * D + col0;
#pragma unroll
                for (int bj = 0; bj < 2; ++bj) { f32x4 r[2];
#pragma unroll
                    for (int n = 0; n < 2; ++n) { const f32x4 xv = *(const f32x4*)(x + off + bj * HALF + 4 * n); const f32x4 pv = *(const f32x4*)(pp + bj * HALF + 4 * n); r[n] = xv + pv + gv[bj][n] * acc[ai][bj][m][n]; }
                    u32x4 w; w.x = cvt_pk_bf16(r[0][0], r[0][1]); w.y = cvt_pk_bf16(r[0][2], r[0][3]); w.z = cvt_pk_bf16(r[1][0], r[1][1]); w.w = cvt_pk_bf16(r[1][2], r[1][3]);
                    *(u32x4*)(O + off + bj * HALF) = w; }
                if (m & 1) asm volatile("" ::: "memory"); }
    }
};
__device__ __forceinline__ unsigned pk4_fp8(float a, float b, float c, float d) { int w = 0; w = __builtin_amdgcn_cvt_pk_fp8_f32(a, b, w, false); w = __builtin_amdgcn_cvt_pk_fp8_f32(c, d, w, true); return (unsigned)w; }
constexpr float WSC = 32.0f, WSCI = 1.0f / 32.0f;
struct EpiGU {
    static constexpr bool PERM = true; static constexpr int CMAP = 0, NST = 8; unsigned char* O; PG8_LAS unsigned char* pf;
    __device__ __forceinline__ bool full(const Unit&, int) const { return true; }
    __device__ __forceinline__ void operator()(const f32x4 (&acc)[2][2][4][2], const Unit& u, int wr, int wc, int fr, int fq) const {
        const int row0 = u.pm * BM + wr * 64 + fr, j0 = u.pn * HALF + wc * 32 + 8 * fq;
        const PG8_LAS float* bg = (const PG8_LAS float*)(pf + u.slot * PF_SLOT + 1024) + wc * 32 + 8 * fq;
        f32x4 bgv[2], buv[2];
#pragma unroll
        for (int n = 0; n < 2; ++n) { bgv[n] = *(const PG8_LAS f32x4*)(bg + 4 * n); buv[n] = *(const PG8_LAS f32x4*)(bg + 128 + 4 * n) + 1.0f; }
        typedef float f32x2 __attribute__((ext_vector_type(2)));
        constexpr float NC = -1.702f * 1.44269504088896f;
#pragma unroll
        for (int ai = 0; ai < 2; ++ai)
#pragma unroll
            for (int m = 0; m < 4; ++m) { unsigned char* rowp = O + (size_t)(row0 + ai * HALF + m * 16) * DE + j0; float r[8];
#pragma unroll
                for (int n = 0; n < 2; ++n) { const f32x4 gt = acc[ai][0][m][n] * WSCI + bgv[n], up = acc[ai][1][m][n] * WSCI + buv[n];
#pragma unroll
                    for (int i = 0; i < 4; i += 2) { const f32x2 g = {fminf(gt[i], 7.0f), fminf(gt[i + 1], 7.0f)}, uu = {fminf(fmaxf(up[i], -6.0f), 8.0f), fminf(fmaxf(up[i + 1], -6.0f), 8.0f)};
                        const f32x2 t = g * NC; const f32x2 d = (f32x2){__builtin_amdgcn_exp2f(t[0]), __builtin_amdgcn_exp2f(t[1])} + 1.0f;
                        const f32x2 rc = {__builtin_amdgcn_rcpf(d[0]), __builtin_amdgcn_rcpf(d[1])}; const f32x2 o = (g * uu) * rc; r[4 * n + i] = o[0]; r[4 * n + i + 1] = o[1]; } }
                u32x2 w; w.x = pk4_fp8(r[0], r[1], r[2], r[3]); w.y = pk4_fp8(r[4], r[5], r[6], r[7]);
                *(u32x2*)rowp = w; }
    }
};
constexpr float YSC = 16.0f, YSCI = 1.0f / 16.0f;
#ifndef YST_NT
#define YST_NT 0
#endif
#if YST_NT
#define YST(p_, w_) __builtin_nontemporal_store((w_), (u32x4*)(p_))
#else
#define YST(p_, w_) (*(u32x4*)(p_) = (w_))
#endif
struct EpiDown {
    static constexpr bool PERM = true; static constexpr int CMAP = 1, NST = 8; unsigned char* O; PG8_LAS unsigned char* pf; const LAS int* cnts;
    __device__ __forceinline__ bool full(const Unit&, int) const { return true; }
    __device__ __forceinline__ void operator()(const f32x4 (&acc)[2][2][4][2], const Unit& u, int wr, int wc, int fr, int fq) const {
        const int row0 = u.pm * BM + wr * 64 + fr, col0 = u.pn * BM + wc * 64 + 16 * fq;
        const PG8_LAS float* bb = (const PG8_LAS float*)(pf + u.slot * PF_SLOT + 1024) + wc * 64 + 16 * fq; const PG8_LAS float* lpl = (const PG8_LAS float*)(pf + u.slot * PF_SLOT + 2048); const int cnt = cnts[u.g];
        f32x4 bv[2][2]; float pv[2][4];
#pragma unroll
        for (int ai = 0; ai < 2; ++ai)
#pragma unroll
            for (int m = 0; m < 4; ++m) pv[ai][m] = lpl[wr * 64 + fr + ai * HALF + m * 16];
#pragma unroll
        for (int bj = 0; bj < 2; ++bj)
#pragma unroll
            for (int n = 0; n < 2; ++n) bv[bj][n] = *(const PG8_LAS f32x4*)(bb + bj * 8 + 4 * n);
#pragma unroll
        for (int ai = 0; ai < 2; ++ai)
#pragma unroll
            for (int m = 0; m < 4; ++m) { const int rt = wr * 64 + fr + ai * HALF + m * 16; const float p = (u.r0 + rt < cnt) ? pv[ai][m] * YSC : 0.f;
                unsigned char* rowp = O + (size_t)(row0 + ai * HALF + m * 16) * D + col0; u32x4 w;
#pragma unroll
                for (int bj = 0; bj < 2; ++bj) { const f32x4 v0 = (acc[ai][bj][m][0] * WSCI + bv[bj][0]) * p, v1 = (acc[ai][bj][m][1] * WSCI + bv[bj][1]) * p;
                    w[2 * bj] = pk4_fp8(v0[0], v0[1], v0[2], v0[3]); w[2 * bj + 1] = pk4_fp8(v1[0], v1[1], v1[2], v1[3]); }
                YST(rowp, w); }
    }
};
}

struct Args { const float* in[24]; float* out; unsigned char* ws; int ph_lo, ph_hi, li, pad; };
enum { I_X = 0, I_C, I_CTX, I_CCTX, I_ADAW, I_ADAB, I_N1G, I_WIN, I_CONVW, I_CONVB, I_MLGB, I_MLNG, I_GW2, I_GGB, I_GNG, I_WOUT, I_N2G, I_RW, I_RB, I_WGU, I_BGU, I_WD, I_BD, I_FNG };

__device__ __forceinline__ void transpose_item(const float* W, int N, bf16* WT, int k0, int n0, int orow0, LAS float* scr, int lane, int orow1 = -1) {
    if (orow1 < 0) orow1 = orow0 + 16;
    const int n = n0 + (lane & 31);
#pragma unroll 8
    for (int i = 0; i < 32; ++i) { const int kk = 2 * i + (lane >> 5); float v = 0.f; if (n < N) v = W[(size_t)(k0 + kk) * N + n]; scr[kk * 33 + (lane & 31)] = v; }
    LDS_WAIT(); asm volatile("" ::: "memory");
    const int c = lane & 7;
#pragma unroll
    for (int j = 0; j < 4; ++j) { const int nn = (lane >> 3) + 8 * j; const LAS float* s = scr + (8 * c) * 33 + nn;
        u32x4 o; o.x = pk2(s[0 * 33], s[1 * 33]); o.y = pk2(s[2 * 33], s[3 * 33]); o.z = pk2(s[4 * 33], s[5 * 33]); o.w = pk2(s[6 * 33], s[7 * 33]);
        *(u32x4*)(WT + (size_t)(nn < 16 ? orow0 + nn : orow1 + nn - 16) * 1024 + k0 + 8 * c) = o; }
    LDS_WAIT(); asm volatile("" ::: "memory");
}

__device__ __forceinline__ void transpose_item_f8(const float* W, int N, unsigned char* WT, int k0, int n0, int orow0, float sc, LAS float* scr, int lane) {
    const int n = n0 + (lane & 31);
#pragma unroll 8
    for (int i = 0; i < 32; ++i) { const int kk = 2 * i + (lane >> 5); float v = 0.f; if (n < N) v = W[(size_t)(k0 + kk) * N + n]; scr[kk * 33 + (lane & 31)] = v * sc; }
    LDS_WAIT(); asm volatile("" ::: "memory");
    const int c = lane & 7;
#pragma unroll
    for (int j = 0; j < 4; ++j) { const int nn = (lane >> 3) + 8 * j; const LAS float* s = scr + (8 * c) * 33 + nn;
        u32x2 o; o.x = pg8::pk4_fp8(s[0 * 33], s[1 * 33], s[2 * 33], s[3 * 33]); o.y = pg8::pk4_fp8(s[4 * 33], s[5 * 33], s[6 * 33], s[7 * 33]);
        *(u32x2*)(WT + (size_t)(orow0 + nn) * 1024 + k0 + 8 * c) = o; }
    LDS_WAIT(); asm volatile("" ::: "memory");
}

__host__ __device__ constexpr int zperm(int n) { return n < 1536 ? n : n < 1552 ? 3072 + (n - 1536) : n < 3088 ? n - 16 : n; }
__device__ __forceinline__ void p0_prologue(const Args& a, LAS unsigned char* lds, int vcu, int G) {
    const int tid = threadIdx.x, lane = tid & 63, wave = __builtin_amdgcn_readfirstlane(tid >> 6);
    unsigned char* ws = a.ws;
    {
        float* mods = (float*)(ws + WS_MODS);
        const float* c = a.in[I_C]; const float* cc = a.in[I_CCTX]; const float* aw = a.in[I_ADAW]; const float* ab = a.in[I_ADAB];
        LAS float* sl = (LAS float*)lds + wave * 4224;
        for (int item = vcu; item < 96; item += G) {
            const int n0 = item * 64;
            for (int idx = lane; idx < 33 * 128; idx += 64) { const int r = idx >> 7, kk = idx & 127, k = 128 * wave + kk; const float cv = r < 32 ? c[r * 1024 + k] : cc[k]; sl[idx] = fsilu(cv); }
            LDS_WAIT(); asm volatile("" ::: "memory");
            float acc[33];
#pragma unroll
            for (int r = 0; r < 33; ++r) acc[r] = 0.f;
            const float* wp = aw + (size_t)(128 * wave) * 6144 + n0 + lane;
            for (int kk = 0; kk < 128; kk += 4) {
                const float w0 = wp[(size_t)(kk + 0) * 6144], w1 = wp[(size_t)(kk + 1) * 6144], w2 = wp[(size_t)(kk + 2) * 6144], w3 = wp[(size_t)(kk + 3) * 6144];
#pragma unroll
                for (int r = 0; r < 33; ++r) { const f32x4 s = *(const LAS f32x4*)(sl + r * 128 + kk); acc[r] += s[0] * w0 + s[1] * w1 + s[2] * w2 + s[3] * w3; }
            }
            __syncthreads();
            LAS float* red = (LAS float*)lds;
#pragma unroll
            for (int r = 0; r < 33; ++r) red[(wave * 33 + r) * 64 + lane] = acc[r];
            __syncthreads();
            for (int idx = tid; idx < 33 * 64; idx += NTHR) { const int r = idx >> 6, l = idx & 63; float s = ab[n0 + l];
#pragma unroll
                for (int w = 0; w < 8; ++w) s += red[(w * 33 + r) * 64 + l];
                mods[(size_t)r * 6144 + n0 + l] = s; }
            __syncthreads();
        }
    }
    const int gw = vcu * NWAVES + wave, NGW = G * NWAVES;
    {
        float* pos = (float*)(ws + WS_POS);
        for (int t = gw; t < T; t += NGW) { const float rr = (float)(t >> 6), cl = (float)(t & 63);
#pragma unroll
            for (int j = 0; j < 16; ++j) { const int d = lane + 64 * j; const int q = d >> 8, i = d & 255;
                const float om = exp2f(-13.287712379549449f * (float)i * (1.0f / 256.0f));
                const float ang = ((q < 2) ? rr : cl) * om * 0.15915494309189535f;
                const float v = (q & 1) ? __builtin_amdgcn_cosf(ang) : __builtin_amdgcn_sinf(ang);
                pos[(size_t)t * D + d] = v; } }
    }
}

__device__ __forceinline__ void p1_weight_copies(const Args& a, LAS unsigned char* lds, int vcu, int G) {
    const int tid = threadIdx.x, lane = tid & 63, wave = __builtin_amdgcn_readfirstlane(tid >> 6);
    unsigned char* ws = a.ws;
    const int gw = vcu * NWAVES + wave, NGW = G * NWAVES;
    {
        LAS float* scr = (LAS float*)(lds + wave * 16384);
        bf16* wint = (bf16*)(ws + WS_WIN); bf16* woutt = (bf16*)(ws + WS_WOUT);
        constexpr int I_IN = 16 * 104, I_OUT = 16 * 32;
        for (int it = gw; it < I_IN + I_OUT; it += NGW) {
            if (it < I_IN) { const int kb = it / 104, nb = it % 104, n0 = 32 * nb;
                transpose_item(a.in[I_WIN], INW, wint, 64 * kb, n0, zperm(n0), scr, lane, zperm(n0 + 16)); }
            else { const int r = it - I_IN, kb = r / 32, nb = r % 32; transpose_item(a.in[I_WOUT], D, woutt, 64 * kb, 32 * nb, 32 * nb, scr, lane); }
        }
        for (int it = gw; it < 16 * 64; it += NGW) { const int kb = it >> 6, nb = it & 63, g0 = nb < 32 ? 512 + 32 * nb : 2048 + 32 * (nb - 32), n0 = g0 < 1536 ? g0 : g0 + 16;
            transpose_item_f8(a.in[I_WIN], INW, ws + WS_WIN8, 64 * kb, n0, g0, pg8::WSC, (LAS float*)(lds + wave * 16384), lane); }
        float* rwt = (float*)(ws + WS_RWT); const float* rw = a.in[I_RW];
        for (int idx = gw * 64 + lane; idx < 32 * 1024; idx += NGW * 64) { const int e = idx >> 10, d = idx & 1023; rwt[idx] = rw[d * 32 + e]; }
    }
}

#define P1C(lane_, j_) (8 * (lane_) + 512 * ((j_) >> 1) + 4 * ((j_) & 1))
__device__ __forceinline__ void p1_load_row(const Args& a, const float* pos, int m, int lane, f32x4 (&v)[4]) {
    if (m < NLAT) { const float* src = a.in[I_X] + (size_t)m * D; const float* pp = pos + (size_t)(m & (T - 1)) * D;
#pragma unroll
        for (int j = 0; j < 4; ++j) v[j] = *(const f32x4*)(src + P1C(lane, j)) + *(const f32x4*)(pp + P1C(lane, j)); }
    else { const float* src = a.in[I_CTX] + (size_t)((m < NTOK ? m : NTOK - 1) - NLAT) * D;
#pragma unroll
        for (int j = 0; j < 4; ++j) v[j] = *(const f32x4*)(src + P1C(lane, j)); }
}
constexpr float USC = 16.0f;
__device__ __forceinline__ void p1_norm1(const Args& a, int vcu, int G) {
    const int tid = threadIdx.x, lane = tid & 63, wave = __builtin_amdgcn_readfirstlane(tid >> 6);
    const int gw = vcu * NWAVES + wave, NGW = G * NWAVES;
    const float* mods = (const float*)(a.ws + WS_MODS); const float* pos = (const float*)(a.ws + WS_POS); const float* g1 = a.in[I_N1G];
    bf16* U = (bf16*)(a.ws + WS_U);
    f32x4 gv[4];
#pragma unroll
    for (int j = 0; j < 4; ++j) gv[j] = *(const f32x4*)(g1 + P1C(lane, j));
    const bool fast = (NGW % NB == 0) && (T % (NGW / NB) == 0);
    const int WPS = fast ? NGW / NB : 1, KL = fast ? T / WPS : 0, KT = fast ? KL + (NCTX + NGW - 1) / NGW : (NTOK + NGW - 1) / NGW;
    const int lb = fast ? (gw / WPS) * T + gw % WPS : 0;
    auto rowk = [&](int k) -> int { return fast ? (k < KL ? lb + WPS * k : NLAT + gw + NGW * (k - KL)) : gw + k * NGW; };
    f32x4 vn[2][4];
    p1_load_row(a, pos, rowk(0), lane, vn[0]); p1_load_row(a, pos, rowk(1), lane, vn[1]);
    int ccr = -1; f32x4 A[4], S[4];
    for (int k0 = 0; k0 < KT; k0 += 2) {
        f32x4 v[2][4];
#pragma unroll
        for (int r = 0; r < 2; ++r)
#pragma unroll
            for (int j = 0; j < 4; ++j) v[r][j] = vn[r][j];
        if (k0 + 2 < KT) { p1_load_row(a, pos, rowk(k0 + 2), lane, vn[0]); p1_load_row(a, pos, rowk(k0 + 3), lane, vn[1]); }
#pragma unroll
        for (int r = 0; r < 2; ++r) { const int m = rowk(k0 + r); if (k0 + r >= KT || m >= NTOK) continue;
            const int cr = m < NLAT ? (m >> 11) : 32;
            if (cr != ccr) { ccr = cr; const float* md = mods + (size_t)cr * 6144;
#pragma unroll
                for (int j = 0; j < 4; ++j) { S[j] = *(const f32x4*)(md + P1C(lane, j)); A[j] = gv[j] * (*(const f32x4*)(md + 1024 + P1C(lane, j)) + 1.0f); } }
            float s = 0.f;
#pragma unroll
            for (int j = 0; j < 4; ++j) s += (v[r][j].x * v[r][j].x + v[r][j].y * v[r][j].y) + (v[r][j].z * v[r][j].z + v[r][j].w * v[r][j].w);
            const float rr = 1.0f / sqrtf(wave_sum(s) * (1.0f / D) + EPS);
            bf16* ub = U + (size_t)m * D + 8 * lane; unsigned char* u8 = a.ws + WS_U8 + (size_t)m * D + 8 * lane;
#pragma unroll
            for (int jp = 0; jp < 2; ++jp) { u32x4 wb; u32x2 w8;
#pragma unroll
                for (int q = 0; q < 2; ++q) { const int j = 2 * jp + q; const f32x4 y = v[r][j] * rr * A[j] + S[j];
                    wb[2 * q] = pk2(y.x, y.y); wb[2 * q + 1] = pk2(y.z, y.w);
                    const f32x4 y8 = y * USC; w8[q] = pg8::pk4_fp8(y8.x, y8.y, y8.z, y8.w); }
                *(u32x4*)(ub + 512 * jp) = wb; *(u32x2*)(u8 + 512 * jp) = w8; } }
    }
}

#undef P1C
typedef short v4i16_t __attribute__((ext_vector_type(4)));
__device__ __forceinline__ s16x4 trr(const LAS unsigned char* p) { return __builtin_bit_cast(s16x4, __builtin_amdgcn_ds_read_tr16_b64_v4i16((LAS v4i16_t*)p)); }
__device__ __forceinline__ bf16x8 cat8(s16x4 lo, s16x4 hi) { return __builtin_shufflevector(lo, hi, 0, 1, 2, 3, 4, 5, 6, 7); }
#define MFMA16(a, b, c) __builtin_amdgcn_mfma_f32_16x16x32_bf16((a), (b), (c), 0, 0, 0)
constexpr int PQK = 144, PV = 272;
__device__ __forceinline__ int vswz(int r) { return ((r & 3) << 2) | ((r >> 2) & 3); }
__device__ __forceinline__ float lane_scan(float x, int lane, int rev) {
#pragma unroll
    for (int o = 1; o < 64; o <<= 1) { const float up = __shfl_up(x, o), dn = __shfl_down(x, o); if (rev) { if (lane + o < 64) x += dn; } else { if (lane >= o) x += up; } }
    return x;
}
__device__ __forceinline__ u32x4 ldz8(const bf16* Z, int segbase, int seglen, int t, int col) {
    u32x4 v = (u32x4){0u, 0u, 0u, 0u};
    if (t >= 0 && t < seglen) v = *(const u32x4*)(Z + (size_t)(segbase + t) * ZW + col);
    return v;
}
__device__ __forceinline__ void conv8(const LAS unsigned char* raw, int s, int c8, const float (&cw)[3][8], const float (&cb)[8], float (&o)[8]) {
    const u32x4 a0 = *(const LAS u32x4*)(raw + (s + 0) * PQK + c8 * 16), a1 = *(const LAS u32x4*)(raw + (s + 1) * PQK + c8 * 16), a2 = *(const LAS u32x4*)(raw + (s + 2) * PQK + c8 * 16);
#pragma unroll
    for (int j = 0; j < 4; ++j) {
        const float l0 = bflo(a0[j]), h0 = bfhi(a0[j]), l1 = bflo(a1[j]), h1 = bfhi(a1[j]), l2 = bflo(a2[j]), h2 = bfhi(a2[j]);
        o[2 * j] = fsilu(cb[2 * j] + cw[0][2 * j] * l0 + cw[1][2 * j] * l1 + cw[2][2 * j] * l2);
        o[2 * j + 1] = fsilu(cb[2 * j + 1] + cw[0][2 * j + 1] * h0 + cw[1][2 * j + 1] * h1 + cw[2][2 * j + 1] * h2);
    }
}
__device__ __forceinline__ u32x4 pack8(const float (&o)[8], float s) { u32x4 w; w.x = pk2(o[0] * s, o[1] * s); w.y = pk2(o[2] * s, o[3] * s); w.z = pk2(o[4] * s, o[5] * s); w.w = pk2(o[6] * s, o[7] * s); return w; }

constexpr int P3_GRP = 73152, P3_RK = 0, P3_VT = 16896, P3_KP = 49664, P3_LR = 68096, P3_WB = 72192, P3_WBS = 320;
__device__ __forceinline__ float fast_logsigmoid(float x) { return fminf(x, 0.f) - __logf(1.0f + __expf(-fabsf(x))); }
__device__ __forceinline__ void glds16(const void* g, LAS unsigned char* l) {
    unsigned keep; const unsigned dst = (unsigned)(size_t)l;
    asm volatile("s_mov_b32 %0, m0\n\ts_mov_b32 m0, %2\n\ts_nop 0\n\tglobal_load_lds_dwordx4 %1, off\n\ts_mov_b32 m0, %0" : "=&s"(keep) : "v"(g), "s"(dst) : "memory");
}
__device__ __forceinline__ void glds16nt(const void* g, LAS unsigned char* l) {
    unsigned keep; const unsigned dst = (unsigned)(size_t)l;
    asm volatile("s_mov_b32 %0, m0\n\ts_mov_b32 m0, %2\n\ts_nop 0\n\tglobal_load_lds_dwordx4 %1, off nt\n\ts_mov_b32 m0, %0" : "=&s"(keep) : "v"(g), "s"(dst) : "memory");
}
__device__ __forceinline__ void p3_chains(const Args& a, LAS unsigned char* lds, int vcu, int G) {
    const int tid = threadIdx.x, lane = tid & 63, wave = __builtin_amdgcn_readfirstlane(tid >> 6);
    const int grp = wave >> 2, gw4 = wave & 3, gt = tid & 255;
    const int g = lane >> 4, q = (lane & 15) >> 2, p = lane & 3, l15 = lane & 15;
    const bf16* Z = (const bf16*)(a.ws + WS_Z);
    bf16* ST = (bf16*)(a.ws + WS_ST); float* NST = (float*)(a.ws + WS_NST);
    LAS unsigned char* base = lds + grp * P3_GRP;
    const int c8 = gt & 7;
    for (int pair = vcu; pair < 256; pair += G) {
        const int ch = pair * 2 + grp;
        const int h = ch & 3, dir = (ch >> 2) & 1, type = (ch >> 3) & 1, b = ch >> 4;
        const bf16* ZK = Z + plane64(type ? F_GK : F_MLK, h); const bf16* ZV = Z + plane128(type ? F_GV : F_MLV, h); const bf16* ZM = Z + Z_MISC;
        float cw[3][8], cb[8];
        {
            const float* w = a.in[I_CONVW]; const float* bb = a.in[I_CONVB]; const int chn = 256 + h * 64 + c8 * 8;
#pragma unroll
            for (int j = 0; j < 8; ++j) { cw[0][j] = w[chn + j]; cw[1][j] = w[512 + chn + j]; cw[2][j] = w[1024 + chn + j]; cb[j] = bb[chn + j]; }
        }
        const float bias_i = a.in[I_MLGB][(2 * dir) * 4 + h], bias_f = a.in[I_MLGB][(2 * dir + 1) * 4 + h];
        bf16x8 w2f; float gbd;
        {
            const int d = h * 64 + 16 * gw4 + l15; const float* w2 = a.in[I_GW2] + (size_t)dir * 16 * 256 + d;
#pragma unroll
            for (int j = 0; j < 8; ++j) { float v = 0.f; if (g < 2) v = w2[(8 * g + j) * 256]; w2f[j] = (short)f2bf(v); }
            gbd = a.in[I_GGB][dir * 256 + d];
        }
        bf16x8 onesf;
#pragma unroll
        for (int j = 0; j < 8; ++j) onesf[j] = (short)(l15 == 0 ? 0x3F80 : 0);
        f32x4 acc[4][2], accn[4];
#pragma unroll
        for (int mt = 0; mt < 4; ++mt) { accn[mt] = (f32x4){0.f, 0.f, 0.f, 0.f};
#pragma unroll
            for (int nt = 0; nt < 2; ++nt) acc[mt][nt] = (f32x4){0.f, 0.f, 0.f, 0.f}; }
        float rgi = 0.f, rgf = 0.f;
#define P3_CHUNK(j, lat_, c_, t0_, sb_, sl_) const bool lat_ = (j) >= 4; const int c_ = dir == 0 ? (lat_ ? (j) - 4 : (j)) : (lat_ ? 35 - (j) : 3 - (j)); \
        const int t0_ = 64 * c_, sb_ = lat_ ? b * T : NLAT + b * CT, sl_ = lat_ ? T : CT
        for (int it = -3; it < 36; ++it) {
            if (type == 0 && gw4 == 0) {
                const int j2 = it + 2;
                if (j2 >= 0 && j2 < 36) { LAS float* WB = (LAS float*)(base + P3_WB + (j2 % 3) * P3_WBS);
                    const float lf = fast_logsigmoid(rgf + bias_f), ig = rgi + bias_i; const float B = lane_scan(lf, lane, dir);
                    const float tot = __shfl(B, dir ? 0 : 63); WB[lane] = __expf(tot - B + ig); if (lane == 0) WB[64] = __expf(tot); }
                const int j3 = it + 3;
                if (j3 < 36) { P3_CHUNK(j3, lat3, c3, t03, sb3, sl3); (void)sl3; (void)lat3; const bf16* zr = ZM + (size_t)(sb3 + t03 + lane) * 64 + M_MLG; rgi = bf2f(zr[(2 * dir) * 4 + h]); rgf = bf2f(zr[(2 * dir + 1) * 4 + h]); }
            }
            {
                const int j2 = it + 2;
                if (j2 >= 0 && j2 < 36) { P3_CHUNK(j2, lat2, c2, t02, sb2, sl2); (void)lat2;
                    LAS unsigned char* RK = base + P3_RK + (j2 & 1) * 8448;
#pragma unroll
                    for (int i = 0; i < 2; ++i) { const int qi = gw4 + 4 * i, row = 8 * qi + (lane >> 3); int t = t02 - 1 + row; t = t < 0 ? 0 : t;
                        glds16(ZK + (size_t)(sb2 + t) * 64 + (lane & 7) * 8, RK + qi * 1024); }
                    if (gw4 == 0 && lane < 16) { const int row = 64 + (lane >> 3); int t = t02 - 1 + row; t = t >= sl2 ? sl2 - 1 : t;
                        glds16(ZK + (size_t)(sb2 + t) * 64 + (lane & 7) * 8, RK + 8192); }
                    if (type == 1 && gw4 < 2) { LAS unsigned char* LR = base + P3_LR + (j2 & 1) * 2048; const int row = 32 * gw4 + (lane >> 1);
                        glds16(ZM + (size_t)(sb2 + t02 + row) * 64 + M_LR + dir * 16 + (lane & 1) * 8, LR + gw4 * 1024); }
                }
                const int j1 = it + 1;
                if (j1 >= 0 && j1 < 36) { P3_CHUNK(j1, lat1, c1, t01, sb1, sl1); (void)lat1; (void)sl1;
                    LAS unsigned char* VT = base + P3_VT + (j1 & 1) * 16384;
#pragma unroll
                    for (int i = 0; i < 4; ++i) { const int qi = gw4 * 4 + i, row = 4 * qi + (lane >> 4);
                        glds16(ZV + (size_t)(sb1 + t01 + row) * 128 + ((lane & 15) ^ vswz(row)) * 8, VT + qi * 1024); }
                }
            }
            {
                const int j1 = it + 1;
                if (j1 >= 0 && j1 < 36) { P3_CHUNK(j1, lat1, c1, t01, sb1, sl1); (void)lat1; (void)sb1;
                    const LAS unsigned char* RK = base + P3_RK + (j1 & 1) * 8448; LAS unsigned char* KP = base + P3_KP + (j1 & 1) * 9216;
                    LAS float* WB = (LAS float*)(base + P3_WB + (j1 % 3) * P3_WBS);
                    if (type == 0) {
#pragma unroll
                        for (int pss = 0; pss < 2; ++pss) { const int s = (gt >> 3) + 32 * pss;
                            u32x4 a0 = *(const LAS u32x4*)(RK + (s + 0) * 128 + c8 * 16); const u32x4 a1 = *(const LAS u32x4*)(RK + (s + 1) * 128 + c8 * 16); u32x4 a2 = *(const LAS u32x4*)(RK + (s + 2) * 128 + c8 * 16);
                            if (t01 + s - 1 < 0) a0 = (u32x4){0u, 0u, 0u, 0u};
                            if (t01 + s + 1 >= sl1) a2 = (u32x4){0u, 0u, 0u, 0u};
                            float o[8];
#pragma unroll
                            for (int j = 0; j < 4; ++j) {
                                o[2 * j] = fsilu(cb[2 * j] + cw[0][2 * j] * bflo(a0[j]) + cw[1][2 * j] * bflo(a1[j]) + cw[2][2 * j] * bflo(a2[j]));
                                o[2 * j + 1] = fsilu(cb[2 * j + 1] + cw[0][2 * j + 1] * bfhi(a0[j]) + cw[1][2 * j + 1] * bfhi(a1[j]) + cw[2][2 * j + 1] * bfhi(a2[j])); }
                            *(LAS u32x4*)(KP + s * PQK + c8 * 16) = pack8(o, WB[s]); }
                    } else {
                        const LAS unsigned char* LR = base + P3_LR + (j1 & 1) * 2048;
                        f32x4 la[4];
#pragma unroll
                        for (int mt = 0; mt < 4; ++mt) { bf16x8 af = (bf16x8){0, 0, 0, 0, 0, 0, 0, 0}; if (g < 2) af = *(const LAS bf16x8*)(LR + (16 * mt + l15) * 32 + g * 16);
                            la[mt] = MFMA16(af, w2f, ((f32x4){gbd, gbd, gbd, gbd}));
#pragma unroll
                            for (int rg = 0; rg < 4; ++rg) la[mt][rg] = fast_logsigmoid(la[mt][rg]) * (1.0f / 16.0f); }
                        float tmt[4];
#pragma unroll
                        for (int mt = 0; mt < 4; ++mt) {
                            if (dir == 0) { la[mt][1] += la[mt][0]; la[mt][2] += la[mt][1]; la[mt][3] += la[mt][2]; }
                            else { la[mt][2] += la[mt][3]; la[mt][1] += la[mt][2]; la[mt][0] += la[mt][1]; }
                            const float tg = dir == 0 ? la[mt][3] : la[mt][0];
                            const float t0 = __shfl(tg, l15), t1 = __shfl(tg, l15 + 16), t2 = __shfl(tg, l15 + 32), t3 = __shfl(tg, l15 + 48);
                            float og;
                            if (dir == 0) og = (g > 0 ? t0 : 0.f) + (g > 1 ? t1 : 0.f) + (g > 2 ? t2 : 0.f);
                            else og = (g < 3 ? t3 : 0.f) + (g < 2 ? t2 : 0.f) + (g < 1 ? t1 : 0.f);
#pragma unroll
                            for (int rg = 0; rg < 4; ++rg) la[mt][rg] += og;
                            tmt[mt] = (t0 + t1) + (t2 + t3); }
                        const float tot = (tmt[0] + tmt[1]) + (tmt[2] + tmt[3]);
#pragma unroll
                        for (int mt = 0; mt < 4; ++mt) { float om;
                            if (dir == 0) om = (mt > 0 ? tmt[0] : 0.f) + (mt > 1 ? tmt[1] : 0.f) + (mt > 2 ? tmt[2] : 0.f);
                            else om = (mt < 3 ? tmt[3] : 0.f) + (mt < 2 ? tmt[2] : 0.f) + (mt < 1 ? tmt[1] : 0.f);
#pragma unroll
                            for (int rg = 0; rg < 4; ++rg) { const int s = 16 * mt + 4 * g + rg, d = 16 * gw4 + l15;
                                const float kv = bf2f(*(const LAS unsigned short*)(RK + (s + 1) * 128 + d * 2));
                                *(LAS unsigned short*)(KP + s * PQK + d * 2) = (unsigned short)f2bf(kv * __expf(tot - (om + la[mt][rg]))); } }
                        if (g == 0) WB[16 * gw4 + l15] = __expf(tot);
                    }
                }
            }
            if (it >= 0) { P3_CHUNK(it, lat0, c0, t00, sb0, sl0); (void)t00; (void)sb0; (void)sl0;
                const LAS unsigned char* KP = base + P3_KP + (it & 1) * 9216; const LAS unsigned char* VT = base + P3_VT + (it & 1) * 16384;
                const LAS float* WB = (const LAS float*)(base + P3_WB + (it % 3) * P3_WBS);
                if (lat0) {
                    bf16* dst = ST + ((((size_t)(type * 2 + dir) * 32 + b) * 4 + h) * 32 + c0) * 8192;
#pragma unroll
                    for (int mt = 0; mt < 4; ++mt)
#pragma unroll
                        for (int nt = 0; nt < 2; ++nt) { u32x2 w; w.x = pk2(acc[mt][nt][0], acc[mt][nt][1]); w.y = pk2(acc[mt][nt][2], acc[mt][nt][3]);
                            const int F = (((2 * gw4 + nt) * 2 + (mt >> 1)) * 64 + (2 * (mt & 1) + (g >> 1)) * 16 + l15);
                            *(u32x2*)(dst + F * 8 + (g & 1) * 4) = w; }
                    if (type == 0 && gw4 == 0 && l15 == 0) { float* nd = NST + ((((size_t)dir * 32 + b) * 4 + h) * 32 + c0) * 64;
#pragma unroll
                        for (int mt = 0; mt < 4; ++mt) *(f32x4*)(nd + 16 * mt + 4 * g) = accn[mt]; }
                }
                if (type == 0) { const float et = WB[64];
#pragma unroll
                    for (int mt = 0; mt < 4; ++mt) { accn[mt] *= et;
#pragma unroll
                        for (int nt = 0; nt < 2; ++nt) acc[mt][nt] *= et; }
                } else {
#pragma unroll
                    for (int mt = 0; mt < 4; ++mt) { const f32x4 e4 = *(const LAS f32x4*)(WB + 16 * mt + 4 * g);
#pragma unroll
                        for (int nt = 0; nt < 2; ++nt) acc[mt][nt] *= e4; }
                }
#pragma unroll
                for (int ks = 0; ks < 2; ++ks) {
                    bf16x8 af[4], bfr[2];
#pragma unroll
                    for (int mt = 0; mt < 4; ++mt) { const LAS unsigned char* pa = KP + (32 * ks + 8 * g + q) * PQK + (16 * mt + 4 * p) * 2; af[mt] = cat8(trr(pa), trr(pa + 4 * PQK)); }
#pragma unroll
                    for (int nt = 0; nt < 2; ++nt) { const int r0 = 32 * ks + 8 * g + q, ch = 4 * gw4 + 2 * nt + (p >> 1);
                        const LAS unsigned char* pb0 = VT + r0 * 256 + ((ch ^ vswz(r0)) * 16) + 8 * (p & 1); const LAS unsigned char* pb1 = VT + (r0 + 4) * 256 + ((ch ^ vswz(r0 + 4)) * 16) + 8 * (p & 1);
                        bfr[nt] = cat8(trr(pb0), trr(pb1)); }
#pragma unroll
                    for (int mt = 0; mt < 4; ++mt) {
#pragma unroll
                        for (int nt = 0; nt < 2; ++nt) acc[mt][nt] = MFMA16(af[mt], bfr[nt], acc[mt][nt]);
                        if (type == 0 && gw4 == 0) accn[mt] = MFMA16(af[mt], onesf, accn[mt]); }
                }
            }
            { const bool st = it >= 4;
              if (!st) VM_WAIT(); else if (type == 0 && gw4 == 0) asm volatile("s_waitcnt vmcnt(12)" ::: "memory"); else asm volatile("s_waitcnt vmcnt(8)" ::: "memory"); }
            BAR_LDS();
        }
#undef P3_CHUNK
    }
}

constexpr int P4_QR = 0, P4_KR = 8448, P4_LR = 16896, P4_VT = 20992, P4_CT = 37376, P4_QP = 70144, P4_KP = 88576, P4_SW = 107008, P4_H = 70144, P4_WB = 125440, P4_CW = 127488;
constexpr int P4_TS = 9216, P4_HS = 17408, PH = 272;
__device__ __forceinline__ void p4_outputs(const Args& a, LAS unsigned char* lds, int vcu, int G) {
    const int tid = threadIdx.x, lane = tid & 63, wave = __builtin_amdgcn_readfirstlane(tid >> 6);
    const int dg = wave >> 2, gw4 = wave & 3, gt = tid & 255;
    const int g = lane >> 4, q = (lane & 15) >> 2, p = lane & 3, l15 = lane & 15;
    const bf16* Z = (const bf16*)(a.ws + WS_Z);
    const bf16* ST = (const bf16*)(a.ws + WS_ST); const float* NST = (const float*)(a.ws + WS_NST);
    bf16* MG = (bf16*)(a.ws + WS_U);
    LAS unsigned char* QR = lds + P4_QR; LAS unsigned char* KR = lds + P4_KR; LAS unsigned char* LR = lds + P4_LR + dg * 2048; LAS unsigned char* VT = lds + P4_VT; LAS unsigned char* CTl = lds + P4_CT + dg * 16384;
    LAS unsigned char* QP = lds + P4_QP + dg * P4_TS; LAS unsigned char* KP = lds + P4_KP + dg * P4_TS; LAS unsigned char* SW = lds + P4_SW + dg * P4_TS;
    LAS unsigned char* Hme = lds + P4_H + dg * P4_HS;
    LAS float* CW = (LAS float*)(lds + P4_CW);
    const int c8 = gt & 7;
    for (int i = tid; i < 2048; i += NTHR) CW[i] = i < 1536 ? a.in[I_CONVW][i] : a.in[I_CONVB][i - 1536];
    if (tid < 16) CW[2048 + tid] = a.in[I_MLGB][tid];
#define P4_DEC(u_, b_, ty_, h_, c_) const int b_ = (u_) >> 8, r_##b_ = (u_) & 255, ty_ = (r_##b_ + b_) & 1, h_ = (r_##b_ >> 1) & 3, c_ = r_##b_ >> 3
#define P4_ISSUE_QK(u_) do { P4_DEC(u_, ib, ity, ih, ic); const int it0 = 64 * ic, isb = ib * T; \
        const bf16* zq = Z + plane64(ity ? F_GQ : F_MLQ, ih); const bf16* zk = Z + plane64(ity ? F_GK : F_MLK, ih); \
        { const int row = 8 * wave + (lane >> 3); int t = it0 - 1 + row; t = t < 0 ? 0 : t; const size_t so = (size_t)(isb + t) * 64 + (lane & 7) * 8; \
          glds16nt(zq + so, QR + wave * 1024); glds16nt(zk + so, KR + wave * 1024); } \
        if (wave < 2 && lane < 16) { const int row = 64 + (lane >> 3); int t = it0 - 1 + row; t = t >= T ? T - 1 : t; \
          glds16nt((wave ? zk : zq) + (size_t)(isb + t) * 64 + (lane & 7) * 8, (wave ? KR : QR) + 8192); } \
        if (gw4 < 2) { const int row = 32 * gw4 + (lane >> 1); glds16nt(Z + Z_MISC + (size_t)(isb + it0 + row) * 64 + M_LR + dg * 16 + (lane & 1) * 8, LR + gw4 * 1024); } } while (0)
#define P4_ISSUE_VC(u_) do { P4_DEC(u_, ib, ity, ih, ic); const int it0 = 64 * ic, isb = ib * T; const bf16* zv = Z + plane128(ity ? F_GV : F_MLV, ih); \
        _Pragma("unroll") for (int i = 0; i < 2; ++i) { const int qi = wave * 2 + i, row = 4 * qi + (lane >> 4); glds16nt(zv + (size_t)(isb + it0 + row) * 128 + ((lane & 15) ^ vswz(row)) * 8, VT + qi * 1024); } \
        const bf16* src = ST + ((((size_t)(ity * 2 + dg) * 32 + ib) * 4 + ih) * 32 + ic) * 8192; \
        _Pragma("unroll") for (int i = 0; i < 4; ++i) { const int qi = gw4 * 4 + i; glds16nt(src + qi * 512 + lane * 8, CTl + qi * 1024); } } while (0)
#define P4_GATES_LOAD(u_, gi_, gf_, gh_) do { P4_DEC(u_, ib, ity, ih, ic); (void)ity; const bf16* zr = Z + Z_MISC + (size_t)(ib * T + 64 * ic + lane) * 64 + M_MLG; \
        gi_ = zr[(2 * dg) * 4 + ih]; gf_ = zr[(2 * dg + 1) * 4 + ih]; gh_ = ih; } while (0)
#define P4_GATES_SCAN(slot_, gi_, gf_, gh_) do { LAS float* WBs = (LAS float*)(lds + P4_WB + ((slot_) * 2 + dg) * 512); const LAS float* GBt = (const LAS float*)(lds + P4_CW + 8192); \
        const float lf = fast_logsigmoid(bf2f(gf_) + GBt[(2 * dg + 1) * 4 + (gh_)]), gi2 = bf2f(gi_) + GBt[(2 * dg) * 4 + (gh_)]; \
        const float B = lane_scan(lf, lane, dg); WBs[lane] = __expf(B) * 0.125f; WBs[64 + lane] = __expf(gi2 - B); } while (0)
    bf16x8 w2h[4]; float gbh[4];
#pragma unroll
    for (int hh = 0; hh < 4; ++hh) { const int d = hh * 64 + 16 * gw4 + l15; const float* w2 = a.in[I_GW2] + (size_t)dg * 16 * 256 + d;
#pragma unroll
        for (int j = 0; j < 8; ++j) { float v = 0.f; if (g < 2) v = w2[(8 * g + j) * 256]; w2h[hh][j] = (short)f2bf(v); }
        gbh[hh] = a.in[I_GGB][dg * 256 + d]; }
    int u = vcu;
    if (u < 8192) {
        P4_ISSUE_QK(u); P4_ISSUE_VC(u);
    }
    VM_WAIT();
    __syncthreads();
    if (u < 8192 && gw4 == 0) { unsigned short gi, gf; int gh; P4_GATES_LOAD(u, gi, gf, gh); P4_GATES_SCAN(0, gi, gf, gh); }
    __syncthreads();
    for (int iter = 0; u < 8192; u += G, ++iter) {
        P4_DEC(u, b, type, h, c);
        const int t0 = 64 * c, segbase = b * T;
        const int un = u + G; const bool has_next = un < 8192;
        const int et = tid >> 3, evc = (tid & 7) * 16, erow = segbase + t0 + et;
        const bf16* zg = Z + plane128(type ? F_GG : F_MLO, h) + (size_t)erow * 128 + evc;
        const u32x4 eg0 = *(const u32x4*)zg, eg1 = *(const u32x4*)(zg + 8);
        f32x4 ngv[4];
        { const float* ngm = a.in[I_MLNG]; const float* ngg = a.in[I_GNG]; asm volatile("" : "+s"(ngm), "+s"(ngg)); const float* ng = (type ? ngg : ngm) + h * 128 + evc;
#pragma unroll
          for (int j = 0; j < 4; ++j) ngv[j] = *(const f32x4*)(ng + 4 * j); }
        f32x4 nsa[2][2];
#pragma unroll
        for (int ks = 0; ks < 2; ++ks) { nsa[ks][0] = (f32x4){0.f, 0.f, 0.f, 0.f}; nsa[ks][1] = nsa[ks][0]; }
        if (type == 0 && l15 == 0) { const float* nd = NST + ((((size_t)dg * 32 + b) * 4 + h) * 32 + c) * 64;
#pragma unroll
            for (int ks = 0; ks < 2; ++ks) { nsa[ks][0] = *(const f32x4*)(nd + 32 * ks + 8 * g); nsa[ks][1] = *(const f32x4*)(nd + 32 * ks + 8 * g + 4); } }
        unsigned short ngi = 0, ngf = 0; int ngh = 0;
        if (gw4 == 0 && has_next) P4_GATES_LOAD(un, ngi, ngf, ngh);
        if (type == 0) {
            const int qk = tid >> 8;
            const LAS float* WB0 = (const LAS float*)(lds + P4_WB + ((iter & 1) * 2 + 0) * 512) + qk * 64; const LAS float* WB1 = (const LAS float*)(lds + P4_WB + ((iter & 1) * 2 + 1) * 512) + qk * 64;
            float cw[3][8], cb[8];
            const int chn = qk * 256 + h * 64 + c8 * 8;
#pragma unroll
            for (int j4 = 0; j4 < 2; ++j4) { const f32x4 x0 = *(const LAS f32x4*)(CW + chn + 4 * j4), x1 = *(const LAS f32x4*)(CW + 512 + chn + 4 * j4), x2 = *(const LAS f32x4*)(CW + 1024 + chn + 4 * j4), x3 = *(const LAS f32x4*)(CW + 1536 + chn + 4 * j4);
#pragma unroll
                for (int i = 0; i < 4; ++i) { cw[0][4 * j4 + i] = x0[i]; cw[1][4 * j4 + i] = x1[i]; cw[2][4 * j4 + i] = x2[i]; cb[4 * j4 + i] = x3[i]; } }
            const LAS unsigned char* RAW = qk ? KR : QR; LAS unsigned char* DST = lds + (qk ? P4_KP : P4_QP);
#pragma unroll
            for (int pss = 0; pss < 2; ++pss) { const int s = (gt >> 3) + 32 * pss;
                u32x4 a0 = *(const LAS u32x4*)(RAW + (s + 0) * 128 + c8 * 16); const u32x4 a1 = *(const LAS u32x4*)(RAW + (s + 1) * 128 + c8 * 16); u32x4 a2 = *(const LAS u32x4*)(RAW + (s + 2) * 128 + c8 * 16);
                if (t0 + s - 1 < 0) a0 = (u32x4){0u, 0u, 0u, 0u};
                if (t0 + s + 1 >= T) a2 = (u32x4){0u, 0u, 0u, 0u};
                float o[8];
#pragma unroll
                for (int j = 0; j < 4; ++j) {
                    o[2 * j] = fsilu(cb[2 * j] + cw[0][2 * j] * bflo(a0[j]) + cw[1][2 * j] * bflo(a1[j]) + cw[2][2 * j] * bflo(a2[j]));
                    o[2 * j + 1] = fsilu(cb[2 * j + 1] + cw[0][2 * j + 1] * bfhi(a0[j]) + cw[1][2 * j + 1] * bfhi(a1[j]) + cw[2][2 * j + 1] * bfhi(a2[j])); }
                *(LAS u32x4*)(DST + s * PQK + c8 * 16) = pack8(o, WB0[s]);
                *(LAS u32x4*)(DST + P4_TS + s * PQK + c8 * 16) = pack8(o, WB1[s]); }
        } else {
            const bf16x8 w2f = h == 0 ? w2h[0] : h == 1 ? w2h[1] : h == 2 ? w2h[2] : w2h[3]; const float gbd = h == 0 ? gbh[0] : h == 1 ? gbh[1] : h == 2 ? gbh[2] : gbh[3];
            f32x4 la[4];
#pragma unroll
            for (int mt = 0; mt < 4; ++mt) { bf16x8 af = (bf16x8){0, 0, 0, 0, 0, 0, 0, 0}; if (g < 2) af = *(const LAS bf16x8*)(LR + (16 * mt + l15) * 32 + g * 16);
                la[mt] = MFMA16(af, w2f, ((f32x4){gbd, gbd, gbd, gbd}));
#pragma unroll
                for (int rg = 0; rg < 4; ++rg) la[mt][rg] = fast_logsigmoid(la[mt][rg]) * (1.0f / 16.0f); }
            float tmt[4];
#pragma unroll
            for (int mt = 0; mt < 4; ++mt) {
                if (dg == 0) { la[mt][1] += la[mt][0]; la[mt][2] += la[mt][1]; la[mt][3] += la[mt][2]; }
                else { la[mt][2] += la[mt][3]; la[mt][1] += la[mt][2]; la[mt][0] += la[mt][1]; }
                const float tg = dg == 0 ? la[mt][3] : la[mt][0];
                const float t0g = __shfl(tg, l15), t1g = __shfl(tg, l15 + 16), t2g = __shfl(tg, l15 + 32), t3g = __shfl(tg, l15 + 48);
                float og;
                if (dg == 0) og = (g > 0 ? t0g : 0.f) + (g > 1 ? t1g : 0.f) + (g > 2 ? t2g : 0.f);
                else og = (g < 3 ? t3g : 0.f) + (g < 2 ? t2g : 0.f) + (g < 1 ? t1g : 0.f);
#pragma unroll
                for (int rg = 0; rg < 4; ++rg) la[mt][rg] += og;
                tmt[mt] = (t0g + t1g) + (t2g + t3g); }
#pragma unroll
            for (int mt = 0; mt < 4; ++mt) { float om;
                if (dg == 0) om = (mt > 0 ? tmt[0] : 0.f) + (mt > 1 ? tmt[1] : 0.f) + (mt > 2 ? tmt[2] : 0.f);
                else om = (mt < 3 ? tmt[3] : 0.f) + (mt < 2 ? tmt[2] : 0.f) + (mt < 1 ? tmt[1] : 0.f);
#pragma unroll
                for (int rg = 0; rg < 4; ++rg) { const int s = 16 * mt + 4 * g + rg, d = 16 * gw4 + l15; const float B = om + la[mt][rg];
                    const float qv = bf2f(*(const LAS unsigned short*)(QR + (s + 1) * 128 + d * 2)), kv = bf2f(*(const LAS unsigned short*)(KR + (s + 1) * 128 + d * 2));
                    *(LAS unsigned short*)(QP + s * PQK + d * 2) = (unsigned short)f2bf(qv * 0.125f * __expf(B));
                    *(LAS unsigned short*)(KP + s * PQK + d * 2) = (unsigned short)f2bf(kv * __expf(-B)); } }
        }
        asm volatile("" :: "v"(eg0), "v"(eg1), "v"(ngi), "v"(ngf), "v"(nsa[0][0]), "v"(nsa[0][1]), "v"(nsa[1][0]), "v"(nsa[1][1]), "v"(ngv[0]), "v"(ngv[1]), "v"(ngv[2]), "v"(ngv[3]));
        VM_WAIT();
        BAR_LDS();
        if (has_next) P4_ISSUE_QK(un);
        bf16x8 qf[2];
#pragma unroll
        for (int ks = 0; ks < 2; ++ks) qf[ks] = *(const LAS bf16x8*)(QP + (16 * gw4 + l15) * PQK + (32 * ks + 8 * g) * 2);
        float rs = 0.f;
        {
            f32x4 sa[4];
#pragma unroll
            for (int mt = 0; mt < 4; ++mt) sa[mt] = (f32x4){0.f, 0.f, 0.f, 0.f};
#pragma unroll
            for (int ks = 0; ks < 2; ++ks)
#pragma unroll
                for (int mt = 0; mt < 4; ++mt) { const bf16x8 kf = *(const LAS bf16x8*)(KP + (16 * mt + l15) * PQK + (32 * ks + 8 * g) * 2); sa[mt] = MFMA16(kf, qf[ks], sa[mt]); }
            const int t = 16 * gw4 + l15;
#pragma unroll
            for (int mt = 0; mt < 4; ++mt) { float v[4];
#pragma unroll
                for (int rg = 0; rg < 4; ++rg) { const int sI = 16 * mt + 4 * g + rg; const bool keep = dg == 0 ? (sI <= t) : (sI >= t); v[rg] = keep ? sa[mt][rg] : 0.f; rs += v[rg]; }
                u32x2 w; w.x = pk2(v[0], v[1]); w.y = pk2(v[2], v[3]);
                *(LAS u32x2*)(SW + t * PQK + (16 * mt + 4 * g) * 2) = w; }
            rs += __shfl_xor(rs, 16); rs += __shfl_xor(rs, 32);
        }
        f32x4 na[8], nn = (f32x4){0.f, 0.f, 0.f, 0.f};
#pragma unroll
        for (int mt = 0; mt < 8; ++mt) na[mt] = (f32x4){0.f, 0.f, 0.f, 0.f};
#pragma unroll
        for (int ks = 0; ks < 2; ++ks) { const bf16x8 sf = *(const LAS bf16x8*)(SW + (16 * gw4 + l15) * PQK + (32 * ks + 8 * g) * 2);
            const int r0 = 32 * ks + 8 * g + q, x0 = vswz(r0), x1 = vswz(r0 + 4);
#pragma unroll
            for (int mt = 0; mt < 8; ++mt) { const int ch = 2 * mt + (p >> 1); const LAS unsigned char* pa0 = VT + r0 * 256 + ((ch ^ x0) * 16) + 8 * (p & 1); const LAS unsigned char* pa1 = VT + (r0 + 4) * 256 + ((ch ^ x1) * 16) + 8 * (p & 1);
                na[mt] = MFMA16(cat8(trr(pa0), trr(pa1)), sf, na[mt]); } }
#pragma unroll
        for (int ks = 0; ks < 2; ++ks) {
#pragma unroll
            for (int mt = 0; mt < 8; ++mt) { const bf16x8 cf = *(const LAS bf16x8*)(CTl + ((mt * 2 + ks) * 64 + lane) * 16); na[mt] = MFMA16(cf, qf[ks], na[mt]); }
            if (type == 0) { bf16x8 nf;
#pragma unroll
                for (int j = 0; j < 4; ++j) { nf[j] = (short)f2bf(nsa[ks][0][j]); nf[4 + j] = (short)f2bf(nsa[ks][1][j]); }
                nn = MFMA16(nf, qf[ks], nn); } }
        float inv = 1.0f;
        if (type == 0) { const float qn = __shfl(nn[0], l15); inv = 1.0f / fmaxf(fabsf(rs + qn), 1.0f); }
        BAR_LDS();
        if (has_next) P4_ISSUE_VC(un);
#pragma unroll
        for (int mt = 0; mt < 8; ++mt) { u32x2 w; w.x = pk2(na[mt][0] * inv, na[mt][1] * inv); w.y = pk2(na[mt][2] * inv, na[mt][3] * inv);
            *(LAS u32x2*)(Hme + (16 * gw4 + l15) * PH + (16 * mt + 4 * g) * 2) = w; }
        if (gw4 == 0 && has_next) P4_GATES_SCAN((iter + 1) & 1, ngi, ngf, ngh);
        BAR_LDS();
        {
            const LAS unsigned char* H0 = lds + P4_H + et * PH + evc * 2; float hv[16]; float ss = 0.f;
#pragma unroll
            for (int j = 0; j < 2; ++j) { const u32x4 x0 = *(const LAS u32x4*)(H0 + 16 * j), x1 = *(const LAS u32x4*)(H0 + P4_HS + 16 * j);
#pragma unroll
                for (int i = 0; i < 4; ++i) { const float v0 = bflo(x0[i]) + bflo(x1[i]), v1 = bfhi(x0[i]) + bfhi(x1[i]); hv[8 * j + 2 * i] = v0; hv[8 * j + 2 * i + 1] = v1; ss += v0 * v0 + v1 * v1; } }
            ss += __shfl_xor(ss, 1); ss += __shfl_xor(ss, 2); ss += __shfl_xor(ss, 4);
            const float rn = 1.0f / sqrtf(ss * (1.0f / 128.0f) + EPS);
            float gate[16];
#pragma unroll
            for (int j = 0; j < 4; ++j) { gate[2 * j] = bflo(eg0[j]); gate[2 * j + 1] = bfhi(eg0[j]); gate[8 + 2 * j] = bflo(eg1[j]); gate[8 + 2 * j + 1] = bfhi(eg1[j]); }
            float o[16];
#pragma unroll
            for (int i = 0; i < 16; ++i) { const float gv = type ? fsilu(gate[i]) : fsigmoid(gate[i]); o[i] = hv[i] * rn * ngv[i >> 2][i & 3] * gv; }
            bf16* dst = MG + (size_t)erow * D + type * 512 + h * 128 + evc;
            u32x4 w0, w1; w0.x = pk2(o[0], o[1]); w0.y = pk2(o[2], o[3]); w0.z = pk2(o[4], o[5]); w0.w = pk2(o[6], o[7]); w1.x = pk2(o[8], o[9]); w1.y = pk2(o[10], o[11]); w1.z = pk2(o[12], o[13]); w1.w = pk2(o[14], o[15]);
            *(u32x4*)dst = w0; *(u32x4*)(dst + 8) = w1;
        }
        asm volatile("s_waitcnt vmcnt(8)" ::: "memory");
        BAR_LDS();
    }
#undef P4_DEC
#undef P4_ISSUE_QK
#undef P4_ISSUE_VC
#undef P4_GATES_LOAD
#undef P4_GATES_SCAN
}

constexpr int P6_LG = 131072, P6_PE = 132096, P6_PP = 136192, P6_PR = 140288, P6_LC = 144384;
constexpr int P6_RWH = 0, P6_RR = 65536, P6_LGT = 66560, P6_AS = 83968;
__device__ __forceinline__ void p6_router(const Args& a, LAS unsigned char* lds, int vcu, int G) {
    const int tid = threadIdx.x, lane = tid & 63, wave = __builtin_amdgcn_readfirstlane(tid >> 6);
    const int g = lane >> 4, l15 = lane & 15;
    const float* mods = (const float*)(a.ws + WS_MODS); const float* rwt = (const float*)(a.ws + WS_RWT); const float* g2 = a.in[I_N2G]; const float* rb = a.in[I_RB];
    const bf16* X1 = (const bf16*)(a.ws + WS_X1B); unsigned char* U2 = a.ws + WS_U;
    int* ltok = (int*)(a.ws + WS_LTOK); float* lp = (float*)(a.ws + WS_LP); int* tgp = (int*)(a.ws + WS_TGP);
    unsigned* cntw = (unsigned*)(a.ws + WS_CTL) + CW_CNT;
    LAS unsigned char* RWH = lds + P6_RWH; LAS float* RR = (LAS float*)(lds + P6_RR) + wave * 32; LAS float* LGT = (LAS float*)(lds + P6_LGT) + wave * 512;
    LAS float* AS = (LAS float*)(lds + P6_AS);
    LAS int* PE = (LAS int*)(lds + P6_PE); LAS float* PP = (LAS float*)(lds + P6_PP); LAS int* PR = (LAS int*)(lds + P6_PR);
    LAS int* LC = (LAS int*)(lds + P6_LC); LAS int* GB = LC + 32;
    for (int f = wave * 8; f < wave * 8 + 8; ++f) { const int mt = f >> 5, ks = f & 31; const float* src = rwt + (size_t)(16 * mt + l15) * 1024 + 32 * ks + 8 * g;
        const f32x4 x0 = *(const f32x4*)src, x1 = *(const f32x4*)(src + 4);
        u32x4 w; w.x = pk2(x0.x, x0.y); w.y = pk2(x0.z, x0.w); w.z = pk2(x1.x, x1.y); w.w = pk2(x1.z, x1.w);
        *(LAS u32x4*)(RWH + (f * 64 + lane) * 16) = w; }
    f32x4 gv[4];
#pragma unroll
    for (int j = 0; j < 4; ++j) gv[j] = *(const f32x4*)(g2 + 4 * lane + 256 * j);
    for (int rbk = vcu; rbk < NLAT / 256; rbk += G) {
        const int mbase = rbk * 256 + wave * 32, b = mbase >> 11;
        const float* md = mods + (size_t)b * 6144;
        if (tid < 32) LC[tid] = 0;
        for (int i = tid; i < 1024; i += NTHR) { AS[i] = g2[i] * (1.0f + md[4 * 1024 + i]); AS[1024 + i] = md[3 * 1024 + i]; }
        __syncthreads();
        f32x4 vn[2][4];
#pragma unroll
        for (int r = 0; r < 2; ++r)
#pragma unroll
            for (int j = 0; j < 4; ++j) vn[r][j] = ldbf4(X1 + (size_t)(mbase + r) * D + 4 * lane + 256 * j);
        for (int i = 0; i < 32; i += 2) {
            f32x4 v[2][4];
#pragma unroll
            for (int r = 0; r < 2; ++r)
#pragma unroll
                for (int j = 0; j < 4; ++j) v[r][j] = vn[r][j];
            if (i + 2 < 32) {
#pragma unroll
                for (int r = 0; r < 2; ++r)
#pragma unroll
                    for (int j = 0; j < 4; ++j) vn[r][j] = ldbf4(X1 + (size_t)(mbase + i + 2 + r) * D + 4 * lane + 256 * j); }
#pragma unroll
            for (int r = 0; r < 2; ++r) { float s = 0.f;
#pragma unroll
                for (int j = 0; j < 4; ++j) s += (v[r][j].x * v[r][j].x + v[r][j].y * v[r][j].y) + (v[r][j].z * v[r][j].z + v[r][j].w * v[r][j].w);
                const float rr = 1.0f / sqrtf(wave_sum(s) * (1.0f / D) + EPS);
                if (lane == 0) RR[i + r] = rr;
                unsigned* o4 = (unsigned*)(U2 + (size_t)(mbase + i + r) * D) + lane;
#pragma unroll
                for (int j = 0; j < 4; ++j) { const f32x4 aa = *(const LAS f32x4*)(AS + 4 * lane + 256 * j), sh = *(const LAS f32x4*)(AS + 1024 + 4 * lane + 256 * j);
                    const f32x4 y = v[r][j] * rr * aa + sh;
                    o4[64 * j] = pg8::pk4_fp8(y.x, y.y, y.z, y.w); } }
        }
        LDS_WAIT(); asm volatile("" ::: "memory");
#pragma unroll 1
        for (int tl = 0; tl < 2; ++tl) {
            const int row = mbase + 16 * tl + l15; const float rr = RR[16 * tl + l15];
            const bf16* xr = X1 + (size_t)row * D + 8 * g;
            f32x4 acc[2]; acc[0] = (f32x4){0.f, 0.f, 0.f, 0.f}; acc[1] = acc[0];
            f32x4 xc[4][2], xn[4][2];
#pragma unroll
            for (int k4 = 0; k4 < 4; ++k4) { xc[k4][0] = ldbf4(xr + 32 * k4); xc[k4][1] = ldbf4(xr + 32 * k4 + 4); }
#pragma unroll 1
            for (int kb = 0; kb < 8; ++kb) {
                const int kn = kb < 7 ? kb + 1 : kb;
#pragma unroll
                for (int k4 = 0; k4 < 4; ++k4) { xn[k4][0] = ldbf4(xr + 32 * (4 * kn + k4)); xn[k4][1] = ldbf4(xr + 32 * (4 * kn + k4) + 4); }
#pragma unroll
                for (int k4 = 0; k4 < 4; ++k4) { const int ks = 4 * kb + k4;
                    const f32x4 a0 = *(const LAS f32x4*)(AS + 32 * ks + 8 * g), a1 = *(const LAS f32x4*)(AS + 32 * ks + 8 * g + 4);
                    const f32x4 s0 = *(const LAS f32x4*)(AS + 1024 + 32 * ks + 8 * g), s1 = *(const LAS f32x4*)(AS + 1024 + 32 * ks + 8 * g + 4);
                    const f32x4 u0 = xc[k4][0] * rr * a0 + s0, u1 = xc[k4][1] * rr * a1 + s1;
                    bf16x8 bh, bl;
#pragma unroll
                    for (int j = 0; j < 4; ++j) { const unsigned h0 = f2bf(u0[j]), h1 = f2bf(u1[j]); bh[j] = (short)h0; bh[4 + j] = (short)h1;
                        bl[j] = (short)f2bf(u0[j] - __builtin_bit_cast(float, h0 << 16)); bl[4 + j] = (short)f2bf(u1[j] - __builtin_bit_cast(float, h1 << 16)); }
#pragma unroll
                    for (int mt = 0; mt < 2; ++mt) { const bf16x8 af = *(const LAS bf16x8*)(RWH + ((mt * 32 + ks) * 64 + lane) * 16); acc[mt] = MFMA16(af, bh, acc[mt]); acc[mt] = MFMA16(af, bl, acc[mt]); } }
#pragma unroll
                for (int k4 = 0; k4 < 4; ++k4) { xc[k4][0] = xn[k4][0]; xc[k4][1] = xn[k4][1]; }
            }
#pragma unroll
            for (int mt = 0; mt < 2; ++mt) { const f32x4 bb = *(const f32x4*)(rb + 16 * mt + 4 * g); *(LAS f32x4*)(LGT + l15 * 32 + 16 * mt + 4 * g) = acc[mt] + bb; }
            LDS_WAIT(); asm volatile("" ::: "memory");
            if (lane < 16) {
                float lv[32];
#pragma unroll
                for (int j = 0; j < 8; ++j) { const f32x4 t4 = *(const LAS f32x4*)(LGT + lane * 32 + 4 * j); lv[4 * j] = t4[0]; lv[4 * j + 1] = t4[1]; lv[4 * j + 2] = t4[2]; lv[4 * j + 3] = t4[3]; }
                unsigned taken = 0u; int sel[4]; float val[4];
#pragma unroll
                for (int k = 0; k < 4; ++k) { float best = -3.0e38f; int bi = 0;
#pragma unroll
                    for (int e = 0; e < 32; ++e) { const bool okk = ((taken >> e) & 1u) == 0u && lv[e] > best; best = okk ? lv[e] : best; bi = okk ? e : bi; }
                    sel[k] = bi; val[k] = best; taken |= 1u << bi; }
                const float e1 = __expf(val[1] - val[0]), e2 = __expf(val[2] - val[0]), e3 = __expf(val[3] - val[0]); const float inv = 1.0f / (1.0f + e1 + e2 + e3);
                const int rl = wave * 32 + 16 * tl + lane; const float pr[4] = {inv, e1 * inv, e2 * inv, e3 * inv};
#pragma unroll
                for (int k = 0; k < 4; ++k) { const int rk = __hip_atomic_fetch_add(LC + sel[k], 1, __ATOMIC_RELAXED, __HIP_MEMORY_SCOPE_WORKGROUP);
                    PE[rl * 4 + k] = sel[k]; PP[rl * 4 + k] = pr[k]; PR[rl * 4 + k] = rk; }
            }
            LDS_WAIT(); asm volatile("" ::: "memory");
        }
        __syncthreads();
        if (tid < 32) GB[tid] = (int)__hip_atomic_fetch_add(cntw + tid * 64, (unsigned)LC[tid], __ATOMIC_RELAXED, __HIP_MEMORY_SCOPE_AGENT);
        __syncthreads();
        for (int pi = tid; pi < 1024; pi += NTHR) { const int e = PE[pi], gg = e, pos = GB[e] + PR[pi], tok = rbk * 256 + (pi >> 2);
            ltok[(size_t)gg * LCAP + pos] = tok; lp[(size_t)gg * LCAP + pos] = PP[pi]; tgp[tok * 4 + (pi & 3)] = (gg << 16) | pos; }
        __syncthreads();
    }
    __syncthreads();
}
__device__ __forceinline__ void p6_convert(const Args& a, LAS unsigned char* lds, int vcu, int G) {
    const int tid = threadIdx.x, lane = tid & 63, wave = __builtin_amdgcn_readfirstlane(tid >> 6);
    {
        const int gw = vcu * NWAVES + wave, NGW = G * NWAVES; LAS float* scr = (LAS float*)(lds + wave * 16384);
        unsigned char* wgut = a.ws + WS_WGU; unsigned char* wdt = a.ws + WS_WD;
        constexpr int I_GU = 32 * 16 * 64, I_DN = 32 * 16 * 32;
        for (int it = gw; it < I_GU + I_DN; it += NGW) {
            if (it < I_GU) { const int e = it >> 10, r = it & 1023, kb = r >> 6, nb = r & 63, n0 = 32 * nb, hf = n0 >> 10, j0 = n0 & 1023;
                transpose_item_f8(a.in[I_WGU] + (size_t)e * 1024 * 2048, 2048, wgut + (size_t)e * 2048 * 1024, 64 * kb, n0, 256 * (j0 >> 7) + 128 * hf + (j0 & 127), pg8::WSC, scr, lane); }
            else { const int r0 = it - I_GU, e = r0 >> 9, r = r0 & 511, kb = r >> 5, nb = r & 31;
                transpose_item_f8(a.in[I_WD] + (size_t)e * 1024 * 1024, 1024, wdt + (size_t)e * 1024 * 1024, 64 * kb, 32 * nb, 32 * nb, pg8::WSC, scr, lane); }
        }
    }
}

__device__ __forceinline__ int moe_tables(const Args& a, LAS unsigned char* lds) {
    const int tid = threadIdx.x;
    LAS int* CN = (LAS int*)(lds + TAB_OFF); LAS int* TS = CN + 64; LAS int* TAB = CN + 128;
    unsigned* cntw = (unsigned*)(a.ws + WS_CTL) + CW_CNT;
    __syncthreads();
    if (tid < 32) { int c = (int)__hip_atomic_load(cntw + tid * 64, __ATOMIC_RELAXED, __HIP_MEMORY_SCOPE_AGENT); CN[tid] = c > LCAP ? LCAP : c; }
    __syncthreads();
    if (tid == 0) { int s = 0; for (int e = 0; e < 32; ++e) { TS[e] = s; s += (CN[e] + 255) >> 8; } TS[32] = s > MAXTILES ? MAXTILES : s; }
    __syncthreads();
    const int nt = TS[32];
    for (int tau = tid; tau < nt; tau += NTHR) { int e = 0;
#pragma unroll 1
        for (int k = 1; k < 32; ++k) if (TS[k] <= tau) e = k;
        TAB[tau] = (e << 16) | (tau - TS[e]); }
    __syncthreads();
    return nt;
}

__device__ __forceinline__ void p9_combine(const Args& a, LAS unsigned char* lds, int vcu, int G, bool dry = false) {
    const int tid = threadIdx.x, lane = tid & 63, wave = __builtin_amdgcn_readfirstlane(tid >> 6);
    (void)moe_tables(a, lds);
    const LAS int* TS = (const LAS int*)(lds + TAB_OFF) + 64;
    const float* mods = (const float*)(a.ws + WS_MODS); const float* fg = a.in[I_FNG]; const int* tgp = (const int*)(a.ws + WS_TGP); const unsigned char* Y = a.ws + WS_Y;
    float* O = a.out; const bf16* X1 = (const bf16*)(a.ws + WS_X1B);
    const int gw = vcu * NWAVES + wave, NGW = G * NWAVES;
    f32x4 gv[4];
#pragma unroll
    for (int j = 0; j < 4; ++j) gv[j] = *(const f32x4*)(fg + 4 * lane + 256 * j);
    for (int i0 = gw; i0 < NLAT; i0 += 2 * NGW) {
        int gpv[2][4];
#pragma unroll
        for (int r = 0; r < 2; ++r) { const int i = i0 + r * NGW; const int m = i < NLAT ? i : i0;
#pragma unroll
            for (int k = 0; k < 4; ++k) gpv[r][k] = tgp[m * 4 + k]; }
        f32x4 acc[2][4], x1v[2][4];
#pragma unroll
        for (int r = 0; r < 2; ++r) { const int i = i0 + r * NGW; const int m = i < NLAT ? i : i0;
#pragma unroll
            for (int j = 0; j < 4; ++j) { acc[r][j] = (f32x4){0.f, 0.f, 0.f, 0.f}; x1v[r][j] = ldbf4(X1 + (size_t)m * D + 4 * lane + 256 * j); }
#pragma unroll
            for (int k = 0; k < 4; ++k) { const int gp = gpv[r][k], g = (gp >> 16) & 31, pos = gp & 0xffff; const size_t prow = (size_t)TS[g] * 256 + pos;
                const int* yr = (const int*)(Y + prow * D) + lane;
#pragma unroll
                for (int j = 0; j < 4; ++j) { const int w = yr[64 * j]; const f32x2 lo = __builtin_amdgcn_cvt_pk_f32_fp8(w, false), hi = __builtin_amdgcn_cvt_pk_f32_fp8(w, true); acc[r][j] += (f32x4){lo.x, lo.y, hi.x, hi.y}; } } }
#pragma unroll
        for (int r = 0; r < 2; ++r) { const int i = i0 + r * NGW; if (i >= NLAT) continue;
            const int m = i, b = m >> 11; const float* md = mods + (size_t)b * 6144 + 5 * 1024;
            f32x4 v[4]; float s = 0.f;
#pragma unroll
            for (int j = 0; j < 4; ++j) { const f32x4 g5 = *(const f32x4*)(md + 4 * lane + 256 * j) * pg8::YSCI;
                v[j] = x1v[r][j] + g5 * acc[r][j]; s += (v[j].x * v[j].x + v[j].y * v[j].y) + (v[j].z * v[j].z + v[j].w * v[j].w); }
            const float rr = 1.0f / sqrtf(wave_sum(s) * (1.0f / D) + EPS);
#pragma unroll
            for (int j = 0; j < 4; ++j) { const f32x4 ov = v[j] * rr * gv[j]; if (!dry) *(f32x4*)(O + (size_t)m * D + 4 * lane + 256 * j) = ov; else asm volatile("" :: "v"(ov)); } }
    }
}

constexpr int NPH = 10;
__global__ void __launch_bounds__(NTHR, 2) fwd_kernel(Args args) {
    extern __shared__ __attribute__((aligned(16))) unsigned char lds_raw[];
    LAS unsigned char* lds = (LAS unsigned char*)lds_raw;
    const int tid = threadIdx.x, G = gridDim.x, bx = blockIdx.x;
    const int vcu = (G % 8 == 0) ? (bx % 8) * (G / 8) + bx / 8 : bx;
    volatile LAS unsigned* MISC = (volatile LAS unsigned*)(lds + MISC_OFF);
    if (tid < 64) MISC[tid] = 0u;
    __syncthreads();
    unsigned* ctl = (unsigned*)(args.ws + WS_CTL);
    const int lo = args.ph_lo, hi = args.ph_hi;
    XcdBarrier bar; bar.bar = ctl + CW_BAR + args.li * XCD_BAR_WORDS; bar.x = 0; bar.st = MISC + 8;
    if (hi - lo > 1) bar = xcd_barrier_post(ctl + CW_BAR + args.li * XCD_BAR_WORDS, MISC + 8);
#ifndef PHMASK
#define PHMASK 0x3ff
#endif
#define IN(k) (((PHMASK >> (k)) & 1) && lo <= (k) && (k) < hi)
#define SEAM(k) do { if (IN(k) && IN((k) + 1)) xcd_barrier(bar); } while (0)
    unsigned char* ws = args.ws;
#ifndef PROBE_DUP
#define PROBE_DUP 0
#endif
#define REPS(k) (1 + ((PROBE_DUP >> (k)) & 1))
    if (IN(0)) { for (int rep = 0; rep < REPS(0); ++rep) { p0_prologue(args, lds, vcu, G); __syncthreads(); } SEAM(0); }
    if (IN(1)) { for (int rep = 0; rep < REPS(1); ++rep) p1_norm1(args, vcu, G); p1_weight_copies(args, lds, vcu, G); SEAM(1); }
    if (IN(2)) {
        { pg8::ProbIn2<false> P{(const char*)(ws + WS_U), (const char*)(ws + WS_WIN), G, bx};
          pg8::EpiZ E{(bf16*)(ws + WS_Z), 1.0f};
          pg8::gemm_phase<pg8::EpiZ, pg8::ProbIn2<false>, true>(lds, P, E); }
        { pg8::ProbIn2<true> P{(const char*)(ws + WS_U8), (const char*)(ws + WS_WIN8), G, G - 1 - bx};
          pg8::EpiZ E{(bf16*)(ws + WS_Z), 1.0f / (USC * pg8::WSC)};
          pg8::gemm_phase<pg8::EpiZ, pg8::ProbIn2<true>, true>(lds, P, E); }
        SEAM(2);
    }
    if (IN(3)) { p3_chains(args, lds, vcu, G); if (REPS(3) > 1) { __syncthreads(); p3_chains(args, lds, vcu, G); } SEAM(3); }
    if (IN(4)) { p4_outputs(args, lds, vcu, G); if (REPS(4) > 1) { __syncthreads(); p4_outputs(args, lds, vcu, G); } SEAM(4); }
    if (IN(5)) {
        pg8::ProbDense P{(const char*)(ws + WS_U), (const char*)(ws + WS_WOUT), NLAT / 256, D / 256, G, bx};
        pg8::EpiX1 E{args.in[I_X], (const float*)(ws + WS_POS), (const float*)(ws + WS_MODS), (bf16*)(ws + WS_X1B)};
        pg8::gemm_phase<pg8::EpiX1, pg8::ProbDense, true>(lds, P, E);
        if (REPS(5) > 1) pg8::gemm_phase<pg8::EpiX1, pg8::ProbDense, true>(lds, P, E);
        SEAM(5);
    }
    if (IN(6)) { p6_router(args, lds, vcu, G);
        if (REPS(12) > 1) { xcd_barrier(bar); if (bx == 0 && tid < 64) (ctl + CW_CNT)[tid * 64] = 0u; xcd_barrier(bar); p6_router(args, lds, vcu, G); }
        p6_convert(args, lds, vcu, G); if (REPS(6) > 1) p6_convert(args, lds, vcu, G); SEAM(6); }
    if (IN(7)) {
        const int ntl = moe_tables(args, lds);
        pg8::ProbMoe<true> P{(const char*)(ws + WS_U), (const char*)(ws + WS_WGU), (const int*)(ws + WS_LTOK), (const LAS int*)(lds + TAB_OFF) + 128, (const LAS int*)(lds + TAB_OFF), ntl, 8, G, bx, (size_t)2048 * 1024, args.in[I_BGU], nullptr};
        pg8::EpiGU E{ws + WS_ACT, lds + PF_OFF};
        pg8::gemm_phase<pg8::EpiGU, pg8::ProbMoe<true>, true>(lds, P, E);
        if (REPS(7) > 1) pg8::gemm_phase<pg8::EpiGU, pg8::ProbMoe<true>, true>(lds, P, E);
        SEAM(7);
    }
    if (IN(8)) {
        const int ntl = moe_tables(args, lds);
        pg8::ProbMoe<false> P{(const char*)(ws + WS_ACT), (const char*)(ws + WS_WD), (const int*)(ws + WS_LTOK), (const LAS int*)(lds + TAB_OFF) + 128, (const LAS int*)(lds + TAB_OFF), ntl, 4, G, bx, (size_t)1024 * 1024, args.in[I_BD], (const float*)(ws + WS_LP)};
        pg8::EpiDown E{ws + WS_Y, lds + PF_OFF, (const LAS int*)(lds + TAB_OFF)};
        pg8::gemm_phase<pg8::EpiDown, pg8::ProbMoe<false>, true>(lds, P, E);
        if (REPS(8) > 1) pg8::gemm_phase<pg8::EpiDown, pg8::ProbMoe<false>, true>(lds, P, E);
        SEAM(8);
    }
    if (IN(9)) { if (REPS(9) > 1) p9_combine(args, lds, vcu, G, true); p9_combine(args, lds, vcu, G); }
#undef IN
#undef SEAM
#undef REPS
}

extern "C" void kernel_launch(void* const* d_in, const int* in_sizes, int n_in, void* d_out, int out_size, void* d_ws, size_t ws_size, hipStream_t stream) {
    static int grid = 0;
    if (grid == 0) {
        if (n_in != 24 || in_sizes[0] != NLAT * D || out_size != NLAT * D || ws_size < WS_END) { fprintf(stderr, "kernel_launch: unexpected shapes (n_in %d, in0 %d, out %d, ws %zu); nothing launched\n", n_in, n_in > 0 ? in_sizes[0] : -1, out_size, ws_size); grid = -1; return; }
        int dev = 0, cus = 0, per_cu = 0;
        if (hipGetDevice(&dev) != hipSuccess || hipDeviceGetAttribute(&cus, hipDeviceAttributeMultiprocessorCount, dev) != hipSuccess) { grid = -1; return; }
        if (hipFuncSetAttribute((const void*)fwd_kernel, hipFuncAttributeMaxDynamicSharedMemorySize, LDS_BYTES) != hipSuccess) { fprintf(stderr, "kernel_launch: hipFuncSetAttribute failed\n"); grid = -1; return; }
        if (hipOccupancyMaxActiveBlocksPerMultiprocessor(&per_cu, (const void*)fwd_kernel, NTHR, LDS_BYTES) != hipSuccess || per_cu < 1) { fprintf(stderr, "kernel_launch: occupancy query reports %d workgroups per CU\n", per_cu); }
        (void)hipGetLastError();
        grid = cus;
    }
    if (grid < 0) return;
    if (hipMemsetAsync((char*)d_ws + WS_CTL, 0, CTL_ZERO_BYTES, stream) != hipSuccess) return;
    Args a{};
    for (int i = 0; i < 24; ++i) a.in[i] = (const float*)d_in[i];
    a.out = (float*)d_out; a.ws = (unsigned char*)d_ws; a.pad = 0;
#if MK_N_LAUNCHES == 1
    a.ph_lo = 0; a.ph_hi = NPH; a.li = 0;
    hipLaunchKernelGGL(fwd_kernel, dim3(grid), dim3(NTHR), LDS_BYTES, stream, a);
#else
    for (int ph = 0; ph < NPH; ++ph) { a.ph_lo = ph; a.ph_hi = ph + 1; a.li = ph; hipLaunchKernelGGL(fwd_kernel, dim3(grid), dim3(NTHR), LDS_BYTES, stream, a); }
#endif
}
```

```cpp
#include <hip/hip_runtime.h>
#include <cstdio>
#include <cstdint>

#ifndef MK_N_LAUNCHES
#define MK_N_LAUNCHES 1
#endif

#define GAS __attribute__((address_space(1)))
#define LAS __attribute__((address_space(3)))
typedef unsigned short bf16;
typedef short bf16x8 __attribute__((ext_vector_type(8)));
typedef short s16x4 __attribute__((ext_vector_type(4)));
typedef float f32x4 __attribute__((ext_vector_type(4)));
typedef float f32x2 __attribute__((ext_vector_type(2)));
typedef unsigned u32x4 __attribute__((ext_vector_type(4)));
typedef unsigned u32x2 __attribute__((ext_vector_type(2)));

constexpr int NB = 32, T = 2048, D = 1024, CT = 256;
constexpr int NLAT = NB * T, NCTX = NB * CT, NTOK = NLAT + NCTX;
constexpr int INW = 3120, ZW = 3328;
constexpr size_t PL64 = (size_t)NTOK * 64, PL128 = (size_t)NTOK * 128;
constexpr int F_MLQ = 0, F_MLK = 1, F_GQ = 2, F_GK = 3, F_MLV = 0, F_MLO = 1, F_GV = 2, F_GG = 3;
__host__ __device__ constexpr size_t plane64(int f, int h) { return (size_t)(f * 4 + h) * PL64; }
__host__ __device__ constexpr size_t plane128(int f, int h) { return 16 * PL64 + (size_t)(f * 4 + h) * PL128; }
constexpr size_t Z_MISC = 16 * PL64 + 16 * PL128;
constexpr int M_MLG = 0, M_LR = 16;
constexpr int NE = 32, TOPK = 4, DE = 1024;
constexpr int LCAP = 65536;
constexpr int MAXTILES = 1056;
constexpr float EPS = 1e-6f;

constexpr size_t MiB = 1u << 20;
constexpr size_t WS_CTL = 0, CTL_ZERO_BYTES = 1 * MiB;
constexpr size_t WS_MODS = 1 * MiB;
constexpr size_t WS_POS = 2 * MiB;
constexpr size_t WS_WIN = 10 * MiB;
constexpr size_t WS_WOUT = 17 * MiB;
constexpr size_t WS_RWT = 19 * MiB;
constexpr size_t WS_LTOK = 20 * MiB;
constexpr size_t WS_LP = 28 * MiB;
constexpr size_t WS_TGP = 36 * MiB;
constexpr size_t WS_NST = 37 * MiB;
constexpr size_t WS_U = 40 * MiB;
constexpr size_t WS_Z = 184 * MiB;
constexpr size_t WS_ST = 652 * MiB;
constexpr size_t WS_WGU = 908 * MiB;
constexpr size_t WS_WD = 972 * MiB;
constexpr size_t WS_ACT = 200 * MiB;
constexpr size_t WS_Y = 472 * MiB;
constexpr size_t WS_X1B = 736 * MiB;
constexpr size_t WS_U8 = 652 * MiB;
constexpr size_t WS_WIN8 = 20 * MiB;
constexpr size_t WS_END = 1004 * MiB;
constexpr int CW_CNT = 2048;
constexpr int CW_BAR = 8192;

constexpr int RING_BYTES = 131072;
constexpr int LDS_BYTES = 147456;
constexpr int MISC_OFF = LDS_BYTES - 256;
constexpr int TAB_OFF = RING_BYTES;
constexpr int PF_OFF = TAB_OFF + 5120, PF_SLOT = 3072;
constexpr int NWAVES = 8, NTHR = 512;

#define LDS_WAIT() asm volatile("s_waitcnt lgkmcnt(0)" ::: "memory")
#define VM_WAIT() asm volatile("s_waitcnt vmcnt(0)" ::: "memory")
#define BAR_LDS() do { asm volatile("s_waitcnt lgkmcnt(0)" ::: "memory"); __builtin_amdgcn_s_barrier(); asm volatile("" ::: "memory"); } while (0)
__device__ __forceinline__ unsigned f2bf(float f) { unsigned u = __builtin_bit_cast(unsigned, f); return (u + 0x7fffu + ((u >> 16) & 1u)) >> 16; }
__device__ __forceinline__ unsigned pk2(float lo, float hi) { unsigned r; asm("v_cvt_pk_bf16_f32 %0, %1, %2" : "=v"(r) : "v"(lo), "v"(hi)); return r; }
__device__ __forceinline__ float bf2f(unsigned short b) { return __builtin_bit_cast(float, ((unsigned)b) << 16); }
__device__ __forceinline__ float bflo(unsigned w) { return __builtin_bit_cast(float, w << 16); }
__device__ __forceinline__ float bfhi(unsigned w) { return __builtin_bit_cast(float, w & 0xffff0000u); }
__device__ __forceinline__ float fsigmoid(float x) { return __builtin_amdgcn_rcpf(1.0f + __expf(-x)); }
__device__ __forceinline__ float fsilu(float x) { return x * __builtin_amdgcn_rcpf(1.0f + __expf(-x)); }
__device__ __forceinline__ float flogsigmoid(float x) { return fminf(x, 0.f) - log1pf(__expf(-fabsf(x))); }
__device__ __forceinline__ f32x4 ldbf4(const bf16* p) { const u32x2 w = *(const u32x2*)p; return (f32x4){bflo(w.x), bfhi(w.x), bflo(w.y), bfhi(w.y)}; }
__device__ __forceinline__ float wave_sum(float v) {
#pragma unroll
    for (int o = 1; o < 64; o <<= 1) v += __shfl_xor(v, o);
    return v;
}

namespace pg8 {
#define PG8_LAS __attribute__((address_space(3)))
typedef unsigned short bf16_t;
constexpr int BM = 256, BK = 64, HALF = 128, HTB = HALF * BK * 2, STAGE_BYTES = 8 * HTB, NXCD = 8, WGM = 8, GK = 1024;
__host__ __device__ __forceinline__ int lds_byte(int r, int c) { const int st = (r >> 4) * 2 + (c >> 5), rr = r & 15, cc = c & 31, ob = rr * 64 + cc * 2; return st * 1024 + (ob ^ (((ob >> 9) & 1) << 5)); }
__host__ __device__ __forceinline__ void stage_rc(int b, int& R, int& C) { const int st = b / 1024, sb = b % 1024, swz = sb ^ (((sb >> 9) & 1) << 5); R = (st >> 1) * 16 + swz / 64; C = (st & 1) * 32 + (swz % 64) / 2; }
__host__ __device__ __forceinline__ int perm32(int rho) { const int n = rho >> 4, i = rho & 15; return 8 * (i >> 2) + 4 * n + (i & 3); }
__host__ __device__ __forceinline__ int perm32w(int rho) { const int n = rho >> 4, i = rho & 15; return 16 * (i >> 2) + 4 * n + (i & 3); }
__device__ __forceinline__ unsigned cvt_pk_bf16(float lo, float hi) { unsigned r; asm volatile("v_cvt_pk_bf16_f32 %0, %1, %2" : "=v"(r) : "v"(lo), "v"(hi)); return r; }

typedef int i32x8 __attribute__((ext_vector_type(8)));
__device__ __forceinline__ i32x8 cat16(bf16x8 a, bf16x8 b) { typedef int i32x4 __attribute__((ext_vector_type(4))); const i32x4 x = __builtin_bit_cast(i32x4, a), y = __builtin_bit_cast(i32x4, b); return __builtin_shufflevector(x, y, 0, 1, 2, 3, 4, 5, 6, 7); }
__device__ __forceinline__ void mfma_f8(f32x4& acc, const i32x8& a, const i32x8& b, int sc) {
    asm volatile("s_nop 1\n\tv_mfma_scale_f32_16x16x128_f8f6f4 %0, %1, %2, %0, %3, %3 op_sel_hi:[0,0,0]" : "+v"(acc) : "v"(a), "v"(b), "v"(sc));
}
__device__ __forceinline__ void dma16(const void* g, PG8_LAS unsigned char* l) {
    unsigned keep; const unsigned dst = (unsigned)(size_t)l;
    asm volatile("s_mov_b32 %0, m0\n\ts_mov_b32 m0, %2\n\ts_nop 0\n\tglobal_load_lds_dwordx4 %1, off\n\ts_mov_b32 m0, %0" : "=&s"(keep) : "v"(g), "s"(dst) : "memory");
}
struct Unit { int pm, pn, g, r0, slot; };

__device__ __forceinline__ bool order_next(int i, int G, int c, int nM, int nN, int& pm, int& pn, const int WGM = pg8::WGM) {
    const int nwg = nM * nN; const long L = (long)i * G + c; if (L >= nwg) return false;
    int wgid = (int)L; { const int q = nwg / NXCD, r = nwg % NXCD, xcd = wgid % NXCD, off = wgid / NXCD; wgid = (xcd < r ? xcd * (q + 1) : r * (q + 1) + (xcd - r) * q) + off; }
    const int nig = WGM * nN, gid = wgid / nig, fm = gid * WGM, gsz = (nM - fm) < WGM ? (nM - fm) : WGM;
    pm = fm + ((wgid % nig) % gsz); pn = (wgid % nig) / gsz; return true;
}

template <class Epi, class Prob, bool ALIGN_EPI>
__device__ __forceinline__ void gemm_phase(PG8_LAS unsigned char* lds, const Prob& P, const Epi& E) {
    const int tid = threadIdx.x, wid = __builtin_amdgcn_readfirstlane(tid >> 6), lane = tid & 63, wr = wid >> 2, wc = wid & 3, fr = lane & 15, fq = lane >> 4;
    constexpr bool F8 = Prob::FP8; constexpr bool CM = Epi::CMAP == 1; constexpr int NST = Epi::NST; static_assert(GK / (F8 ? 128 : 64) >= 6, "peeled K loop");
    constexpr int RSB = F8 ? GK : GK * 2, nt = RSB / 128;
    unsigned vB, vA, cA2;
    { int R, C; stage_rc(tid * 16, R, C); const int Rb = CM ? 64 * (R >> 5) + perm32w(R & 31) : Epi::PERM ? ((R & ~31) + perm32(R & 31)) : R; vB = (unsigned)(Rb * RSB + C * 2); vA = (unsigned)(R * RSB + C * 2); cA2 = (unsigned)(C * 2); }
    constexpr size_t kstep = (size_t)(BK * 2);
    constexpr size_t hstep = (size_t)(CM ? 8 : HALF) * RSB;
    const unsigned ldsw = (unsigned)wid * 1024u;
    const int aoff = lds_byte(wr * 64 + fr, fq * 8), boff = lds_byte(wc * 32 + fr, fq * 8);
#define PG8_SA(b, h) (((b) * 2 + (h)) * HTB)
#define PG8_SB(b, h) ((4 + (b) * 2 + (h)) * HTB)
#define PG8_STAGE_B(bufoff, gbase) do { _Pragma("unroll") for (int _i = 0; _i < 2; ++_i) \
        __builtin_amdgcn_global_load_lds((const unsigned*)((const char*)(gbase) + (size_t)(_i * (CM ? 128 : 64) * RSB) + vB), (PG8_LAS unsigned*)(lds + (bufoff) + ldsw + _i * 8192), 16, 0, 0); } while (0)
#define PG8_STAGE_A(bufoff, abase, tk, h) do { _Pragma("unroll") for (int _i = 0; _i < 2; ++_i) { \
        if constexpr (GATH) { const unsigned _t = _i ? ((tk)[h] >> 16) : ((tk)[h] & 0xffffu); \
            __builtin_amdgcn_global_load_lds((const unsigned*)((abase) + (size_t)(_t * (unsigned)RSB + cA2)), (PG8_LAS unsigned*)(lds + (bufoff) + ldsw + _i * 8192), 16, 0, 0); } \
        else __builtin_amdgcn_global_load_lds((const unsigned*)((abase) + (size_t)(((h) * 128 + _i * 64) * RSB) + vA), (PG8_LAS unsigned*)(lds + (bufoff) + ldsw + _i * 8192), 16, 0, 0); } } while (0)
#define PG8_LDA(dst, b, h) do { _Pragma("unroll") for (int m = 0; m < 4; ++m) _Pragma("unroll") for (int k = 0; k < 2; ++k) dst[m][k] = *(const PG8_LAS bf16x8*)(lds + PG8_SA(b, h) + aoff + m * 2048 + k * 1024); } while (0)
#define PG8_LDB(dst, b, h) do { _Pragma("unroll") for (int n = 0; n < 2; ++n) _Pragma("unroll") for (int k = 0; k < 2; ++k) dst[n][k] = *(const PG8_LAS bf16x8*)(lds + PG8_SB(b, h) + boff + n * 2048 + k * 1024); } while (0)
#define PG8_MMA(ai, bj, At, Bt) do { __builtin_amdgcn_s_setprio(1); _Pragma("unroll") for (int m = 0; m < 4; ++m) _Pragma("unroll") for (int n = 0; n < 2; ++n) { \
        if constexpr (F8) { mfma_f8(acc[ai][bj][m][n], cat16(Bt[n][0], Bt[n][1]), cat16(At[m][0], At[m][1]), sc127); } \
        else { _Pragma("unroll") for (int k = 0; k < 2; ++k) acc[ai][bj][m][n] = __builtin_amdgcn_mfma_f32_16x16x32_bf16(Bt[n][k], At[m][k], acc[ai][bj][m][n], 0, 0, 0); } } \
        __builtin_amdgcn_s_setprio(0); } while (0)
#define PG8_MMA1(ai) do { if constexpr (Prob::NARROWS) { if (!narrow) PG8_MMA(ai, 1, At, B1); } else PG8_MMA(ai, 1, At, B1); } while (0)
#define PG8_WAIT_V(n) asm volatile("s_waitcnt vmcnt(" #n ")" ::: "memory")
#define PG8_WAIT_VN(n) asm volatile("s_waitcnt vmcnt(%0)" :: "n"(n) : "memory")
#define PG8_WAIT_L(n) asm volatile("s_waitcnt lgkmcnt(" #n ")" ::: "memory")
#define PG8_BAR __builtin_amdgcn_s_barrier()
#define PG8_SCHED __builtin_amdgcn_sched_barrier(0)
    Unit cur, nxt; int ui = 0;
    if (!P.next(0, cur)) return;
    f32x4 acc[2][2][4][2];
#pragma unroll
    for (int a = 0; a < 2; ++a)
#pragma unroll
        for (int b = 0; b < 2; ++b)
#pragma unroll
            for (int m = 0; m < 4; ++m)
#pragma unroll
                for (int n = 0; n < 2; ++n) acc[a][b][m][n] = (f32x4){0.f, 0.f, 0.f, 0.f};
    bf16x8 At[4][2], B0[2][2], B1[2][2];
    constexpr bool GATH = Prob::GATHERS;
    int sc127 = 127; asm volatile("" : "+v"(sc127));
    unsigned tc[2] = {0u, 0u}, tn[2] = {0u, 0u};
    constexpr bool PF = Prob::PREFETCH;
    cur.slot = 0;
    if constexpr (PF) { P.pf_issue(cur, 0, wid, lane, lds); PG8_WAIT_V(0); PG8_BAR; asm volatile("" ::: "memory"); }
    if constexpr (GATH) P.a_tok(cur, tid, tc, lds);
    const char* cA = P.a_ptr(cur);
    const char* cB = P.b_ptr(cur);
    PG8_STAGE_B(PG8_SB(0, 0), cB); PG8_STAGE_B(PG8_SB(0, 1), cB + hstep); PG8_STAGE_A(PG8_SA(0, 0), cA, tc, 0); PG8_STAGE_A(PG8_SA(0, 1), cA, tc, 1);
    if (wr == 1) PG8_BAR;
    PG8_WAIT_V(2); PG8_BAR;
    PG8_STAGE_B(PG8_SB(1, 0), cB + kstep); PG8_STAGE_A(PG8_SA(1, 0), cA + kstep, tc, 0); PG8_STAGE_B(PG8_SB(1, 1), cB + hstep + kstep); PG8_STAGE_A(PG8_SA(1, 1), cA + kstep, tc, 1);
    PG8_WAIT_V(0); PG8_BAR;
    bool relax = false;
    for (;;) {
        const bool narrow = Prob::NARROWS && P.narrow(cur);
        const bool has_next = P.next(ui + 1, nxt);
        const char* nB = cB; const char* nA = cA;
        nxt.slot = (ui + 1) % 3;
        if (has_next) { if constexpr (PF) P.pf_issue(nxt, nxt.slot, wid, lane, lds); nA = P.a_ptr(nxt); nB = P.b_ptr(nxt); }
        tn[0] = tc[0]; tn[1] = tc[1];
        {
            const char* a2 = cA + (size_t)2 * kstep; const char* a3 = a2 + kstep; const char* b2 = cB + (size_t)2 * kstep; const char* b3 = b2 + kstep;
            PG8_LDB(B0, 0, 0); PG8_LDB(B1, 0, 1); PG8_SCHED; PG8_LDA(At, 0, 0);
            if (relax) PG8_WAIT_VN(8 + NST); else PG8_WAIT_V(8);
            PG8_WAIT_L(0); PG8_BAR; PG8_MMA(0, 0, At, B0); PG8_MMA1(0); PG8_BAR; PG8_SCHED;
            PG8_LDA(At, 0, 1); PG8_STAGE_B(PG8_SB(0, 0), b2); PG8_STAGE_B(PG8_SB(0, 1), b2 + hstep); PG8_STAGE_A(PG8_SA(0, 0), a2, tc, 0);
            if (relax) PG8_WAIT_VN(8 + NST); else PG8_WAIT_V(8);
            PG8_WAIT_L(0); PG8_BAR; PG8_MMA(1, 0, At, B0); PG8_MMA1(1); PG8_BAR; PG8_SCHED;
            PG8_LDB(B0, 1, 0); PG8_LDB(B1, 1, 1); PG8_SCHED; PG8_LDA(At, 1, 0); PG8_STAGE_A(PG8_SA(0, 1), a2, tc, 1);
            if (relax) PG8_WAIT_VN(8 + NST); else PG8_WAIT_V(8);
            PG8_WAIT_L(0); PG8_BAR; PG8_MMA(0, 0, At, B0); PG8_MMA1(0); PG8_BAR; PG8_SCHED;
            PG8_LDA(At, 1, 1); PG8_STAGE_B(PG8_SB(1, 0), b3); PG8_STAGE_B(PG8_SB(1, 1), b3 + hstep); PG8_STAGE_A(PG8_SA(1, 0), a3, tc, 0);
            if (relax) PG8_WAIT_VN(8); else PG8_WAIT_V(8);
            PG8_WAIT_L(0); PG8_BAR; PG8_MMA(1, 0, At, B0); PG8_MMA1(1); PG8_BAR; PG8_SCHED;
        }
#pragma unroll 1
        for (int t = 2; t < nt; t += 2) {
            const bool last = (t == nt - 2);
            if constexpr (GATH) { if (t == nt - 4 && has_next) P.a_tok(nxt, tid, tn, lds); }
            const char* a1 = cA + (size_t)(t + 1) * kstep;
            const char* a2 = last ? nA : cA + (size_t)(t + 2) * kstep; const char* a3 = a2 + kstep;
            const char* b2 = last ? nB : cB + (size_t)(t + 2) * kstep; const char* b3 = b2 + kstep;
            PG8_LDB(B0, 0, 0); PG8_LDB(B1, 0, 1); PG8_SCHED; PG8_LDA(At, 0, 0); PG8_STAGE_A(PG8_SA(1, 1), a1, tc, 1);
            PG8_WAIT_V(8); PG8_WAIT_L(0); PG8_BAR; PG8_MMA(0, 0, At, B0); PG8_MMA1(0); PG8_BAR; PG8_SCHED;
            PG8_LDA(At, 0, 1); PG8_STAGE_B(PG8_SB(0, 0), b2); PG8_STAGE_B(PG8_SB(0, 1), b2 + hstep); { unsigned t2[2] = {last ? tn[0] : tc[0], last ? tn[1] : tc[1]}; PG8_STAGE_A(PG8_SA(0, 0), a2, t2, 0); }
            PG8_WAIT_V(8); PG8_WAIT_L(0); PG8_BAR; PG8_MMA(1, 0, At, B0); PG8_MMA1(1); PG8_BAR; PG8_SCHED;
            PG8_LDB(B0, 1, 0); PG8_LDB(B1, 1, 1); PG8_SCHED; PG8_LDA(At, 1, 0); { unsigned t2[2] = {last ? tn[0] : tc[0], last ? tn[1] : tc[1]}; PG8_STAGE_A(PG8_SA(0, 1), a2, t2, 1); }
            PG8_WAIT_V(8); PG8_WAIT_L(0); PG8_BAR; PG8_MMA(0, 0, At, B0); PG8_MMA1(0); PG8_BAR; PG8_SCHED;
            PG8_LDA(At, 1, 1); PG8_STAGE_B(PG8_SB(1, 0), b3); PG8_STAGE_B(PG8_SB(1, 1), b3 + hstep); { unsigned t2[2] = {last ? tn[0] : tc[0], last ? tn[1] : tc[1]}; PG8_STAGE_A(PG8_SA(1, 0), a3, t2, 0); }
            PG8_WAIT_V(8); PG8_WAIT_L(0); PG8_BAR; PG8_MMA(1, 0, At, B0); PG8_MMA1(1); PG8_BAR; PG8_SCHED;
        }
        PG8_STAGE_A(PG8_SA(1, 1), nA + kstep, tn, 1);
        if constexpr (ALIGN_EPI) { if (wr == 0) PG8_BAR; }
        E(acc, cur, wr, wc, fr, fq);
        if (!has_next) break;
        relax = NST > 0 && E.full(cur, wc);
#pragma unroll
        for (int a = 0; a < 2; ++a)
#pragma unroll
            for (int b = 0; b < 2; ++b)
#pragma unroll
                for (int m = 0; m < 4; ++m)
#pragma unroll
                    for (int n = 0; n < 2; ++n) acc[a][b][m][n] = (f32x4){0.f, 0.f, 0.f, 0.f};
        cur = nxt; cB = nB; cA = nA; ++ui; tc[0] = tn[0]; tc[1] = tn[1];
        if constexpr (ALIGN_EPI) { if (wr == 1) PG8_BAR; }
    }
    PG8_WAIT_V(0);
    if constexpr (!ALIGN_EPI) { if (wr == 0) PG8_BAR; }
    PG8_BAR;
#undef PG8_SA
#undef PG8_SB
#undef PG8_STAGE_A
#undef PG8_STAGE_B
#undef PG8_LDA
#undef PG8_LDB
#undef PG8_MMA
#undef PG8_WAIT_V
#undef PG8_MMA1
#undef PG8_WAIT_VN
#undef PG8_WAIT_L
#undef PG8_BAR
#undef PG8_SCHED
}
}

#define XB_TMO      128
#define XB_XCNT(j)  (256  + 64 * (j))
#define XB_XSUB(j)  (1280 + 64 * (j))
#define XB_XGEN(j)  (2304 + 64 * (j))
#define XB_TOP      3328
#define XB_TOPGEN   3392
#define XCD_BAR_WORDS 3456
#define XB_SPIN_CAP (1u << 18)
__device__ __forceinline__ unsigned xb_ld(unsigned* p)              { return __hip_atomic_load(p, __ATOMIC_RELAXED, __HIP_MEMORY_SCOPE_AGENT); }
__device__ __forceinline__ unsigned xb_add(unsigned* p, unsigned v) { return __hip_atomic_fetch_add(p, v, __ATOMIC_RELAXED, __HIP_MEMORY_SCOPE_AGENT); }
__device__ __forceinline__ unsigned xb_xcc_id() { return (unsigned)__builtin_amdgcn_s_getreg((3 << 11) | 20) & 0xFu; }
#define XB_SPIN(cond, bar) do { unsigned _sp = 0; while (cond) { __builtin_amdgcn_s_sleep(1); \
    if ((++_sp & 255u) == 0u) { if (xb_ld(&(bar)[XB_TMO])) break; if (_sp > XB_SPIN_CAP) { atomicAdd(&(bar)[XB_TMO], 1u); break; } } } } while (0)
struct XcdBarrier { unsigned* bar; unsigned x; volatile LAS unsigned* st; };
__device__ __forceinline__ XcdBarrier xcd_barrier_post(unsigned* bar, volatile LAS unsigned* st) {
    XcdBarrier b; b.bar = bar; b.x = xb_xcc_id(); b.st = st;
    if (threadIdx.x == 0) (void)xb_add(&bar[XB_XCNT(b.x)], 1u);
    return b;
}
__device__ __forceinline__ void xcd_barrier_complete(unsigned* bar, unsigned x, unsigned& nloc, unsigned& nx) {
    const unsigned G = gridDim.x * gridDim.y * gridDim.z;
    unsigned sum, cnt, mine, sp = 0u;
    for (;;) {
        sum = 0u; cnt = 0u; mine = 0u;
#pragma unroll
        for (unsigned j = 0; j < 16; ++j) { const unsigned c = xb_ld(&bar[XB_XCNT(j)]); sum += c; cnt += (c > 0u) ? 1u : 0u; mine = (j == x) ? c : mine; }
        if (sum == G) break;
        __builtin_amdgcn_s_sleep(1);
        if ((++sp & 255u) == 0u) { if (xb_ld(&bar[XB_TMO])) break; if (sp > XB_SPIN_CAP) { atomicAdd(&bar[XB_TMO], 1u); break; } }
    }
    nloc = mine > 0u ? mine : 1u; nx = cnt > 0u ? cnt : 1u;
}
__device__ __forceinline__ void xcd_barrier(const XcdBarrier& b) {
    asm volatile("s_waitcnt vmcnt(0)" ::: "memory");
    __syncthreads();
    if (threadIdx.x == 0) {
        unsigned* bar = b.bar;
        __builtin_amdgcn_s_waitcnt(0);
        unsigned nloc = b.st[0], nx = b.st[1];
        if (nloc == 0u) { xcd_barrier_complete(bar, b.x, nloc, nx); b.st[0] = nloc; b.st[1] = nx; }
        const unsigned old = xb_add(&bar[XB_XSUB(b.x)], 1u);
        const unsigned gen = old / nloc;
        if (old + 1u == (gen + 1u) * nloc) {
            __builtin_amdgcn_fence(__ATOMIC_RELEASE, "agent");
            asm volatile("s_waitcnt vmcnt(0)" ::: "memory");
            const unsigned og = xb_add(&bar[XB_TOP], 1u);
            const unsigned tg = og / nx;
            if (og + 1u == (tg + 1u) * nx) xb_add(&bar[XB_TOPGEN], 1u);
            else XB_SPIN(xb_ld(&bar[XB_TOPGEN]) == tg, bar);
            __builtin_amdgcn_fence(__ATOMIC_ACQUIRE, "agent");
            xb_add(&bar[XB_XGEN(b.x)], 1u);
            asm volatile("s_waitcnt vmcnt(0)" ::: "memory");
        } else {
            XB_SPIN(xb_ld(&bar[XB_XGEN(b.x)]) == gen, bar);
            __builtin_amdgcn_fence(__ATOMIC_ACQUIRE, "agent");
            asm volatile("s_waitcnt vmcnt(0)" ::: "memory");
        }
    }
    __syncthreads();
}

namespace pg8 {
struct ProbDense {
    static constexpr bool FP8 = false, GATHERS = false, PREFETCH = false, NARROWS = false; const char* A; const char* Bt; int nM, nN, G, c;
    __device__ __forceinline__ bool narrow(const Unit&) const { return false; }
    __device__ __forceinline__ bool next(int i, Unit& u) const { u.g = 0; u.r0 = 0; return order_next(i, G, c, nM, nN, u.pm, u.pn); }
    __device__ __forceinline__ const char* a_ptr(const Unit& u) const { return A + (size_t)u.pm * (256 * 2048); }
    __device__ __forceinline__ void a_tok(const Unit&, int, unsigned (&)[2], PG8_LAS unsigned char*) const {}
    __device__ __forceinline__ const char* b_ptr(const Unit& u) const { return Bt + (size_t)u.pn * (256 * 2048); }
};
struct ProbIn {
    static constexpr bool FP8 = false, GATHERS = false, PREFETCH = false; const char* A; const char* Bt; int G, c;
    __device__ __forceinline__ bool next(int i, Unit& u) const { u.g = 0; u.r0 = 0;
        const int L = i * G + c;
        if (L < 256 * 13) return order_next(i, G, c, 256, 13, u.pm, u.pn);
        const int L2 = L - 256 * 13; if (L2 >= 32 * 7) return false;
        const int k = L2 % 7; u.pm = 256 + L2 / 7; u.pn = k < 3 ? k + 1 : k < 6 ? k + 4 : 12; return true; }
    __device__ __forceinline__ const char* a_ptr(const Unit& u) const { return A + (size_t)u.pm * (256 * 2048); }
    __device__ __forceinline__ void a_tok(const Unit&, int, unsigned (&)[2], PG8_LAS unsigned char*) const {}
    __device__ __forceinline__ const char* b_ptr(const Unit& u) const { return Bt + (size_t)u.pn * (256 * 2048); }
};
template <bool F8> struct ProbIn2 {
    static constexpr bool FP8 = F8, GATHERS = false, PREFETCH = false, NARROWS = !F8; const char* A; const char* Bt; int G, c;
    __device__ __forceinline__ bool narrow(const Unit& u) const { return u.pn == 12; }
    static constexpr int NT = F8 ? 8 : 5, NC = F8 ? 4 : 3, RS = F8 ? 1024 : 2048;
    __device__ __forceinline__ bool next(int i, Unit& u) const { u.g = 0; u.r0 = 0;
        const int L = i * G + c; int k;
        if (L < 256 * NT) { if (!order_next(i, G, c, 256, NT, u.pm, k)) return false; u.pn = F8 ? (k < 4 ? 2 + k : 4 + k) : (k < 2 ? k : k < 4 ? k + 4 : 12); return true; }
        const int L2 = L - 256 * NT; if (L2 >= 32 * NC) return false;
        k = L2 % NC; u.pm = 256 + L2 / NC; u.pn = F8 ? (k < 2 ? 2 + k : 6 + k) : (k == 0 ? 1 : k == 1 ? 7 : 12); return true; }
    __device__ __forceinline__ const char* a_ptr(const Unit& u) const { return A + (size_t)u.pm * (256 * RS); }
    __device__ __forceinline__ void a_tok(const Unit&, int, unsigned (&)[2], PG8_LAS unsigned char*) const {}
    __device__ __forceinline__ const char* b_ptr(const Unit& u) const { return Bt + (size_t)u.pn * (256 * RS); }
};
template <bool GATHER> struct ProbMoe {
    static constexpr bool FP8 = true, GATHERS = GATHER, PREFETCH = true, NARROWS = false;
    __device__ __forceinline__ bool narrow(const Unit&) const { return false; }
    const char* A; const char* W; const int* ltok; const LAS int* tab; const LAS int* cnts; int nM, nN, G, c; size_t wstride; const float* bias; const float* lp;
    __device__ __forceinline__ bool next(int i, Unit& u) const {
        if (!order_next(i, G, c, nM, nN, u.pm, u.pn, GATHER ? 4 : 8)) return false;
        const int e = tab[u.pm]; u.g = e >> 16; u.r0 = (e & 0xffff) * 256; return true;
    }
    __device__ __forceinline__ const char* a_ptr(const Unit& u) const { return GATHER ? A : A + (size_t)u.pm * (256 * 1024); }
    __device__ __forceinline__ void pf_issue(const Unit& u, int slot, int wid, int lane, PG8_LAS unsigned char* lds) const {
        PG8_LAS unsigned char* sl = lds + PF_OFF + slot * PF_SLOT;
        if (GATHER && wid == 0) dma16(ltok + (size_t)u.g * LCAP + u.r0 + 4 * lane, sl);
        if (wid == 1) { const float* src = GATHER ? bias + (size_t)(u.g & 31) * 2048 + (lane >> 5) * 1024 + u.pn * 128 + (lane & 31) * 4 : bias + (size_t)(u.g & 31) * 1024 + u.pn * 256 + lane * 4; dma16(src, sl + 1024); }
        if (!GATHER && wid == 2) dma16(lp + (size_t)u.g * LCAP + u.r0 + 4 * lane, sl + 2048);
    }
    __device__ __forceinline__ void a_tok(const Unit& u, int tid, unsigned (&tk)[2], PG8_LAS unsigned char* lds) const {
        if constexpr (GATHER) {
            int R, C; stage_rc(tid * 16, R, C); (void)C; const int cnt = cnts[u.g]; const PG8_LAS int* T = (const PG8_LAS int*)(lds + PF_OFF + u.slot * PF_SLOT);
#pragma unroll
            for (int h = 0; h < 2; ++h) { unsigned t[2];
#pragma unroll
                for (int i = 0; i < 2; ++i) { const int row = h * 128 + i * 64 + R; const int tok = T[row]; t[i] = (u.r0 + row < cnt) ? (unsigned)tok : 0u; }
                tk[h] = t[0] | (t[1] << 16); }
        }
    }
    __device__ __forceinline__ const char* b_ptr(const Unit& u) const { return W + (size_t)(u.g & 31) * wstride + (size_t)u.pn * (256 * 1024); }
};

struct EpiZ {
    static constexpr bool PERM = true; static constexpr int CMAP = 0, NST = 16; bf16_t* O; float sc;
    __device__ __forceinline__ bool full(const Unit& u, int) const { return u.pn != 12; }
    __device__ __forceinline__ void operator()(const f32x4 (&acc)[2][2][4][2], const Unit& u, int wr, int wc, int fr, int fq) const {
        const int row0 = u.pm * BM + wr * 64 + fr, pn = u.pn;
        int kind, f, hb;
        if (pn == 0) { kind = 0; f = F_MLQ; hb = 0; } else if (pn == 1) { kind = 0; f = F_MLK; hb = 0; } else if (pn == 6) { kind = 0; f = F_GQ; hb = 0; } else if (pn == 7) { kind = 0; f = F_GK; hb = 0; }
        else if (pn < 4) { kind = 1; f = F_MLV; hb = 2 * (pn - 2); } else if (pn < 6) { kind = 1; f = F_MLO; hb = 2 * (pn - 4); } else if (pn < 10) { kind = 1; f = F_GV; hb = 2 * (pn - 8); }
        else if (pn < 12) { kind = 1; f = F_GG; hb = 2 * (pn - 10); } else { kind = 2; f = 0; hb = 0; }
#pragma unroll
        for (int bj = 0; bj < 2; ++bj) {
            bf16_t* base; int pitch; bool ok = true;
            if (kind == 0) { base = O + plane64(f, 2 * bj + (wc >> 1)) + (wc & 1) * 32 + 8 * fq; pitch = 64; }
            else if (kind == 1) { base = O + plane128(f, hb + bj) + wc * 32 + 8 * fq; pitch = 128; }
            else { base = O + Z_MISC + wc * 32 + 8 * fq; pitch = 64; ok = (bj == 0) && (wc < 2); }
            if (ok) {
#pragma unroll
                for (int ai = 0; ai < 2; ++ai)
#pragma unroll
                    for (int m = 0; m < 4; ++m) { const f32x4 v0 = acc[ai][bj][m][0] * sc, v1 = acc[ai][bj][m][1] * sc;
                        u32x4 w; w.x = cvt_pk_bf16(v0[0], v0[1]); w.y = cvt_pk_bf16(v0[2], v0[3]); w.z = cvt_pk_bf16(v1[0], v1[1]); w.w = cvt_pk_bf16(v1[2], v1[3]);
                        *(u32x4*)(base + (size_t)(row0 + ai * HALF + m * 16) * pitch) = w; } }
        }
    }
};
struct EpiX1 {
    static constexpr bool PERM = true; static constexpr int CMAP = 0, NST = 16; const float* x; const float* pos; const float* mods; bf16_t* O;
    __device__ __forceinline__ bool full(const Unit&, int) const { return true; }
    __device__ __forceinline__ void operator()(const f32x4 (&acc)[2][2][4][2], const Unit& u, int wr, int wc, int fr, int fq) const {
        const int row0 = u.pm * BM + wr * 64 + fr, col0 = u.pn * BM + wc * 32 + 8 * fq;
        const int b = (u.pm * BM) >> 11;
        const float* g1 = mods + (size_t)b * 6144 + 2 * 1024 + col0;
        f32x4 gv[2][2];
#pragma unroll
        for (int bj = 0; bj < 2; ++bj)
#pragma unroll
            for (int n = 0; n < 2; ++n) gv[bj][n] = *(const f32x4*)(g1 + bj * HALF + 4 * n);
#pragma unroll
        for (int ai = 0; ai < 2; ++ai)
#pragma unroll
            for (int m = 0; m < 4; ++m) { const int row = row0 + ai * HALF + m * 16; const size_t off = (size_t)row * D + col0; const float* pp = pos + (size_t)(row & (T - 1)) * D + col0;
#pragma unroll
                for (int bj = 0; bj < 2; ++bj) { f32x4 r[2];
#pragma unroll
                    for (int n = 0; n < 2; ++n) { const f32x4 xv = *(const f32x4*)(x + off + bj * HALF + 4 * n); const f32x4 pv = *(const f32x4*)(pp + bj * HALF + 4 * n); r[n] = xv + pv + gv[bj][n] * acc[ai][bj][m][n]; }
                    u32x4 w; w.x = cvt_pk_bf16(r[0][0], r[0][1]); w.y = cvt_pk_bf16(r[0][2], r[0][3]); w.z = cvt_pk_bf16(r[1][0], r[1][1]); w.w = cvt_pk_bf16(r[1][2], r[1][3]);
                    *(u32x4*)(O + off + bj * HALF) = w; }
                if (m & 1) asm volatile("" ::: "memory"); }
    }
};
__device__ __forceinline__ unsigned pk4_fp8(float a, float b, float c, float d) { int w = 0; w = __builtin_amdgcn_cvt_pk_fp8_f32(a, b, w, false); w = __builtin_amdgcn_cvt_pk_fp8_f32(c, d, w, true); return (unsigned)w; }
constexpr float WSC = 32.0f, WSCI = 1.0f / 32.0f;
struct EpiGU {
    static constexpr bool PERM = true; static constexpr int CMAP = 0, NST = 8; unsigned char* O; PG8_LAS unsigned char* pf;
    __device__ __forceinline__ bool full(const Unit&, int) const { return true; }
    __device__ __forceinline__ void operator()(const f32x4 (&acc)[2][2][4][2], const Unit& u, int wr, int wc, int fr, int fq) const {
        const int row0 = u.pm * BM + wr * 64 + fr, j0 = u.pn * HALF + wc * 32 + 8 * fq;
        const PG8_LAS float* bg = (const PG8_LAS float*)(pf + u.slot * PF_SLOT + 1024) + wc * 32 + 8 * fq;
        f32x4 bgv[2], buv[2];
#pragma unroll
        for (int n = 0; n < 2; ++n) { bgv[n] = *(const PG8_LAS f32x4*)(bg + 4 * n); buv[n] = *(const PG8_LAS f32x4*)(bg + 128 + 4 * n) + 1.0f; }
        typedef float f32x2 __attribute__((ext_vector_type(2)));
        constexpr float NC = -1.702f * 1.44269504088896f;
#pragma unroll
        for (int ai = 0; ai < 2; ++ai)
#pragma unroll
            for (int m = 0; m < 4; ++m) { unsigned char* rowp = O + (size_t)(row0 + ai * HALF + m * 16) * DE + j0; float r[8];
#pragma unroll
                for (int n = 0; n < 2; ++n) { const f32x4 gt = acc[ai][0][m][n] * WSCI + bgv[n], up = acc[ai][1][m][n] * WSCI + buv[n];
#pragma unroll
                    for (int i = 0; i < 4; i += 2) { const f32x2 g = {fminf(gt[i], 7.0f), fminf(gt[i + 1], 7.0f)}, uu = {fminf(fmaxf(up[i], -6.0f), 8.0f), fminf(fmaxf(up[i + 1], -6.0f), 8.0f)};
                        const f32x2 t = g * NC; const f32x2 d = (f32x2){__builtin_amdgcn_exp2f(t[0]), __builtin_amdgcn_exp2f(t[1])} + 1.0f;
                        const f32x2 rc = {__builtin_amdgcn_rcpf(d[0]), __builtin_amdgcn_rcpf(d[1])}; const f32x2 o = (g * uu) * rc; r[4 * n + i] = o[0]; r[4 * n + i + 1] = o[1]; } }
                u32x2 w; w.x = pk4_fp8(r[0], r[1], r[2], r[3]); w.y = pk4_fp8(r[4], r[5], r[6], r[7]);
                *(u32x2*)rowp = w; }
    }
};
constexpr float YSC = 16.0f, YSCI = 1.0f / 16.0f;
#ifndef YST_NT
#define YST_NT 0
#endif
#if YST_NT
#define YST(p_, w_) __builtin_nontemporal_store((w_), (u32x4*)(p_))
#else
#define YST(p_, w_) (*(u32x4*)(p_) = (w_))
#endif
struct EpiDown {
    static constexpr bool PERM = true; static constexpr int CMAP = 1, NST = 8; unsigned char* O; PG8_LAS unsigned char* pf; const LAS int* cnts;
    __device__ __forceinline__ bool full(const Unit&, int) const { return true; }
    __device__ __forceinline__ void operator()(const f32x4 (&acc)[2][2][4][2], const Unit& u, int wr, int wc, int fr, int fq) const {
        const int row0 = u.pm * BM + wr * 64 + fr, col0 = u.pn * BM + wc * 64 + 16 * fq;
        const PG8_LAS float* bb = (const PG8_LAS float*)(pf + u.slot * PF_SLOT + 1024) + wc * 64 + 16 * fq; const PG8_LAS float* lpl = (const PG8_LAS float*)(pf + u.slot * PF_SLOT + 2048); const int cnt = cnts[u.g];
        f32x4 bv[2][2]; float pv[2][4];
#pragma unroll
        for (int ai = 0; ai < 2; ++ai)
#pragma unroll
            for (int m = 0; m < 4; ++m) pv[ai][m] = lpl[wr * 64 + fr + ai * HALF + m * 16];
#pragma unroll
        for (int bj = 0; bj < 2; ++bj)
#pragma unroll
            for (int n = 0; n < 2; ++n) bv[bj][n] = *(const PG8_LAS f32x4*)(bb + bj * 8 + 4 * n);
#pragma unroll
        for (int ai = 0; ai < 2; ++ai)
#pragma unroll
            for (int m = 0; m < 4; ++m) { const int rt = wr * 64 + fr + ai * HALF + m * 16; const float p = (u.r0 + rt < cnt) ? pv[ai][m] * YSC : 0.f;
                unsigned char* rowp = O + (size_t)(row0 + ai * HALF + m * 16) * D + col0; u32x4 w;
#pragma unroll
                for (int bj = 0; bj < 2; ++bj) { const f32x4 v0 = (acc[ai][bj][m][0] * WSCI + bv[bj][0]) * p, v1 = (acc[ai][bj][m][1] * WSCI + bv[bj][1]) * p;
                    w[2 * bj] = pk4_fp8(v0[0], v0[1], v0[2], v0[3]); w[2 * bj + 1] = pk4_fp8(v1[0], v1[1], v1[2], v1[3]); }
                YST(rowp, w); }
    }
};
}

struct Args { const float* in[24]; float* out; unsigned char* ws; int ph_lo, ph_hi, li, pad; };
enum { I_X = 0, I_C, I_CTX, I_CCTX, I_ADAW, I_ADAB, I_N1G, I_WIN, I_CONVW, I_CONVB, I_MLGB, I_MLNG, I_GW2, I_GGB, I_GNG, I_WOUT, I_N2G, I_RW, I_RB, I_WGU, I_BGU, I_WD, I_BD, I_FNG };

__device__ __forceinline__ void transpose_item(const float* W, int N, bf16* WT, int k0, int n0, int orow0, LAS float* scr, int lane, int orow1 = -1) {
    if (orow1 < 0) orow1 = orow0 + 16;
    const int n = n0 + (lane & 31);
#pragma unroll 8
    for (int i = 0; i < 32; ++i) { const int kk = 2 * i + (lane >> 5); float v = 0.f; if (n < N) v = W[(size_t)(k0 + kk) * N + n]; scr[kk * 33 + (lane & 31)] = v; }
    LDS_WAIT(); asm volatile("" ::: "memory");
    const int c = lane & 7;
#pragma unroll
    for (int j = 0; j < 4; ++j) { const int nn = (lane >> 3) + 8 * j; const LAS float* s = scr + (8 * c) * 33 + nn;
        u32x4 o; o.x = pk2(s[0 * 33], s[1 * 33]); o.y = pk2(s[2 * 33], s[3 * 33]); o.z = pk2(s[4 * 33], s[5 * 33]); o.w = pk2(s[6 * 33], s[7 * 33]);
        *(u32x4*)(WT + (size_t)(nn < 16 ? orow0 + nn : orow1 + nn - 16) * 1024 + k0 + 8 * c) = o; }
    LDS_WAIT(); asm volatile("" ::: "memory");
}

__device__ __forceinline__ void transpose_item_f8(const float* W, int N, unsigned char* WT, int k0, int n0, int orow0, float sc, LAS float* scr, int lane) {
    const int n = n0 + (lane & 31);
#pragma unroll 8
    for (int i = 0; i < 32; ++i) { const int kk = 2 * i + (lane >> 5); float v = 0.f; if (n < N) v = W[(size_t)(k0 + kk) * N + n]; scr[kk * 33 + (lane & 31)] = v * sc; }
    LDS_WAIT(); asm volatile("" ::: "memory");
    const int c = lane & 7;
#pragma unroll
    for (int j = 0; j < 4; ++j) { const int nn = (lane >> 3) + 8 * j; const LAS float* s = scr + (8 * c) * 33 + nn;
        u32x2 o; o.x = pg8::pk4_fp8(s[0 * 33], s[1 * 33], s[2 * 33], s[3 * 33]); o.y = pg8::pk4_fp8(s[4 * 33], s[5 * 33], s[6 * 33], s[7 * 33]);
        *(u32x2*)(WT + (size_t)(orow0 + nn) * 1024 + k0 + 8 * c) = o; }
    LDS_WAIT(); asm volatile("" ::: "memory");
}

__host__ __device__ constexpr int zperm(int n) { return n < 1536 ? n : n < 1552 ? 3072 + (n - 1536) : n < 3088 ? n - 16 : n; }
__device__ __forceinline__ void p0_prologue(const Args& a, LAS unsigned char* lds, int vcu, int G) {
    const int tid = threadIdx.x, lane = tid & 63, wave = __builtin_amdgcn_readfirstlane(tid >> 6);
    unsigned char* ws = a.ws;
    {
        float* mods = (float*)(ws + WS_MODS);
        const float* c = a.in[I_C]; const float* cc = a.in[I_CCTX]; const float* aw = a.in[I_ADAW]; const float* ab = a.in[I_ADAB];
        LAS float* sl = (LAS float*)lds + wave * 4224;
        for (int item = vcu; item < 96; item += G) {
            const int n0 = item * 64;
#pragma unroll 1
            for (int t0 = 0; t0 < 66; t0 += 22) { float cvv[22];
#pragma unroll
              for (int q = 0; q < 22; ++q) { const int t = t0 + q, k = 128 * wave + 64 * (t & 1) + lane; const float* src = (t >> 1) < 32 ? c + (t >> 1) * 1024 : cc; cvv[q] = src[k]; }
#pragma unroll
              for (int q = 0; q < 22; ++q) sl[lane + 64 * (t0 + q)] = fsilu(cvv[q]); }
            LDS_WAIT(); asm volatile("" ::: "memory");
            const int l15 = lane & 15, g = lane >> 4;
            f32x4 acc[3][4];
#pragma unroll
            for (int rt = 0; rt < 3; ++rt)
#pragma unroll
                for (int nt = 0; nt < 4; ++nt) acc[rt][nt] = (f32x4){0.f, 0.f, 0.f, 0.f};
            const float* wp = aw + (size_t)(128 * wave + 8 * g) * 6144 + n0 + l15;
            float wv[4][8], wn[4][8];
#pragma unroll
            for (int nt = 0; nt < 4; ++nt)
#pragma unroll
                for (int i = 0; i < 8; ++i) wv[nt][i] = wp[(size_t)i * 6144 + 16 * nt];
#pragma unroll 1
            for (int ks = 0; ks < 4; ++ks) {
                const int kn = ks < 3 ? ks + 1 : ks;
#pragma unroll
                for (int nt = 0; nt < 4; ++nt)
#pragma unroll
                    for (int i = 0; i < 8; ++i) wn[nt][i] = wp[(size_t)(32 * kn + i) * 6144 + 16 * nt];
                bf16x8 bh[4], bl[4];
#pragma unroll
                for (int nt = 0; nt < 4; ++nt)
#pragma unroll
                    for (int i = 0; i < 8; ++i) { const unsigned h = f2bf(wv[nt][i]); bh[nt][i] = (short)h; bl[nt][i] = (short)f2bf(wv[nt][i] - __builtin_bit_cast(float, h << 16)); }
#pragma unroll
                for (int rt = 0; rt < 3; ++rt) { const int r = 16 * rt + l15; bf16x8 ah, al;
                    f32x4 s0 = (f32x4){0.f, 0.f, 0.f, 0.f}, s1 = s0;
                    if (r < 33) { s0 = *(const LAS f32x4*)(sl + r * 128 + 32 * ks + 8 * g); s1 = *(const LAS f32x4*)(sl + r * 128 + 32 * ks + 8 * g + 4); }
#pragma unroll
                    for (int i = 0; i < 4; ++i) { const unsigned h0 = f2bf(s0[i]), h1 = f2bf(s1[i]); ah[i] = (short)h0; ah[4 + i] = (short)h1;
                        al[i] = (short)f2bf(s0[i] - __builtin_bit_cast(float, h0 << 16)); al[4 + i] = (short)f2bf(s1[i] - __builtin_bit_cast(float, h1 << 16)); }
#pragma unroll
                    for (int nt = 0; nt < 4; ++nt) { acc[rt][nt] = __builtin_amdgcn_mfma_f32_16x16x32_bf16(ah, bh[nt], acc[rt][nt], 0, 0, 0);
                        acc[rt][nt] = __builtin_amdgcn_mfma_f32_16x16x32_bf16(ah, bl[nt], acc[rt][nt], 0, 0, 0); acc[rt][nt] = __builtin_amdgcn_mfma_f32_16x16x32_bf16(al, bh[nt], acc[rt][nt], 0, 0, 0); } }
#pragma unroll
                for (int nt = 0; nt < 4; ++nt)
#pragma unroll
                    for (int i = 0; i < 8; ++i) wv[nt][i] = wn[nt][i];
            }
            __syncthreads();
            LAS float* red = (LAS float*)lds;
#pragma unroll
            for (int rt = 0; rt < 3; ++rt)
#pragma unroll
                for (int nt = 0; nt < 4; ++nt)
#pragma unroll
                    for (int j = 0; j < 4; ++j) red[(wave * 48 + 16 * rt + 4 * g + j) * 64 + 16 * nt + l15] = acc[rt][nt][j];
            __syncthreads();
            for (int idx = tid; idx < 33 * 64; idx += NTHR) { const int r = idx >> 6, l = idx & 63; float s = ab[n0 + l];
#pragma unroll
                for (int w = 0; w < 8; ++w) s += red[(w * 48 + r) * 64 + l];
                mods[(size_t)r * 6144 + n0 + l] = s; }
            __syncthreads();
        }
    }
    const int gw = vcu * NWAVES + wave, NGW = G * NWAVES;
    {
        float* pos = (float*)(ws + WS_POS);
        for (int t = gw; t < T; t += NGW) { const float rr = (float)(t >> 6), cl = (float)(t & 63);
#pragma unroll
            for (int j = 0; j < 16; ++j) { const int d = lane + 64 * j; const int q = d >> 8, i = d & 255;
                const float om = exp2f(-13.287712379549449f * (float)i * (1.0f / 256.0f));
                const float ang = ((q < 2) ? rr : cl) * om * 0.15915494309189535f;
                const float v = (q & 1) ? __builtin_amdgcn_cosf(ang) : __builtin_amdgcn_sinf(ang);
                pos[(size_t)t * D + d] = v; } }
    }
}

__device__ __forceinline__ void p1_weight_copies(const Args& a, LAS unsigned char* lds, int vcu, int G) {
    const int tid = threadIdx.x, lane = tid & 63, wave = __builtin_amdgcn_readfirstlane(tid >> 6);
    unsigned char* ws = a.ws;
    const int gw = vcu * NWAVES + wave, NGW = G * NWAVES;
    {
        LAS float* scr = (LAS float*)(lds + wave * 16384);
        bf16* wint = (bf16*)(ws + WS_WIN); bf16* woutt = (bf16*)(ws + WS_WOUT);
        constexpr int I_IN = 16 * 104, I_OUT = 16 * 32;
        for (int it = gw; it < I_IN + I_OUT; it += NGW) {
            if (it < I_IN) { const int kb = it / 104, nb = it % 104, n0 = 32 * nb;
                transpose_item(a.in[I_WIN], INW, wint, 64 * kb, n0, zperm(n0), scr, lane, zperm(n0 + 16)); }
            else { const int r = it - I_IN, kb = r / 32, nb = r % 32; transpose_item(a.in[I_WOUT], D, woutt, 64 * kb, 32 * nb, 32 * nb, scr, lane); }
        }
        for (int it = gw; it < 16 * 64; it += NGW) { const int kb = it >> 6, nb = it & 63, g0 = nb < 32 ? 512 + 32 * nb : 2048 + 32 * (nb - 32), n0 = g0 < 1536 ? g0 : g0 + 16;
            transpose_item_f8(a.in[I_WIN], INW, ws + WS_WIN8, 64 * kb, n0, g0, pg8::WSC, (LAS float*)(lds + wave * 16384), lane); }
        float* rwt = (float*)(ws + WS_RWT); const float* rw = a.in[I_RW];
        for (int idx = gw * 64 + lane; idx < 32 * 1024; idx += NGW * 64) { const int e = idx >> 10, d = idx & 1023; rwt[idx] = rw[d * 32 + e]; }
    }
}

#define P1C(lane_, j_) (8 * (lane_) + 512 * ((j_) >> 1) + 4 * ((j_) & 1))
__device__ __forceinline__ void p1_load_row(const Args& a, const float* pos, int m, int lane, f32x4 (&v)[4]) {
    if (m < NLAT) { const float* src = a.in[I_X] + (size_t)m * D; const float* pp = pos + (size_t)(m & (T - 1)) * D;
#pragma unroll
        for (int j = 0; j < 4; ++j) v[j] = *(const f32x4*)(src + P1C(lane, j)) + *(const f32x4*)(pp + P1C(lane, j)); }
    else { const float* src = a.in[I_CTX] + (size_t)((m < NTOK ? m : NTOK - 1) - NLAT) * D;
#pragma unroll
        for (int j = 0; j < 4; ++j) v[j] = *(const f32x4*)(src + P1C(lane, j)); }
}
constexpr float USC = 16.0f;
__device__ __forceinline__ void p1_norm1(const Args& a, int vcu, int G) {
    const int tid = threadIdx.x, lane = tid & 63, wave = __builtin_amdgcn_readfirstlane(tid >> 6);
    const int gw = vcu * NWAVES + wave, NGW = G * NWAVES;
    const float* mods = (const float*)(a.ws + WS_MODS); const float* pos = (const float*)(a.ws + WS_POS); const float* g1 = a.in[I_N1G];
    bf16* U = (bf16*)(a.ws + WS_U);
    f32x4 gv[4];
#pragma unroll
    for (int j = 0; j < 4; ++j) gv[j] = *(const f32x4*)(g1 + P1C(lane, j));
    const bool fast = (NGW % NB == 0) && (T % (NGW / NB) == 0);
    const int WPS = fast ? NGW / NB : 1, KL = fast ? T / WPS : 0, KT = fast ? KL + (NCTX + NGW - 1) / NGW : (NTOK + NGW - 1) / NGW;
    const int lb = fast ? (gw / WPS) * T + gw % WPS : 0;
    auto rowk = [&](int k) -> int { return fast ? (k < KL ? lb + WPS * k : NLAT + gw + NGW * (k - KL)) : gw + k * NGW; };
    f32x4 vn[2][4];
    p1_load_row(a, pos, rowk(0), lane, vn[0]); p1_load_row(a, pos, rowk(1), lane, vn[1]);
    int ccr = -1; f32x4 A[4], S[4];
    for (int k0 = 0; k0 < KT; k0 += 2) {
        f32x4 v[2][4];
#pragma unroll
        for (int r = 0; r < 2; ++r)
#pragma unroll
            for (int j = 0; j < 4; ++j) v[r][j] = vn[r][j];
        if (k0 + 2 < KT) { p1_load_row(a, pos, rowk(k0 + 2), lane, vn[0]); p1_load_row(a, pos, rowk(k0 + 3), lane, vn[1]); }
#pragma unroll
        for (int r = 0; r < 2; ++r) { const int m = rowk(k0 + r); if (k0 + r >= KT || m >= NTOK) continue;
            const int cr = m < NLAT ? (m >> 11) : 32;
            if (cr != ccr) { ccr = cr; const float* md = mods + (size_t)cr * 6144;
#pragma unroll
                for (int j = 0; j < 4; ++j) { S[j] = *(const f32x4*)(md + P1C(lane, j)); A[j] = gv[j] * (*(const f32x4*)(md + 1024 + P1C(lane, j)) + 1.0f); } }
            float s = 0.f;
#pragma unroll
            for (int j = 0; j < 4; ++j) s += (v[r][j].x * v[r][j].x + v[r][j].y * v[r][j].y) + (v[r][j].z * v[r][j].z + v[r][j].w * v[r][j].w);
            const float rr = 1.0f / sqrtf(wave_sum(s) * (1.0f / D) + EPS);
            bf16* ub = U + (size_t)m * D + 8 * lane; unsigned char* u8 = a.ws + WS_U8 + (size_t)m * D + 8 * lane;
#pragma unroll
            for (int jp = 0; jp < 2; ++jp) { u32x4 wb; u32x2 w8;
#pragma unroll
                for (int q = 0; q < 2; ++q) { const int j = 2 * jp + q; const f32x4 y = v[r][j] * rr * A[j] + S[j];
                    wb[2 * q] = pk2(y.x, y.y); wb[2 * q + 1] = pk2(y.z, y.w);
                    const f32x4 y8 = y * USC; w8[q] = pg8::pk4_fp8(y8.x, y8.y, y8.z, y8.w); }
                *(u32x4*)(ub + 512 * jp) = wb; *(u32x2*)(u8 + 512 * jp) = w8; } }
    }
}

#undef P1C
typedef short v4i16_t __attribute__((ext_vector_type(4)));
__device__ __forceinline__ s16x4 trr(const LAS unsigned char* p) { return __builtin_bit_cast(s16x4, __builtin_amdgcn_ds_read_tr16_b64_v4i16((LAS v4i16_t*)p)); }
__device__ __forceinline__ bf16x8 cat8(s16x4 lo, s16x4 hi) { return __builtin_shufflevector(lo, hi, 0, 1, 2, 3, 4, 5, 6, 7); }
#define MFMA16(a, b, c) __builtin_amdgcn_mfma_f32_16x16x32_bf16((a), (b), (c), 0, 0, 0)
constexpr int PQK = 144, PV = 272;
__device__ __forceinline__ int vswz(int r) { return ((r & 3) << 2) | ((r >> 2) & 3); }
__device__ __forceinline__ float lane_scan(float x, int lane, int rev) {
#pragma unroll
    for (int o = 1; o < 64; o <<= 1) { const float up = __shfl_up(x, o), dn = __shfl_down(x, o); if (rev) { if (lane + o < 64) x += dn; } else { if (lane >= o) x += up; } }
    return x;
}
__device__ __forceinline__ u32x4 ldz8(const bf16* Z, int segbase, int seglen, int t, int col) {
    u32x4 v = (u32x4){0u, 0u, 0u, 0u};
    if (t >= 0 && t < seglen) v = *(const u32x4*)(Z + (size_t)(segbase + t) * ZW + col);
    return v;
}
__device__ __forceinline__ void conv8(const LAS unsigned char* raw, int s, int c8, const float (&cw)[3][8], const float (&cb)[8], float (&o)[8]) {
    const u32x4 a0 = *(const LAS u32x4*)(raw + (s + 0) * PQK + c8 * 16), a1 = *(const LAS u32x4*)(raw + (s + 1) * PQK + c8 * 16), a2 = *(const LAS u32x4*)(raw + (s + 2) * PQK + c8 * 16);
#pragma unroll
    for (int j = 0; j < 4; ++j) {
        const float l0 = bflo(a0[j]), h0 = bfhi(a0[j]), l1 = bflo(a1[j]), h1 = bfhi(a1[j]), l2 = bflo(a2[j]), h2 = bfhi(a2[j]);
        o[2 * j] = fsilu(cb[2 * j] + cw[0][2 * j] * l0 + cw[1][2 * j] * l1 + cw[2][2 * j] * l2);
        o[2 * j + 1] = fsilu(cb[2 * j + 1] + cw[0][2 * j + 1] * h0 + cw[1][2 * j + 1] * h1 + cw[2][2 * j + 1] * h2);
    }
}
__device__ __forceinline__ u32x4 pack8(const float (&o)[8], float s) { u32x4 w; w.x = pk2(o[0] * s, o[1] * s); w.y = pk2(o[2] * s, o[3] * s); w.z = pk2(o[4] * s, o[5] * s); w.w = pk2(o[6] * s, o[7] * s); return w; }

constexpr int P3_GRP = 73152, P3_RK = 0, P3_VT = 16896, P3_KP = 49664, P3_LR = 68096, P3_WB = 72192, P3_WBS = 320;
__device__ __forceinline__ float fast_logsigmoid(float x) { return fminf(x, 0.f) - __logf(1.0f + __expf(-fabsf(x))); }
__device__ __forceinline__ void glds16(const void* g, LAS unsigned char* l) {
    unsigned keep; const unsigned dst = (unsigned)(size_t)l;
    asm volatile("s_mov_b32 %0, m0\n\ts_mov_b32 m0, %2\n\ts_nop 0\n\tglobal_load_lds_dwordx4 %1, off\n\ts_mov_b32 m0, %0" : "=&s"(keep) : "v"(g), "s"(dst) : "memory");
}
__device__ __forceinline__ void glds16nt(const void* g, LAS unsigned char* l) {
    unsigned keep; const unsigned dst = (unsigned)(size_t)l;
    asm volatile("s_mov_b32 %0, m0\n\ts_mov_b32 m0, %2\n\ts_nop 0\n\tglobal_load_lds_dwordx4 %1, off nt\n\ts_mov_b32 m0, %0" : "=&s"(keep) : "v"(g), "s"(dst) : "memory");
}
__device__ __forceinline__ void p3_chains(const Args& a, LAS unsigned char* lds, int vcu, int G) {
    const int tid = threadIdx.x, lane = tid & 63, wave = __builtin_amdgcn_readfirstlane(tid >> 6);
    const int grp = wave >> 2, gw4 = wave & 3, gt = tid & 255;
    const int g = lane >> 4, q = (lane & 15) >> 2, p = lane & 3, l15 = lane & 15;
    const bf16* Z = (const bf16*)(a.ws + WS_Z);
    bf16* ST = (bf16*)(a.ws + WS_ST); float* NST = (float*)(a.ws + WS_NST);
    LAS unsigned char* base = lds + grp * P3_GRP;
    const int c8 = gt & 7;
    for (int pair = vcu; pair < 256; pair += G) {
        const int ch = pair * 2 + grp;
        const int h = ch & 3, dir = (ch >> 2) & 1, type = (ch >> 3) & 1, b = ch >> 4;
        const bf16* ZK = Z + plane64(type ? F_GK : F_MLK, h); const bf16* ZV = Z + plane128(type ? F_GV : F_MLV, h); const bf16* ZM = Z + Z_MISC;
        float cw[3][8], cb[8];
        {
            const float* w = a.in[I_CONVW]; const float* bb = a.in[I_CONVB]; const int chn = 256 + h * 64 + c8 * 8;
#pragma unroll
            for (int j = 0; j < 8; ++j) { cw[0][j] = w[chn + j]; cw[1][j] = w[512 + chn + j]; cw[2][j] = w[1024 + chn + j]; cb[j] = bb[chn + j]; }
        }
        const float bias_i = a.in[I_MLGB][(2 * dir) * 4 + h], bias_f = a.in[I_MLGB][(2 * dir + 1) * 4 + h];
        bf16x8 w2f; float gbd;
        {
            const int d = h * 64 + 16 * gw4 + l15; const float* w2 = a.in[I_GW2] + (size_t)dir * 16 * 256 + d;
#pragma unroll
            for (int j = 0; j < 8; ++j) { float v = 0.f; if (g < 2) v = w2[(8 * g + j) * 256]; w2f[j] = (short)f2bf(v); }
            gbd = a.in[I_GGB][dir * 256 + d];
        }
        bf16x8 onesf;
#pragma unroll
        for (int j = 0; j < 8; ++j) onesf[j] = (short)(l15 == 0 ? 0x3F80 : 0);
        f32x4 acc[4][2], accn[4];
#pragma unroll
        for (int mt = 0; mt < 4; ++mt) { accn[mt] = (f32x4){0.f, 0.f, 0.f, 0.f};
#pragma unroll
            for (int nt = 0; nt < 2; ++nt) acc[mt][nt] = (f32x4){0.f, 0.f, 0.f, 0.f}; }
        float rgi = 0.f, rgf = 0.f;
#define P3_CHUNK(j, lat_, c_, t0_, sb_, sl_) const bool lat_ = (j) >= 4; const int c_ = dir == 0 ? (lat_ ? (j) - 4 : (j)) : (lat_ ? 35 - (j) : 3 - (j)); \
        const int t0_ = 64 * c_, sb_ = lat_ ? b * T : NLAT + b * CT, sl_ = lat_ ? T : CT
        for (int it = -3; it < 36; ++it) {
            if (type == 0 && gw4 == 0) {
                const int j2 = it + 2;
                if (j2 >= 0 && j2 < 36) { LAS float* WB = (LAS float*)(base + P3_WB + (j2 % 3) * P3_WBS);
                    const float lf = fast_logsigmoid(rgf + bias_f), ig = rgi + bias_i; const float B = lane_scan(lf, lane, dir);
                    const float tot = __shfl(B, dir ? 0 : 63); WB[lane] = __expf(tot - B + ig); if (lane == 0) WB[64] = __expf(tot); }
                const int j3 = it + 3;
                if (j3 < 36) { P3_CHUNK(j3, lat3, c3, t03, sb3, sl3); (void)sl3; (void)lat3; const bf16* zr = ZM + (size_t)(sb3 + t03 + lane) * 64 + M_MLG; rgi = bf2f(zr[(2 * dir) * 4 + h]); rgf = bf2f(zr[(2 * dir + 1) * 4 + h]); }
            }
            {
                const int j2 = it + 2;
                if (j2 >= 0 && j2 < 36) { P3_CHUNK(j2, lat2, c2, t02, sb2, sl2); (void)lat2;
                    LAS unsigned char* RK = base + P3_RK + (j2 & 1) * 8448;
#pragma unroll
                    for (int i = 0; i < 2; ++i) { const int qi = gw4 + 4 * i, row = 8 * qi + (lane >> 3); int t = t02 - 1 + row; t = t < 0 ? 0 : t;
                        glds16(ZK + (size_t)(sb2 + t) * 64 + (lane & 7) * 8, RK + qi * 1024); }
                    if (gw4 == 0 && lane < 16) { const int row = 64 + (lane >> 3); int t = t02 - 1 + row; t = t >= sl2 ? sl2 - 1 : t;
                        glds16(ZK + (size_t)(sb2 + t) * 64 + (lane & 7) * 8, RK + 8192); }
                    if (type == 1 && gw4 < 2) { LAS unsigned char* LR = base + P3_LR + (j2 & 1) * 2048; const int row = 32 * gw4 + (lane >> 1);
                        glds16(ZM + (size_t)(sb2 + t02 + row) * 64 + M_LR + dir * 16 + (lane & 1) * 8, LR + gw4 * 1024); }
                }
                const int j1 = it + 1;
                if (j1 >= 0 && j1 < 36) { P3_CHUNK(j1, lat1, c1, t01, sb1, sl1); (void)lat1; (void)sl1;
                    LAS unsigned char* VT = base + P3_VT + (j1 & 1) * 16384;
#pragma unroll
                    for (int i = 0; i < 4; ++i) { const int qi = gw4 * 4 + i, row = 4 * qi + (lane >> 4);
                        glds16(ZV + (size_t)(sb1 + t01 + row) * 128 + ((lane & 15) ^ vswz(row)) * 8, VT + qi * 1024); }
                }
            }
            {
                const int j1 = it + 1;
                if (j1 >= 0 && j1 < 36) { P3_CHUNK(j1, lat1, c1, t01, sb1, sl1); (void)lat1; (void)sb1;
                    const LAS unsigned char* RK = base + P3_RK + (j1 & 1) * 8448; LAS unsigned char* KP = base + P3_KP + (j1 & 1) * 9216;
                    LAS float* WB = (LAS float*)(base + P3_WB + (j1 % 3) * P3_WBS);
                    if (type == 0) {
#pragma unroll
                        for (int pss = 0; pss < 2; ++pss) { const int s = (gt >> 3) + 32 * pss;
                            u32x4 a0 = *(const LAS u32x4*)(RK + (s + 0) * 128 + c8 * 16); const u32x4 a1 = *(const LAS u32x4*)(RK + (s + 1) * 128 + c8 * 16); u32x4 a2 = *(const LAS u32x4*)(RK + (s + 2) * 128 + c8 * 16);
                            if (t01 + s - 1 < 0) a0 = (u32x4){0u, 0u, 0u, 0u};
                            if (t01 + s + 1 >= sl1) a2 = (u32x4){0u, 0u, 0u, 0u};
                            float o[8];
#pragma unroll
                            for (int j = 0; j < 4; ++j) {
                                o[2 * j] = fsilu(cb[2 * j] + cw[0][2 * j] * bflo(a0[j]) + cw[1][2 * j] * bflo(a1[j]) + cw[2][2 * j] * bflo(a2[j]));
                                o[2 * j + 1] = fsilu(cb[2 * j + 1] + cw[0][2 * j + 1] * bfhi(a0[j]) + cw[1][2 * j + 1] * bfhi(a1[j]) + cw[2][2 * j + 1] * bfhi(a2[j])); }
                            *(LAS u32x4*)(KP + s * PQK + c8 * 16) = pack8(o, WB[s]); }
                    } else {
                        const LAS unsigned char* LR = base + P3_LR + (j1 & 1) * 2048;
                        f32x4 la[4];
#pragma unroll
                        for (int mt = 0; mt < 4; ++mt) { bf16x8 af = (bf16x8){0, 0, 0, 0, 0, 0, 0, 0}; if (g < 2) af = *(const LAS bf16x8*)(LR + (16 * mt + l15) * 32 + g * 16);
                            la[mt] = MFMA16(af, w2f, ((f32x4){gbd, gbd, gbd, gbd}));
#pragma unroll
                            for (int rg = 0; rg < 4; ++rg) la[mt][rg] = fast_logsigmoid(la[mt][rg]) * (1.0f / 16.0f); }
                        float tmt[4];
#pragma unroll
                        for (int mt = 0; mt < 4; ++mt) {
                            if (dir == 0) { la[mt][1] += la[mt][0]; la[mt][2] += la[mt][1]; la[mt][3] += la[mt][2]; }
                            else { la[mt][2] += la[mt][3]; la[mt][1] += la[mt][2]; la[mt][0] += la[mt][1]; }
                            const float tg = dir == 0 ? la[mt][3] : la[mt][0];
                            const float t0 = __shfl(tg, l15), t1 = __shfl(tg, l15 + 16), t2 = __shfl(tg, l15 + 32), t3 = __shfl(tg, l15 + 48);
                            float og;
                            if (dir == 0) og = (g > 0 ? t0 : 0.f) + (g > 1 ? t1 : 0.f) + (g > 2 ? t2 : 0.f);
                            else og = (g < 3 ? t3 : 0.f) + (g < 2 ? t2 : 0.f) + (g < 1 ? t1 : 0.f);
#pragma unroll
                            for (int rg = 0; rg < 4; ++rg) la[mt][rg] += og;
                            tmt[mt] = (t0 + t1) + (t2 + t3); }
                        const float tot = (tmt[0] + tmt[1]) + (tmt[2] + tmt[3]);
#pragma unroll
                        for (int mt = 0; mt < 4; ++mt) { float om;
                            if (dir == 0) om = (mt > 0 ? tmt[0] : 0.f) + (mt > 1 ? tmt[1] : 0.f) + (mt > 2 ? tmt[2] : 0.f);
                            else om = (mt < 3 ? tmt[3] : 0.f) + (mt < 2 ? tmt[2] : 0.f) + (mt < 1 ? tmt[1] : 0.f);
#pragma unroll
                            for (int rg = 0; rg < 4; ++rg) { const int s = 16 * mt + 4 * g + rg, d = 16 * gw4 + l15;
                                const float kv = bf2f(*(const LAS unsigned short*)(RK + (s + 1) * 128 + d * 2));
                                *(LAS unsigned short*)(KP + s * PQK + d * 2) = (unsigned short)f2bf(kv * __expf(tot - (om + la[mt][rg]))); } }
                        if (g == 0) WB[16 * gw4 + l15] = __expf(tot);
                    }
                }
            }
            if (it >= 0) { P3_CHUNK(it, lat0, c0, t00, sb0, sl0); (void)t00; (void)sb0; (void)sl0;
                const LAS unsigned char* KP = base + P3_KP + (it & 1) * 9216; const LAS unsigned char* VT = base + P3_VT + (it & 1) * 16384;
                const LAS float* WB = (const LAS float*)(base + P3_WB + (it % 3) * P3_WBS);
                if (lat0) {
                    bf16* dst = ST + ((((size_t)(type * 2 + dir) * 32 + b) * 4 + h) * 32 + c0) * 8192;
#pragma unroll
                    for (int mt = 0; mt < 4; ++mt)
#pragma unroll
                        for (int nt = 0; nt < 2; ++nt) { u32x2 w; w.x = pk2(acc[mt][nt][0], acc[mt][nt][1]); w.y = pk2(acc[mt][nt][2], acc[mt][nt][3]);
                            const int F = (((2 * gw4 + nt) * 2 + (mt >> 1)) * 64 + (2 * (mt & 1) + (g >> 1)) * 16 + l15);
                            *(u32x2*)(dst + F * 8 + (g & 1) * 4) = w; }
                    if (type == 0 && gw4 == 0 && l15 == 0) { float* nd = NST + ((((size_t)dir * 32 + b) * 4 + h) * 32 + c0) * 64;
#pragma unroll
                        for (int mt = 0; mt < 4; ++mt) *(f32x4*)(nd + 16 * mt + 4 * g) = accn[mt]; }
                }
                if (type == 0) { const float et = WB[64];
#pragma unroll
                    for (int mt = 0; mt < 4; ++mt) { accn[mt] *= et;
#pragma unroll
                        for (int nt = 0; nt < 2; ++nt) acc[mt][nt] *= et; }
                } else {
#pragma unroll
                    for (int mt = 0; mt < 4; ++mt) { const f32x4 e4 = *(const LAS f32x4*)(WB + 16 * mt + 4 * g);
#pragma unroll
                        for (int nt = 0; nt < 2; ++nt) acc[mt][nt] *= e4; }
                }
#pragma unroll
                for (int ks = 0; ks < 2; ++ks) {
                    bf16x8 af[4], bfr[2];
#pragma unroll
                    for (int mt = 0; mt < 4; ++mt) { const LAS unsigned char* pa = KP + (32 * ks + 8 * g + q) * PQK + (16 * mt + 4 * p) * 2; af[mt] = cat8(trr(pa), trr(pa + 4 * PQK)); }
#pragma unroll
                    for (int nt = 0; nt < 2; ++nt) { const int r0 = 32 * ks + 8 * g + q, ch = 4 * gw4 + 2 * nt + (p >> 1);
                        const LAS unsigned char* pb0 = VT + r0 * 256 + ((ch ^ vswz(r0)) * 16) + 8 * (p & 1); const LAS unsigned char* pb1 = VT + (r0 + 4) * 256 + ((ch ^ vswz(r0 + 4)) * 16) + 8 * (p & 1);
                        bfr[nt] = cat8(trr(pb0), trr(pb1)); }
#pragma unroll
                    for (int mt = 0; mt < 4; ++mt) {
#pragma unroll
                        for (int nt = 0; nt < 2; ++nt) acc[mt][nt] = MFMA16(af[mt], bfr[nt], acc[mt][nt]);
                        if (type == 0 && gw4 == 0) accn[mt] = MFMA16(af[mt], onesf, accn[mt]); }
                }
            }
            { const bool st = it >= 4;
              if (!st) VM_WAIT(); else if (type == 0 && gw4 == 0) asm volatile("s_waitcnt vmcnt(12)" ::: "memory"); else asm volatile("s_waitcnt vmcnt(8)" ::: "memory"); }
            BAR_LDS();
        }
#undef P3_CHUNK
    }
}

constexpr int P4_QR = 0, P4_KR = 8448, P4_LR = 16896, P4_VT = 20992, P4_CT = 37376, P4_QP = 70144, P4_KP = 88576, P4_SW = 107008, P4_H = 70144, P4_WB = 125440, P4_CW = 127488;
constexpr int P4_TS = 9216, P4_HS = 17408, PH = 272;
__device__ __forceinline__ void p4_outputs(const Args& a, LAS unsigned char* lds, int vcu, int G) {
    const int tid = threadIdx.x, lane = tid & 63, wave = __builtin_amdgcn_readfirstlane(tid >> 6);
    const int dg = wave >> 2, gw4 = wave & 3, gt = tid & 255;
    const int g = lane >> 4, q = (lane & 15) >> 2, p = lane & 3, l15 = lane & 15;
    const bf16* Z = (const bf16*)(a.ws + WS_Z);
    const bf16* ST = (const bf16*)(a.ws + WS_ST); const float* NST = (const float*)(a.ws + WS_NST);
    bf16* MG = (bf16*)(a.ws + WS_U);
    LAS unsigned char* QR = lds + P4_QR; LAS unsigned char* KR = lds + P4_KR; LAS unsigned char* LR = lds + P4_LR + dg * 2048; LAS unsigned char* VT = lds + P4_VT; LAS unsigned char* CTl = lds + P4_CT + dg * 16384;
    LAS unsigned char* QP = lds + P4_QP + dg * P4_TS; LAS unsigned char* KP = lds + P4_KP + dg * P4_TS; LAS unsigned char* SW = lds + P4_SW + dg * P4_TS;
    LAS unsigned char* Hme = lds + P4_H + dg * P4_HS;
    LAS float* CW = (LAS float*)(lds + P4_CW);
    const int c8 = gt & 7;
    for (int i = tid; i < 2048; i += NTHR) CW[i] = i < 1536 ? a.in[I_CONVW][i] : a.in[I_CONVB][i - 1536];
    if (tid < 16) CW[2048 + tid] = a.in[I_MLGB][tid];
#define P4_DEC(u_, b_, ty_, h_, c_) const int b_ = (u_) >> 8, r_##b_ = (u_) & 255, ty_ = (r_##b_ + b_) & 1, h_ = (r_##b_ >> 1) & 3, c_ = r_##b_ >> 3
#define P4_ISSUE_QK(u_) do { P4_DEC(u_, ib, ity, ih, ic); const int it0 = 64 * ic, isb = ib * T; \
        const bf16* zq = Z + plane64(ity ? F_GQ : F_MLQ, ih); const bf16* zk = Z + plane64(ity ? F_GK : F_MLK, ih); \
        { const int row = 8 * wave + (lane >> 3); int t = it0 - 1 + row; t = t < 0 ? 0 : t; const size_t so = (size_t)(isb + t) * 64 + (lane & 7) * 8; \
          glds16nt(zq + so, QR + wave * 1024); glds16nt(zk + so, KR + wave * 1024); } \
        if (wave < 2 && lane < 16) { const int row = 64 + (lane >> 3); int t = it0 - 1 + row; t = t >= T ? T - 1 : t; \
          glds16nt((wave ? zk : zq) + (size_t)(isb + t) * 64 + (lane & 7) * 8, (wave ? KR : QR) + 8192); } \
        if (gw4 < 2) { const int row = 32 * gw4 + (lane >> 1); glds16nt(Z + Z_MISC + (size_t)(isb + it0 + row) * 64 + M_LR + dg * 16 + (lane & 1) * 8, LR + gw4 * 1024); } } while (0)
#define P4_ISSUE_VC(u_) do { P4_DEC(u_, ib, ity, ih, ic); const int it0 = 64 * ic, isb = ib * T; const bf16* zv = Z + plane128(ity ? F_GV : F_MLV, ih); \
        _Pragma("unroll") for (int i = 0; i < 2; ++i) { const int qi = wave * 2 + i, row = 4 * qi + (lane >> 4); glds16nt(zv + (size_t)(isb + it0 + row) * 128 + ((lane & 15) ^ vswz(row)) * 8, VT + qi * 1024); } \
        const bf16* src = ST + ((((size_t)(ity * 2 + dg) * 32 + ib) * 4 + ih) * 32 + ic) * 8192; \
        _Pragma("unroll") for (int i = 0; i < 4; ++i) { const int qi = gw4 * 4 + i; glds16nt(src + qi * 512 + lane * 8, CTl + qi * 1024); } } while (0)
#define P4_GATES_LOAD(u_, gi_, gf_, gh_) do { P4_DEC(u_, ib, ity, ih, ic); (void)ity; const bf16* zr = Z + Z_MISC + (size_t)(ib * T + 64 * ic + lane) * 64 + M_MLG; \
        gi_ = zr[(2 * dg) * 4 + ih]; gf_ = zr[(2 * dg + 1) * 4 + ih]; gh_ = ih; } while (0)
#define P4_GATES_SCAN(slot_, gi_, gf_, gh_) do { LAS float* WBs = (LAS float*)(lds + P4_WB + ((slot_) * 2 + dg) * 512); const LAS float* GBt = (const LAS float*)(lds + P4_CW + 8192); \
        const float lf = fast_logsigmoid(bf2f(gf_) + GBt[(2 * dg + 1) * 4 + (gh_)]), gi2 = bf2f(gi_) + GBt[(2 * dg) * 4 + (gh_)]; \
        const float B = lane_scan(lf, lane, dg); WBs[lane] = __expf(B) * 0.125f; WBs[64 + lane] = __expf(gi2 - B); } while (0)
    bf16x8 w2h[4]; float gbh[4];
#pragma unroll
    for (int hh = 0; hh < 4; ++hh) { const int d = hh * 64 + 16 * gw4 + l15; const float* w2 = a.in[I_GW2] + (size_t)dg * 16 * 256 + d;
#pragma unroll
        for (int j = 0; j < 8; ++j) { float v = 0.f; if (g < 2) v = w2[(8 * g + j) * 256]; w2h[hh][j] = (short)f2bf(v); }
        gbh[hh] = a.in[I_GGB][dg * 256 + d]; }
    int u = vcu;
    if (u < 8192) {
        P4_ISSUE_QK(u); P4_ISSUE_VC(u);
    }
    VM_WAIT();
    __syncthreads();
    if (u < 8192 && gw4 == 0) { unsigned short gi, gf; int gh; P4_GATES_LOAD(u, gi, gf, gh); P4_GATES_SCAN(0, gi, gf, gh); }
    __syncthreads();
    for (int iter = 0; u < 8192; u += G, ++iter) {
        P4_DEC(u, b, type, h, c);
        const int t0 = 64 * c, segbase = b * T;
        const int un = u + G; const bool has_next = un < 8192;
        const int et = tid >> 3, evc = (tid & 7) * 16, erow = segbase + t0 + et;
        const bf16* zg = Z + plane128(type ? F_GG : F_MLO, h) + (size_t)erow * 128 + evc;
        u32x4 eg0, eg1;
        f32x4 ngv[4];
        { const float* ngm = a.in[I_MLNG]; const float* ngg = a.in[I_GNG]; asm volatile("" : "+s"(ngm), "+s"(ngg)); const float* ng = (type ? ngg : ngm) + h * 128 + evc;
#pragma unroll
          for (int j = 0; j < 4; ++j) ngv[j] = *(const f32x4*)(ng + 4 * j); }
        f32x4 nsa[2][2];
#pragma unroll
        for (int ks = 0; ks < 2; ++ks) { nsa[ks][0] = (f32x4){0.f, 0.f, 0.f, 0.f}; nsa[ks][1] = nsa[ks][0]; }
        if (type == 0 && l15 == 0) { const float* nd = NST + ((((size_t)dg * 32 + b) * 4 + h) * 32 + c) * 64;
#pragma unroll
            for (int ks = 0; ks < 2; ++ks) { nsa[ks][0] = *(const f32x4*)(nd + 32 * ks + 8 * g); nsa[ks][1] = *(const f32x4*)(nd + 32 * ks + 8 * g + 4); } }
        unsigned short ngi = 0, ngf = 0; int ngh = 0;
        if (gw4 == 0 && has_next) P4_GATES_LOAD(un, ngi, ngf, ngh);
        if (type == 0) {
            const int qk = tid >> 8;
            const LAS float* WB0 = (const LAS float*)(lds + P4_WB + ((iter & 1) * 2 + 0) * 512) + qk * 64; const LAS float* WB1 = (const LAS float*)(lds + P4_WB + ((iter & 1) * 2 + 1) * 512) + qk * 64;
            float cw[3][8], cb[8];
            const int chn = qk * 256 + h * 64 + c8 * 8;
#pragma unroll
            for (int j4 = 0; j4 < 2; ++j4) { const f32x4 x0 = *(const LAS f32x4*)(CW + chn + 4 * j4), x1 = *(const LAS f32x4*)(CW + 512 + chn + 4 * j4), x2 = *(const LAS f32x4*)(CW + 1024 + chn + 4 * j4), x3 = *(const LAS f32x4*)(CW + 1536 + chn + 4 * j4);
#pragma unroll
                for (int i = 0; i < 4; ++i) { cw[0][4 * j4 + i] = x0[i]; cw[1][4 * j4 + i] = x1[i]; cw[2][4 * j4 + i] = x2[i]; cb[4 * j4 + i] = x3[i]; } }
            const LAS unsigned char* RAW = qk ? KR : QR; LAS unsigned char* DST = lds + (qk ? P4_KP : P4_QP);
#pragma unroll
            for (int pss = 0; pss < 2; ++pss) { const int s = (gt >> 3) + 32 * pss;
                u32x4 a0 = *(const LAS u32x4*)(RAW + (s + 0) * 128 + c8 * 16); const u32x4 a1 = *(const LAS u32x4*)(RAW + (s + 1) * 128 + c8 * 16); u32x4 a2 = *(const LAS u32x4*)(RAW + (s + 2) * 128 + c8 * 16);
                if (t0 + s - 1 < 0) a0 = (u32x4){0u, 0u, 0u, 0u};
                if (t0 + s + 1 >= T) a2 = (u32x4){0u, 0u, 0u, 0u};
                float o[8];
#pragma unroll
                for (int j = 0; j < 4; ++j) {
                    o[2 * j] = fsilu(cb[2 * j] + cw[0][2 * j] * bflo(a0[j]) + cw[1][2 * j] * bflo(a1[j]) + cw[2][2 * j] * bflo(a2[j]));
                    o[2 * j + 1] = fsilu(cb[2 * j + 1] + cw[0][2 * j + 1] * bfhi(a0[j]) + cw[1][2 * j + 1] * bfhi(a1[j]) + cw[2][2 * j + 1] * bfhi(a2[j])); }
                *(LAS u32x4*)(DST + s * PQK + c8 * 16) = pack8(o, WB0[s]);
                *(LAS u32x4*)(DST + P4_TS + s * PQK + c8 * 16) = pack8(o, WB1[s]); }
        } else {
            const bf16x8 w2f = h == 0 ? w2h[0] : h == 1 ? w2h[1] : h == 2 ? w2h[2] : w2h[3]; const float gbd = h == 0 ? gbh[0] : h == 1 ? gbh[1] : h == 2 ? gbh[2] : gbh[3];
            f32x4 la[4];
#pragma unroll
            for (int mt = 0; mt < 4; ++mt) { bf16x8 af = (bf16x8){0, 0, 0, 0, 0, 0, 0, 0}; if (g < 2) af = *(const LAS bf16x8*)(LR + (16 * mt + l15) * 32 + g * 16);
                la[mt] = MFMA16(af, w2f, ((f32x4){gbd, gbd, gbd, gbd}));
#pragma unroll
                for (int rg = 0; rg < 4; ++rg) la[mt][rg] = fast_logsigmoid(la[mt][rg]) * (1.0f / 16.0f); }
            float tmt[4];
#pragma unroll
            for (int mt = 0; mt < 4; ++mt) {
                if (dg == 0) { la[mt][1] += la[mt][0]; la[mt][2] += la[mt][1]; la[mt][3] += la[mt][2]; }
                else { la[mt][2] += la[mt][3]; la[mt][1] += la[mt][2]; la[mt][0] += la[mt][1]; }
                const float tg = dg == 0 ? la[mt][3] : la[mt][0];
                const float t0g = __shfl(tg, l15), t1g = __shfl(tg, l15 + 16), t2g = __shfl(tg, l15 + 32), t3g = __shfl(tg, l15 + 48);
                float og;
                if (dg == 0) og = (g > 0 ? t0g : 0.f) + (g > 1 ? t1g : 0.f) + (g > 2 ? t2g : 0.f);
                else og = (g < 3 ? t3g : 0.f) + (g < 2 ? t2g : 0.f) + (g < 1 ? t1g : 0.f);
#pragma unroll
                for (int rg = 0; rg < 4; ++rg) la[mt][rg] += og;
                tmt[mt] = (t0g + t1g) + (t2g + t3g); }
#pragma unroll
            for (int mt = 0; mt < 4; ++mt) { float om;
                if (dg == 0) om = (mt > 0 ? tmt[0] : 0.f) + (mt > 1 ? tmt[1] : 0.f) + (mt > 2 ? tmt[2] : 0.f);
                else om = (mt < 3 ? tmt[3] : 0.f) + (mt < 2 ? tmt[2] : 0.f) + (mt < 1 ? tmt[1] : 0.f);
#pragma unroll
                for (int rg = 0; rg < 4; ++rg) { const int s = 16 * mt + 4 * g + rg, d = 16 * gw4 + l15; const float B = om + la[mt][rg];
                    const float qv = bf2f(*(const LAS unsigned short*)(QR + (s + 1) * 128 + d * 2)), kv = bf2f(*(const LAS unsigned short*)(KR + (s + 1) * 128 + d * 2));
                    *(LAS unsigned short*)(QP + s * PQK + d * 2) = (unsigned short)f2bf(qv * 0.125f * __expf(B));
                    *(LAS unsigned short*)(KP + s * PQK + d * 2) = (unsigned short)f2bf(kv * __expf(-B)); } }
        }
        asm volatile("" :: "v"(ngi), "v"(ngf), "v"(nsa[0][0]), "v"(nsa[0][1]), "v"(nsa[1][0]), "v"(nsa[1][1]), "v"(ngv[0]), "v"(ngv[1]), "v"(ngv[2]), "v"(ngv[3]));
        VM_WAIT();
        BAR_LDS();
        asm volatile("global_load_dwordx4 %0, %2, off nt\n\tglobal_load_dwordx4 %1, %2, off offset:16 nt" : "=&v"(eg0), "=&v"(eg1) : "v"(zg) : "memory");
        if (has_next) P4_ISSUE_QK(un);
        bf16x8 qf[2];
#pragma unroll
        for (int ks = 0; ks < 2; ++ks) qf[ks] = *(const LAS bf16x8*)(QP + (16 * gw4 + l15) * PQK + (32 * ks + 8 * g) * 2);
        float rs = 0.f;
        {
            f32x4 sa[4];
#pragma unroll
            for (int mt = 0; mt < 4; ++mt) sa[mt] = (f32x4){0.f, 0.f, 0.f, 0.f};
#pragma unroll
            for (int ks = 0; ks < 2; ++ks)
#pragma unroll
                for (int mt = 0; mt < 4; ++mt) { const bf16x8 kf = *(const LAS bf16x8*)(KP + (16 * mt + l15) * PQK + (32 * ks + 8 * g) * 2); sa[mt] = MFMA16(kf, qf[ks], sa[mt]); }
            const int t = 16 * gw4 + l15;
#pragma unroll
            for (int mt = 0; mt < 4; ++mt) { float v[4];
#pragma unroll
                for (int rg = 0; rg < 4; ++rg) { const int sI = 16 * mt + 4 * g + rg; const bool keep = dg == 0 ? (sI <= t) : (sI >= t); v[rg] = keep ? sa[mt][rg] : 0.f; rs += v[rg]; }
                u32x2 w; w.x = pk2(v[0], v[1]); w.y = pk2(v[2], v[3]);
                *(LAS u32x2*)(SW + t * PQK + (16 * mt + 4 * g) * 2) = w; }
            rs += __shfl_xor(rs, 16); rs += __shfl_xor(rs, 32);
        }
        f32x4 na[8], nn = (f32x4){0.f, 0.f, 0.f, 0.f};
#pragma unroll
        for (int mt = 0; mt < 8; ++mt) na[mt] = (f32x4){0.f, 0.f, 0.f, 0.f};
#pragma unroll
        for (int ks = 0; ks < 2; ++ks) { const bf16x8 sf = *(const LAS bf16x8*)(SW + (16 * gw4 + l15) * PQK + (32 * ks + 8 * g) * 2);
            const int r0 = 32 * ks + 8 * g + q, x0 = vswz(r0), x1 = vswz(r0 + 4);
#pragma unroll
            for (int mt = 0; mt < 8; ++mt) { const int ch = 2 * mt + (p >> 1); const LAS unsigned char* pa0 = VT + r0 * 256 + ((ch ^ x0) * 16) + 8 * (p & 1); const LAS unsigned char* pa1 = VT + (r0 + 4) * 256 + ((ch ^ x1) * 16) + 8 * (p & 1);
                na[mt] = MFMA16(cat8(trr(pa0), trr(pa1)), sf, na[mt]); } }
#pragma unroll
        for (int ks = 0; ks < 2; ++ks) {
#pragma unroll
            for (int mt = 0; mt < 8; ++mt) { const bf16x8 cf = *(const LAS bf16x8*)(CTl + ((mt * 2 + ks) * 64 + lane) * 16); na[mt] = MFMA16(cf, qf[ks], na[mt]); }
            if (type == 0) { bf16x8 nf;
#pragma unroll
                for (int j = 0; j < 4; ++j) { nf[j] = (short)f2bf(nsa[ks][0][j]); nf[4 + j] = (short)f2bf(nsa[ks][1][j]); }
                nn = MFMA16(nf, qf[ks], nn); } }
        float inv = 1.0f;
        if (type == 0) { const float qn = __shfl(nn[0], l15); inv = 1.0f / fmaxf(fabsf(rs + qn), 1.0f); }
        BAR_LDS();
        if (has_next) P4_ISSUE_VC(un);
#pragma unroll
        for (int mt = 0; mt < 8; ++mt) { u32x2 w; w.x = pk2(na[mt][0] * inv, na[mt][1] * inv); w.y = pk2(na[mt][2] * inv, na[mt][3] * inv);
            *(LAS u32x2*)(Hme + (16 * gw4 + l15) * PH + (16 * mt + 4 * g) * 2) = w; }
        if (gw4 == 0 && has_next) P4_GATES_SCAN((iter + 1) & 1, ngi, ngf, ngh);
        BAR_LDS();
        {
            const LAS unsigned char* H0 = lds + P4_H + et * PH + evc * 2; float hv[16]; float ss = 0.f;
#pragma unroll
            for (int j = 0; j < 2; ++j) { const u32x4 x0 = *(const LAS u32x4*)(H0 + 16 * j), x1 = *(const LAS u32x4*)(H0 + P4_HS + 16 * j);
#pragma unroll
                for (int i = 0; i < 4; ++i) { const float v0 = bflo(x0[i]) + bflo(x1[i]), v1 = bfhi(x0[i]) + bfhi(x1[i]); hv[8 * j + 2 * i] = v0; hv[8 * j + 2 * i + 1] = v1; ss += v0 * v0 + v1 * v1; } }
            ss += __shfl_xor(ss, 1); ss += __shfl_xor(ss, 2); ss += __shfl_xor(ss, 4);
            const float rn = 1.0f / sqrtf(ss * (1.0f / 128.0f) + EPS);
            { const int nq = has_next ? 8 + (wave < 2 ? 1 : 0) + (gw4 < 2 ? 1 : 0) : 0;
              if (nq == 0) asm volatile("s_waitcnt vmcnt(0)" ::: "memory"); else if (nq == 8) asm volatile("s_waitcnt vmcnt(8)" ::: "memory"); else if (nq == 9) asm volatile("s_waitcnt vmcnt(9)" ::: "memory"); else asm volatile("s_waitcnt vmcnt(10)" ::: "memory");
              asm volatile("" : "+v"(eg0), "+v"(eg1)); }
            float gate[16];
#pragma unroll
            for (int j = 0; j < 4; ++j) { gate[2 * j] = bflo(eg0[j]); gate[2 * j + 1] = bfhi(eg0[j]); gate[8 + 2 * j] = bflo(eg1[j]); gate[8 + 2 * j + 1] = bfhi(eg1[j]); }
            float o[16];
#pragma unroll
            for (int i = 0; i < 16; ++i) { const float gv = type ? fsilu(gate[i]) : fsigmoid(gate[i]); o[i] = hv[i] * rn * ngv[i >> 2][i & 3] * gv; }
            bf16* dst = MG + (size_t)erow * D + type * 512 + h * 128 + evc;
            u32x4 w0, w1; w0.x = pk2(o[0], o[1]); w0.y = pk2(o[2], o[3]); w0.z = pk2(o[4], o[5]); w0.w = pk2(o[6], o[7]); w1.x = pk2(o[8], o[9]); w1.y = pk2(o[10], o[11]); w1.z = pk2(o[12], o[13]); w1.w = pk2(o[14], o[15]);
            *(u32x4*)dst = w0; *(u32x4*)(dst + 8) = w1;
        }
        asm volatile("s_waitcnt vmcnt(8)" ::: "memory");
        BAR_LDS();
    }
#undef P4_DEC
#undef P4_ISSUE_QK
#undef P4_ISSUE_VC
#undef P4_GATES_LOAD
#undef P4_GATES_SCAN
}

constexpr int P6_LG = 131072, P6_PE = 132096, P6_PP = 136192, P6_PR = 140288, P6_LC = 144384;
constexpr int P6_RWH = 0, P6_RR = 65536, P6_LGT = 66560, P6_AS = 83968;
constexpr int CV_GU = 32 * 16 * 64, CV_DN = 32 * 16 * 32, CV_ALL = CV_GU + CV_DN;
__device__ __forceinline__ void cv_load(const Args& a, int it, int lane, f32x4 (&v)[8]) {
    const int c4 = 4 * (lane & 7), kr = 8 * (lane >> 3);
    if (it < CV_GU) { const int e = it >> 10, r = it & 1023, kb = r >> 6, nb = r & 63; const float* W = a.in[I_WGU] + (size_t)e * 1024 * 2048 + (size_t)(64 * kb + kr) * 2048 + 32 * nb + c4;
#pragma unroll
        for (int i = 0; i < 8; ++i) v[i] = __builtin_nontemporal_load((const f32x4*)(W + (size_t)i * 2048)); }
    else { const int r0 = it - CV_GU, e = r0 >> 9, r = r0 & 511, kb = r >> 5, nb = r & 31; const float* W = a.in[I_WD] + (size_t)e * 1024 * 1024 + (size_t)(64 * kb + kr) * 1024 + 32 * nb + c4;
#pragma unroll
        for (int i = 0; i < 8; ++i) v[i] = __builtin_nontemporal_load((const f32x4*)(W + (size_t)i * 1024)); }
}
__device__ __forceinline__ void cv_finish(const Args& a, int it, const f32x4 (&v)[8], LAS float* scr, int lane) {
    (void)scr; const int c4 = 4 * (lane & 7), kr = 8 * (lane >> 3);
    unsigned char* WT; int k0, orow0;
    if (it < CV_GU) { const int e = it >> 10, r = it & 1023, kb = r >> 6, nb = r & 63, n0 = 32 * nb, hf = n0 >> 10, j0 = n0 & 1023; WT = a.ws + WS_WGU + (size_t)e * 2048 * 1024; k0 = 64 * kb; orow0 = 256 * (j0 >> 7) + 128 * hf + (j0 & 127); }
    else { const int r0 = it - CV_GU, e = r0 >> 9, r = r0 & 511, kb = r >> 5, nb = r & 31; WT = a.ws + WS_WD + (size_t)e * 1024 * 1024; k0 = 64 * kb; orow0 = 32 * nb; }
    unsigned char* dst = WT + (size_t)(orow0 + c4) * 1024 + k0 + kr;
#pragma unroll
    for (int j = 0; j < 4; ++j) { u32x2 o;
        o.x = pg8::pk4_fp8(v[0][j] * pg8::WSC, v[1][j] * pg8::WSC, v[2][j] * pg8::WSC, v[3][j] * pg8::WSC); o.y = pg8::pk4_fp8(v[4][j] * pg8::WSC, v[5][j] * pg8::WSC, v[6][j] * pg8::WSC, v[7][j] * pg8::WSC);
        *(u32x2*)(dst + (size_t)j * 1024) = o; }
}
__device__ __forceinline__ void p6_router(const Args& a, LAS unsigned char* lds, int vcu, int G, int cv_lo, int cv_hi) {
    const int tid = threadIdx.x, lane = tid & 63, wave = __builtin_amdgcn_readfirstlane(tid >> 6);
    const int g = lane >> 4, l15 = lane & 15;
    const float* mods = (const float*)(a.ws + WS_MODS); const float* rwt = (const float*)(a.ws + WS_RWT); const float* g2 = a.in[I_N2G]; const float* rb = a.in[I_RB];
    const bf16* X1 = (const bf16*)(a.ws + WS_X1B); unsigned char* U2 = a.ws + WS_U;
    int* ltok = (int*)(a.ws + WS_LTOK); float* lp = (float*)(a.ws + WS_LP); int* tgp = (int*)(a.ws + WS_TGP);
    unsigned* cntw = (unsigned*)(a.ws + WS_CTL) + CW_CNT;
    LAS unsigned char* RWH = lds + P6_RWH; LAS float* RR = (LAS float*)(lds + P6_RR) + wave * 32; LAS float* LGT = (LAS float*)(lds + P6_LGT) + wave * 512;
    LAS float* AS = (LAS float*)(lds + P6_AS);
    LAS int* PE = (LAS int*)(lds + P6_PE); LAS float* PP = (LAS float*)(lds + P6_PP); LAS int* PR = (LAS int*)(lds + P6_PR);
    LAS int* LC = (LAS int*)(lds + P6_LC); LAS int* GB = LC + 32;
    for (int f = wave * 8; f < wave * 8 + 8; ++f) { const int mt = f >> 5, ks = f & 31; const float* src = rwt + (size_t)(16 * mt + l15) * 1024 + 32 * ks + 8 * g;
        const f32x4 x0 = *(const f32x4*)src, x1 = *(const f32x4*)(src + 4);
        u32x4 w; w.x = pk2(x0.x, x0.y); w.y = pk2(x0.z, x0.w); w.z = pk2(x1.x, x1.y); w.w = pk2(x1.z, x1.w);
        *(LAS u32x4*)(RWH + (f * 64 + lane) * 16) = w; }
    f32x4 gv[4];
#pragma unroll
    for (int j = 0; j < 4; ++j) gv[j] = *(const f32x4*)(g2 + 4 * lane + 256 * j);
    const int NGWc = G * NWAVES; int cit = cv_lo + vcu * NWAVES + wave; f32x4 cva[8], cvb[8];
    if (cit < cv_hi) cv_load(a, cit, lane, cva);
    for (int rbk = vcu; rbk < NLAT / 256; rbk += G) {
        const int mbase = rbk * 256 + wave * 32, b = mbase >> 11;
        const float* md = mods + (size_t)b * 6144;
        if (tid < 32) LC[tid] = 0;
        for (int i = tid; i < 1024; i += NTHR) { AS[i] = g2[i] * (1.0f + md[4 * 1024 + i]); AS[1024 + i] = md[3 * 1024 + i]; }
        __syncthreads();
        f32x4 vn[2][4], vm[2][4];
#pragma unroll
        for (int r = 0; r < 2; ++r)
#pragma unroll
            for (int j = 0; j < 4; ++j) { vn[r][j] = ldbf4(X1 + (size_t)(mbase + r) * D + 4 * lane + 256 * j); vm[r][j] = ldbf4(X1 + (size_t)(mbase + 2 + r) * D + 4 * lane + 256 * j); }
        for (int i = 0; i < 32; i += 2) {
            f32x4 v[2][4];
#pragma unroll
            for (int r = 0; r < 2; ++r)
#pragma unroll
                for (int j = 0; j < 4; ++j) { v[r][j] = vn[r][j]; vn[r][j] = vm[r][j]; }
            if (i + 4 < 32) {
#pragma unroll
                for (int r = 0; r < 2; ++r)
#pragma unroll
                    for (int j = 0; j < 4; ++j) vm[r][j] = ldbf4(X1 + (size_t)(mbase + i + 4 + r) * D + 4 * lane + 256 * j); }
#pragma unroll
            for (int r = 0; r < 2; ++r) { float s = 0.f;
#pragma unroll
                for (int j = 0; j < 4; ++j) s += (v[r][j].x * v[r][j].x + v[r][j].y * v[r][j].y) + (v[r][j].z * v[r][j].z + v[r][j].w * v[r][j].w);
                const float rr = 1.0f / sqrtf(wave_sum(s) * (1.0f / D) + EPS);
                if (lane == 0) RR[i + r] = rr;
                unsigned* o4 = (unsigned*)(U2 + (size_t)(mbase + i + r) * D) + lane;
#pragma unroll
                for (int j = 0; j < 4; ++j) { const f32x4 aa = *(const LAS f32x4*)(AS + 4 * lane + 256 * j), sh = *(const LAS f32x4*)(AS + 1024 + 4 * lane + 256 * j);
                    const f32x4 y = v[r][j] * rr * aa + sh;
                    o4[64 * j] = pg8::pk4_fp8(y.x, y.y, y.z, y.w); } }
        }
        LDS_WAIT(); asm volatile("" ::: "memory");
#pragma unroll 1
        for (int tl = 0; tl < 2; ++tl) {
            const int row = mbase + 16 * tl + l15; const float rr = RR[16 * tl + l15];
            const bf16* xr = X1 + (size_t)row * D + 8 * g;
            f32x4 acc[2]; acc[0] = (f32x4){0.f, 0.f, 0.f, 0.f}; acc[1] = acc[0];
            f32x4 xc[4][2], xn[4][2];
#pragma unroll
            for (int k4 = 0; k4 < 4; ++k4) { xc[k4][0] = ldbf4(xr + 32 * k4); xc[k4][1] = ldbf4(xr + 32 * k4 + 4); }
#define P6_KB(kb_, LB_, FB_) do { \
                const int kn = (kb_) < 7 ? (kb_) + 1 : (kb_); \
_Pragma("unroll") \
                for (int k4 = 0; k4 < 4; ++k4) { xn[k4][0] = ldbf4(xr + 32 * (4 * kn + k4)); xn[k4][1] = ldbf4(xr + 32 * (4 * kn + k4) + 4); } \
                if (cit + NGWc < cv_hi) cv_load(a, cit + NGWc, lane, LB_); \
_Pragma("unroll") \
                for (int k4 = 0; k4 < 4; ++k4) { const int ks = 4 * (kb_) + k4; \
                    const f32x4 a0 = *(const LAS f32x4*)(AS + 32 * ks + 8 * g), a1 = *(const LAS f32x4*)(AS + 32 * ks + 8 * g + 4); \
                    const f32x4 s0 = *(const LAS f32x4*)(AS + 1024 + 32 * ks + 8 * g), s1 = *(const LAS f32x4*)(AS + 1024 + 32 * ks + 8 * g + 4); \
                    const f32x4 u0 = xc[k4][0] * rr * a0 + s0, u1 = xc[k4][1] * rr * a1 + s1; \
                    bf16x8 bh, bl; \
_Pragma("unroll") \
                    for (int j = 0; j < 4; ++j) { const unsigned h0 = f2bf(u0[j]), h1 = f2bf(u1[j]); bh[j] = (short)h0; bh[4 + j] = (short)h1; \
                        bl[j] = (short)f2bf(u0[j] - __builtin_bit_cast(float, h0 << 16)); bl[4 + j] = (short)f2bf(u1[j] - __builtin_bit_cast(float, h1 << 16)); } \
_Pragma("unroll") \
                    for (int mt = 0; mt < 2; ++mt) { const bf16x8 af = *(const LAS bf16x8*)(RWH + ((mt * 32 + ks) * 64 + lane) * 16); acc[mt] = MFMA16(af, bh, acc[mt]); acc[mt] = MFMA16(af, bl, acc[mt]); } } \
_Pragma("unroll") \
                for (int k4 = 0; k4 < 4; ++k4) { xc[k4][0] = xn[k4][0]; xc[k4][1] = xn[k4][1]; } \
                if (cit < cv_hi) cv_finish(a, cit, FB_, nullptr, lane); \
                cit += NGWc; \
            } while (0)
#pragma unroll 1
            for (int kb = 0; kb < 8; kb += 2) { P6_KB(kb, cvb, cva); P6_KB(kb + 1, cva, cvb); }
#undef P6_KB
#pragma unroll
            for (int mt = 0; mt < 2; ++mt) { const f32x4 bb = *(const f32x4*)(rb + 16 * mt + 4 * g); *(LAS f32x4*)(LGT + l15 * 32 + 16 * mt + 4 * g) = acc[mt] + bb; }
            LDS_WAIT(); asm volatile("" ::: "memory");
            if (lane < 16) {
                float lv[32];
#pragma unroll
                for (int j = 0; j < 8; ++j) { const f32x4 t4 = *(const LAS f32x4*)(LGT + lane * 32 + 4 * j); lv[4 * j] = t4[0]; lv[4 * j + 1] = t4[1]; lv[4 * j + 2] = t4[2]; lv[4 * j + 3] = t4[3]; }
                unsigned taken = 0u; int sel[4]; float val[4];
#pragma unroll
                for (int k = 0; k < 4; ++k) { float best = -3.0e38f; int bi = 0;
#pragma unroll
                    for (int e = 0; e < 32; ++e) { const bool okk = ((taken >> e) & 1u) == 0u && lv[e] > best; best = okk ? lv[e] : best; bi = okk ? e : bi; }
                    sel[k] = bi; val[k] = best; taken |= 1u << bi; }
                const float e1 = __expf(val[1] - val[0]), e2 = __expf(val[2] - val[0]), e3 = __expf(val[3] - val[0]); const float inv = 1.0f / (1.0f + e1 + e2 + e3);
                const int rl = wave * 32 + 16 * tl + lane; const float pr[4] = {inv, e1 * inv, e2 * inv, e3 * inv};
#pragma unroll
                for (int k = 0; k < 4; ++k) { const int rk = __hip_atomic_fetch_add(LC + sel[k], 1, __ATOMIC_RELAXED, __HIP_MEMORY_SCOPE_WORKGROUP);
                    PE[rl * 4 + k] = sel[k]; PP[rl * 4 + k] = pr[k]; PR[rl * 4 + k] = rk; }
            }
            LDS_WAIT(); asm volatile("" ::: "memory");
        }
        __syncthreads();
        if (tid < 32) GB[tid] = (int)__hip_atomic_fetch_add(cntw + tid * 64, (unsigned)LC[tid], __ATOMIC_RELAXED, __HIP_MEMORY_SCOPE_AGENT);
        __syncthreads();
        for (int pi = tid; pi < 1024; pi += NTHR) { const int e = PE[pi], gg = e, pos = GB[e] + PR[pi], tok = rbk * 256 + (pi >> 2);
            ltok[(size_t)gg * LCAP + pos] = tok; lp[(size_t)gg * LCAP + pos] = PP[pi]; tgp[tok * 4 + (pi & 3)] = (gg << 16) | pos; }
        __syncthreads();
    }
    __syncthreads();
    while (cit < cv_hi) { cv_finish(a, cit, cva, nullptr, lane); cit += NGWc; if (cit < cv_hi) cv_load(a, cit, lane, cva); }
}
__device__ __forceinline__ void p6_convert(const Args& a, LAS unsigned char* lds, int vcu, int G, int lo, int hi) {
    const int tid = threadIdx.x, lane = tid & 63, wave = __builtin_amdgcn_readfirstlane(tid >> 6);
    const int gw = vcu * NWAVES + wave, NGW = G * NWAVES; LAS float* scr = (LAS float*)(lds + wave * 16384);
    int it = lo + gw; if (it >= hi) return;
    f32x4 va[8], vb[8], vc[8];
    cv_load(a, it, lane, va); if (it + NGW < hi) cv_load(a, it + NGW, lane, vb);
    for (;;) {
        if (it + 2 * NGW < hi) cv_load(a, it + 2 * NGW, lane, vc);
        cv_finish(a, it, va, scr, lane); if (it + NGW >= hi) break; it += NGW;
        if (it + 2 * NGW < hi) cv_load(a, it + 2 * NGW, lane, va);
        cv_finish(a, it, vb, scr, lane); if (it + NGW >= hi) break; it += NGW;
        if (it + 2 * NGW < hi) cv_load(a, it + 2 * NGW, lane, vb);
        cv_finish(a, it, vc, scr, lane); if (it + NGW >= hi) break; it += NGW;
    }
}

__device__ __forceinline__ int moe_tables(const Args& a, LAS unsigned char* lds) {
    const int tid = threadIdx.x;
    LAS int* CN = (LAS int*)(lds + TAB_OFF); LAS int* TS = CN + 64; LAS int* TAB = CN + 128;
    unsigned* cntw = (unsigned*)(a.ws + WS_CTL) + CW_CNT;
    __syncthreads();
    if (tid < 32) { int c = (int)__hip_atomic_load(cntw + tid * 64, __ATOMIC_RELAXED, __HIP_MEMORY_SCOPE_AGENT); CN[tid] = c > LCAP ? LCAP : c; }
    __syncthreads();
    if (tid == 0) { int s = 0; for (int e = 0; e < 32; ++e) { TS[e] = s; s += (CN[e] + 255) >> 8; } TS[32] = s > MAXTILES ? MAXTILES : s; }
    __syncthreads();
    const int nt = TS[32];
    for (int tau = tid; tau < nt; tau += NTHR) { int e = 0;
#pragma unroll 1
        for (int k = 1; k < 32; ++k) if (TS[k] <= tau) e = k;
        TAB[tau] = (e << 16) | (tau - TS[e]); }
    __syncthreads();
    return nt;
}

__device__ __forceinline__ void p9_combine(const Args& a, LAS unsigned char* lds, int vcu, int G, bool dry = false) {
    const int tid = threadIdx.x, lane = tid & 63, wave = __builtin_amdgcn_readfirstlane(tid >> 6);
    (void)moe_tables(a, lds);
    const LAS int* TS = (const LAS int*)(lds + TAB_OFF) + 64;
    const float* mods = (const float*)(a.ws + WS_MODS); const float* fg = a.in[I_FNG]; const int* tgp = (const int*)(a.ws + WS_TGP); const unsigned char* Y = a.ws + WS_Y;
    float* O = a.out; const bf16* X1 = (const bf16*)(a.ws + WS_X1B);
    const int gw = vcu * NWAVES + wave, NGW = G * NWAVES;
    f32x4 gv[4];
#pragma unroll
    for (int j = 0; j < 4; ++j) gv[j] = *(const f32x4*)(fg + 4 * lane + 256 * j);
    for (int i0 = gw; i0 < NLAT; i0 += 2 * NGW) {
        int gpv[2][4];
#pragma unroll
        for (int r = 0; r < 2; ++r) { const int i = i0 + r * NGW; const int m = i < NLAT ? i : i0;
#pragma unroll
            for (int k = 0; k < 4; ++k) gpv[r][k] = tgp[m * 4 + k]; }
        f32x4 acc[2][4], x1v[2][4];
#pragma unroll
        for (int r = 0; r < 2; ++r) { const int i = i0 + r * NGW; const int m = i < NLAT ? i : i0;
#pragma unroll
            for (int j = 0; j < 4; ++j) { acc[r][j] = (f32x4){0.f, 0.f, 0.f, 0.f}; x1v[r][j] = ldbf4(X1 + (size_t)m * D + 4 * lane + 256 * j); }
#pragma unroll
            for (int k = 0; k < 4; ++k) { const int gp = gpv[r][k], g = (gp >> 16) & 31, pos = gp & 0xffff; const size_t prow = (size_t)TS[g] * 256 + pos;
                const int* yr = (const int*)(Y + prow * D) + lane;
#pragma unroll
                for (int j = 0; j < 4; ++j) { const int w = yr[64 * j]; const f32x2 lo = __builtin_amdgcn_cvt_pk_f32_fp8(w, false), hi = __builtin_amdgcn_cvt_pk_f32_fp8(w, true); acc[r][j] += (f32x4){lo.x, lo.y, hi.x, hi.y}; } } }
#pragma unroll
        for (int r = 0; r < 2; ++r) { const int i = i0 + r * NGW; if (i >= NLAT) continue;
            const int m = i, b = m >> 11; const float* md = mods + (size_t)b * 6144 + 5 * 1024;
            f32x4 v[4]; float s = 0.f;
#pragma unroll
            for (int j = 0; j < 4; ++j) { const f32x4 g5 = *(const f32x4*)(md + 4 * lane + 256 * j) * pg8::YSCI;
                v[j] = x1v[r][j] + g5 * acc[r][j]; s += (v[j].x * v[j].x + v[j].y * v[j].y) + (v[j].z * v[j].z + v[j].w * v[j].w); }
            const float rr = 1.0f / sqrtf(wave_sum(s) * (1.0f / D) + EPS);
#pragma unroll
            for (int j = 0; j < 4; ++j) { const f32x4 ov = v[j] * rr * gv[j]; if (!dry) *(f32x4*)(O + (size_t)m * D + 4 * lane + 256 * j) = ov; else asm volatile("" :: "v"(ov)); } }
    }
}

constexpr int NPH = 10;
#ifndef NCV_
#define NCV_ 32
#endif
#ifndef CV_P2_
#define CV_P2_ 24576
#endif
constexpr int NCV = NCV_, CV_P2 = CV_P2_;
__global__ void __launch_bounds__(NTHR, 2) fwd_kernel(Args args) {
    extern __shared__ __attribute__((aligned(16))) unsigned char lds_raw[];
    LAS unsigned char* lds = (LAS unsigned char*)lds_raw;
    const int tid = threadIdx.x, G = gridDim.x, bx = blockIdx.x;
    const int vcu = (G % 8 == 0) ? (bx % 8) * (G / 8) + bx / 8 : bx;
    volatile LAS unsigned* MISC = (volatile LAS unsigned*)(lds + MISC_OFF);
    if (tid < 64) MISC[tid] = 0u;
    __syncthreads();
    unsigned* ctl = (unsigned*)(args.ws + WS_CTL);
    const int lo = args.ph_lo, hi = args.ph_hi;
    XcdBarrier bar; bar.bar = ctl + CW_BAR + args.li * XCD_BAR_WORDS; bar.x = 0; bar.st = MISC + 8;
    if (hi - lo > 1) bar = xcd_barrier_post(ctl + CW_BAR + args.li * XCD_BAR_WORDS, MISC + 8);
#ifndef PHMASK
#define PHMASK 0x3ff
#endif
#define IN(k) (((PHMASK >> (k)) & 1) && lo <= (k) && (k) < hi)
#define SEAM(k) do { if (IN(k) && IN((k) + 1)) xcd_barrier(bar); } while (0)
    unsigned char* ws = args.ws;
#ifndef PROBE_DUP
#define PROBE_DUP 0
#endif
#define REPS(k) (1 + ((PROBE_DUP >> (k)) & 1))
    if (IN(0)) { for (int rep = 0; rep < REPS(0); ++rep) { p0_prologue(args, lds, vcu, G); __syncthreads(); } SEAM(0); }
    if (IN(1)) { for (int rep = 0; rep < REPS(1); ++rep) p1_norm1(args, vcu, G); p1_weight_copies(args, lds, vcu, G); SEAM(1); }
    if (IN(2)) {
        const int GG = G > 2 * NCV ? G - NCV : G;
        if (bx >= GG) p6_convert(args, lds, bx - GG, G - GG, 0, CV_P2);
        else {
        { pg8::ProbIn2<false> P{(const char*)(ws + WS_U), (const char*)(ws + WS_WIN), GG, bx};
          pg8::EpiZ E{(bf16*)(ws + WS_Z), 1.0f};
          pg8::gemm_phase<pg8::EpiZ, pg8::ProbIn2<false>, true>(lds, P, E); }
        { pg8::ProbIn2<true> P{(const char*)(ws + WS_U8), (const char*)(ws + WS_WIN8), GG, GG - 1 - bx};
          pg8::EpiZ E{(bf16*)(ws + WS_Z), 1.0f / (USC * pg8::WSC)};
          pg8::gemm_phase<pg8::EpiZ, pg8::ProbIn2<true>, true>(lds, P, E); }
        }
        SEAM(2);
    }
    if (IN(3)) { p3_chains(args, lds, vcu, G); if (REPS(3) > 1) { __syncthreads(); p3_chains(args, lds, vcu, G); } SEAM(3); }
    if (IN(4)) { p4_outputs(args, lds, vcu, G); if (REPS(4) > 1) { __syncthreads(); p4_outputs(args, lds, vcu, G); } SEAM(4); }
    if (IN(5)) {
        pg8::ProbDense P{(const char*)(ws + WS_U), (const char*)(ws + WS_WOUT), NLAT / 256, D / 256, G, bx};
        pg8::EpiX1 E{args.in[I_X], (const float*)(ws + WS_POS), (const float*)(ws + WS_MODS), (bf16*)(ws + WS_X1B)};
        pg8::gemm_phase<pg8::EpiX1, pg8::ProbDense, true>(lds, P, E);
        if (REPS(5) > 1) pg8::gemm_phase<pg8::EpiX1, pg8::ProbDense, true>(lds, P, E);
        SEAM(5);
    }
    if (IN(6)) { p6_router(args, lds, vcu, G, (G > 2 * NCV) ? CV_P2 : 0, CV_ALL);
        if (REPS(12) > 1) { xcd_barrier(bar); if (bx == 0 && tid < 64) (ctl + CW_CNT)[tid * 64] = 0u; xcd_barrier(bar); p6_router(args, lds, vcu, G, 0, 0); }
        SEAM(6); }
    if (IN(7)) {
        const int ntl = moe_tables(args, lds);
        pg8::ProbMoe<true> P{(const char*)(ws + WS_U), (const char*)(ws + WS_WGU), (const int*)(ws + WS_LTOK), (const LAS int*)(lds + TAB_OFF) + 128, (const LAS int*)(lds + TAB_OFF), ntl, 8, G, bx, (size_t)2048 * 1024, args.in[I_BGU], nullptr};
        pg8::EpiGU E{ws + WS_ACT, lds + PF_OFF};
        pg8::gemm_phase<pg8::EpiGU, pg8::ProbMoe<true>, true>(lds, P, E);
        if (REPS(7) > 1) pg8::gemm_phase<pg8::EpiGU, pg8::ProbMoe<true>, true>(lds, P, E);
        SEAM(7);
    }
    if (IN(8)) {
        const int ntl = moe_tables(args, lds);
        pg8::ProbMoe<false> P{(const char*)(ws + WS_ACT), (const char*)(ws + WS_WD), (const int*)(ws + WS_LTOK), (const LAS int*)(lds + TAB_OFF) + 128, (const LAS int*)(lds + TAB_OFF), ntl, 4, G, bx, (size_t)1024 * 1024, args.in[I_BD], (const float*)(ws + WS_LP)};
        pg8::EpiDown E{ws + WS_Y, lds + PF_OFF, (const LAS int*)(lds + TAB_OFF)};
        pg8::gemm_phase<pg8::EpiDown, pg8::ProbMoe<false>, true>(lds, P, E);
        if (REPS(8) > 1) pg8::gemm_phase<pg8::EpiDown, pg8::ProbMoe<false>, true>(lds, P, E);
        SEAM(8);
    }
    if (IN(9)) { if (REPS(9) > 1) p9_combine(args, lds, vcu, G, true); p9_combine(args, lds, vcu, G); }
#undef IN
#undef SEAM
#undef REPS
}

extern "C" void kernel_launch(void* const* d_in, const int* in_sizes, int n_in, void* d_out, int out_size, void* d_ws, size_t ws_size, hipStream_t stream) {
    static int grid = 0;
    if (grid == 0) {
        if (n_in != 24 || in_sizes[0] != NLAT * D || out_size != NLAT * D || ws_size < WS_END) { fprintf(stderr, "kernel_launch: unexpected shapes (n_in %d, in0 %d, out %d, ws %zu); nothing launched\n", n_in, n_in > 0 ? in_sizes[0] : -1, out_size, ws_size); grid = -1; return; }
        int dev = 0, cus = 0, per_cu = 0;
        if (hipGetDevice(&dev) != hipSuccess || hipDeviceGetAttribute(&cus, hipDeviceAttributeMultiprocessorCount, dev) != hipSuccess) { grid = -1; return; }
        if (hipFuncSetAttribute((const void*)fwd_kernel, hipFuncAttributeMaxDynamicSharedMemorySize, LDS_BYTES) != hipSuccess) { fprintf(stderr, "kernel_launch: hipFuncSetAttribute failed\n"); grid = -1; return; }
        if (hipOccupancyMaxActiveBlocksPerMultiprocessor(&per_cu, (const void*)fwd_kernel, NTHR, LDS_BYTES) != hipSuccess || per_cu < 1) { fprintf(stderr, "kernel_launch: occupancy query reports %d workgroups per CU\n", per_cu); }
        (void)hipGetLastError();
        grid = cus;
    }
    if (grid < 0) return;
    if (hipMemsetAsync((char*)d_ws + WS_CTL, 0, CTL_ZERO_BYTES, stream) != hipSuccess) return;
    Args a{};
    for (int i = 0; i < 24; ++i) a.in[i] = (const float*)d_in[i];
    a.out = (float*)d_out; a.ws = (unsigned char*)d_ws; a.pad = 0;
#if MK_N_LAUNCHES == 1
    a.ph_lo = 0; a.ph_hi = NPH; a.li = 0;
    hipLaunchKernelGGL(fwd_kernel, dim3(grid), dim3(NTHR), LDS_BYTES, stream, a);
#else
    for (int ph = 0; ph < NPH; ++ph) { a.ph_lo = ph; a.ph_hi = ph + 1; a.li = ph; hipLaunchKernelGGL(fwd_kernel, dim3(grid), dim3(NTHR), LDS_BYTES, stream, a); }
#endif
}
```
